# Optimizing an MI355X kernel written in HIP

```python
import math
import jax, jax.numpy as jnp
from jax import lax
import numpy as np

D_MODEL = 1024
BATCH = 8
SEQ = 4096
DEPTH = 2

N_BRANCH = 4
BRANCH_W = D_MODEL // 4
POOL_WINDOWS = (2, 4, 8, 16)
POOL_GW = BRANCH_W // len(POOL_WINDOWS)
CONV_W = 3
DA_HEADS = 4
DA_HEAD_DIM = BRANCH_W // (2 * DA_HEADS)
DA_V_DIM = 2 * DA_HEAD_DIM
ROPE_THETA = 10000.0
Q_BLOCK = 128
SG_CHUNK = 128
SG_GROUPS = 4
SG_GW = BRANCH_W // SG_GROUPS
N_GROUPS = 4
EXPERTS_PER_GROUP = 4
N_EXPERTS = N_GROUPS * EXPERTS_PER_GROUP
TOP_K = 2
EXPERT_HIDDEN = 256
IN_COLS = BRANCH_W + 3 * BRANCH_W + 3 * BRANCH_W + 2 * BRANCH_W + N_BRANCH * D_MODEL
LN_EPS = 1e-5
NEG_INF = -1e30
DEEPNORM_ALPHA = (2 * DEPTH) ** 0.25
DEEPNORM_BETA = (8 * DEPTH) ** -0.25

kernel_name = 'hybrid_gated_pool_conv_diffattn_sgmlp_hmoe'


def layer_norm(x, g, b):
    xf = x.astype(jnp.float32)
    mu = jnp.mean(xf, axis=-1, keepdims=True)
    var = jnp.mean(jnp.square(xf - mu), axis=-1, keepdims=True)
    return ((xf - mu) * lax.rsqrt(var + LN_EPS)).astype(x.dtype) * g + b


def rotary(x, cos, sin):
    half = x.shape[-1] // 2
    c = cos[None, :, None, None, :]
    s = sin[None, :, None, None, :]
    xf = x.astype(jnp.float32)
    x1, x2 = xf[..., :half], xf[..., half:]
    return jnp.concatenate([x1 * c - x2 * s, x2 * c + x1 * s], axis=-1).astype(x.dtype)


def causal_multiscale_pool(a, pool_w, pool_scale):
    S = a.shape[1]
    af = a.astype(jnp.float32)
    csum = jnp.pad(jnp.cumsum(af, axis=1), ((0, 0), (1, 0), (0, 0)))
    t = jnp.arange(S)
    pooled = []
    for g, w in enumerate(POOL_WINDOWS):
        cg = csum[..., g * POOL_GW:(g + 1) * POOL_GW]
        lo = jnp.maximum(t + 1 - w, 0)
        win_sum = cg[:, 1:] - jnp.take(cg, lo, axis=1)
        count = jnp.minimum(t + 1, w).astype(jnp.float32)
        pooled.append(win_sum / count[None, :, None])
    pooled = jnp.stack(pooled, axis=2)
    d = (pooled - af.reshape(pooled.shape)).astype(a.dtype)
    y = jnp.einsum('bsgc,gcd->bsgd', d, pool_w)
    return y.reshape(a.shape) * pool_scale


def short_gated_conv(gb, gc, h, conv_w):
    S = h.shape[1]
    z = jnp.pad(gc * h, ((0, 0), (CONV_W - 1, 0), (0, 0)))
    y = z[:, 0:S] * conv_w[0]
    for j in range(1, CONV_W):
        y = y + z[:, j:j + S] * conv_w[j]
    return gb * y


def differential_attention(q, k, v, cos, sin, lam, lam_init, subln_g):
    q = rotary(q, cos, sin)
    k = rotary(k, cos, sin)
    S = q.shape[1]
    scale = DA_HEAD_DIM ** -0.5
    outs = []
    for qb in range(S // Q_BLOCK):
        q0 = qb * Q_BLOCK
        kv = q0 + Q_BLOCK
        s = jnp.einsum('bqhmd,bkhmd->bhmqk', q[:, q0:kv], k[:, :kv]).astype(jnp.float32) * scale
        causal = (q0 + jnp.arange(Q_BLOCK))[:, None] >= jnp.arange(kv)[None, :]
        p = jax.nn.softmax(jnp.where(causal, s, NEG_INF), axis=-1)
        a = p[:, :, 0] - lam * p[:, :, 1]
        outs.append(jnp.einsum('bhqk,bkhe->bqhe', a.astype(v.dtype), v[:, :kv]))
    o = jnp.concatenate(outs, axis=1).astype(jnp.float32)
    o = o * lax.rsqrt(jnp.mean(o * o, axis=-1, keepdims=True) + LN_EPS)
    o = (o * (1.0 - lam_init)).astype(v.dtype) * subln_g
    return o.reshape(o.shape[0], S, DA_HEADS * DA_V_DIM)


def chunked_spatial_gating(u, v, ln_g, ln_b, w_s, b_s):
    B, S, _ = v.shape
    v = layer_norm(v, ln_g, ln_b)
    vc = v.reshape(B, S // SG_CHUNK, SG_CHUNK, SG_GROUPS, SG_GW)
    mask = jnp.tril(jnp.ones((SG_CHUNK, SG_CHUNK), dtype=bool))
    ws = jnp.where(mask[None], w_s, jnp.zeros_like(w_s))
    y = jnp.einsum('gts,bnsgc->bntgc', ws, vc) + b_s.T[None, None, :, :, None]
    return u * y.reshape(B, S, BRANCH_W)


def token_mixer(x, cos, sin, lam_init, w_in, pool_w, pool_scale, conv_w, lam_q1, lam_k1, lam_q2, lam_k2,
                subln_g, sg_ln_g, sg_ln_b, sg_w, sg_b, w_branch, w_o):
    B, S, _ = x.shape
    W = BRANCH_W
    proj = x @ w_in
    p_pool, p_conv, p_attn, p_sg, p_gate = jnp.split(proj, [W, 4 * W, 7 * W, 9 * W], axis=-1)
    y_a = causal_multiscale_pool(p_pool, pool_w, pool_scale)
    gb, gc, h = jnp.split(p_conv, 3, axis=-1)
    y_b = short_gated_conv(gb, gc, h, conv_w)
    q, k, v = jnp.split(p_attn, 3, axis=-1)
    q = q.reshape(B, S, DA_HEADS, 2, DA_HEAD_DIM)
    k = k.reshape(B, S, DA_HEADS, 2, DA_HEAD_DIM)
    v = v.reshape(B, S, DA_HEADS, DA_V_DIM)
    lam = (jnp.exp(jnp.sum(lam_q1.astype(jnp.float32) * lam_k1.astype(jnp.float32)))
           - jnp.exp(jnp.sum(lam_q2.astype(jnp.float32) * lam_k2.astype(jnp.float32))) + lam_init)
    y_c = differential_attention(q, k, v, cos, sin, lam, lam_init, subln_g)
    uv = jax.nn.gelu(p_sg)
    u, vv = jnp.split(uv, 2, axis=-1)
    y_d = chunked_spatial_gating(u, vv, sg_ln_g, sg_ln_b, sg_w, sg_b)
    gates = jax.nn.sigmoid(p_gate.reshape(B, S, N_BRANCH, D_MODEL))
    branches = (y_a, y_b, y_c, y_d)
    merged = gates[:, :, 0] * (branches[0] @ w_branch[0])
    for i in range(1, N_BRANCH):
        merged = merged + gates[:, :, i] * (branches[i] @ w_branch[i])
    return merged @ w_o


def hierarchical_moe(x, w_rg, b_rg, w_re, b_re, w_gate, w_up, w_down):
    gl = (x @ w_rg + b_rg).astype(jnp.float32)
    pg = jax.nn.softmax(gl, axis=-1)
    g_sel = jnp.argmax(gl, axis=-1)
    p_sel = jnp.take_along_axis(pg, g_sel[..., None], axis=-1)
    el = (jnp.einsum('bsd,gde->bsge', x, w_re) + b_re).astype(jnp.float32)
    el_sel = jnp.take_along_axis(el, g_sel[..., None, None], axis=2)[:, :, 0]
    top_v, top_i = lax.top_k(el_sel, TOP_K)
    top_w = jax.nn.softmax(top_v, axis=-1) * p_sel
    expert_id = g_sel[..., None] * EXPERTS_PER_GROUP + top_i
    gate = jnp.sum(jax.nn.one_hot(expert_id, N_EXPERTS, dtype=jnp.float32) * top_w[..., None], axis=-2)
    gate = gate.astype(x.dtype)
    hg = jnp.einsum('bsd,edh->bseh', x, w_gate)
    hu = jnp.einsum('bsd,edh->bseh', x, w_up)
    act = jax.nn.silu(hg) * hu * gate[..., None]
    return jnp.einsum('bseh,ehd->bsd', act, w_down)


def setup_inputs(seed: int = 0) -> dict:
    key = jax.random.key(seed)
    ks = jax.random.split(key, 32)
    f32 = jnp.float32
    L = DEPTH

    def nrm(k, shape, scale):
        return jax.random.normal(k, shape, f32) * scale

    return {
        'x': nrm(ks[0], (BATCH, SEQ, D_MODEL), 1.0),
        'w_in': nrm(ks[1], (L, D_MODEL, IN_COLS), D_MODEL ** -0.5),
        'pool_w': nrm(ks[2], (L, len(POOL_WINDOWS), POOL_GW, POOL_GW), POOL_GW ** -0.5),
        'pool_scale': 1.0 + nrm(ks[3], (L, BRANCH_W), 0.02),
        'conv_w': nrm(ks[4], (L, CONV_W, BRANCH_W), CONV_W ** -0.5),
        'lam_q1': nrm(ks[5], (L, DA_HEAD_DIM), 0.1),
        'lam_k1': nrm(ks[6], (L, DA_HEAD_DIM), 0.1),
        'lam_q2': nrm(ks[7], (L, DA_HEAD_DIM), 0.1),
        'lam_k2': nrm(ks[8], (L, DA_HEAD_DIM), 0.1),
        'subln_g': 1.0 + nrm(ks[9], (L, DA_V_DIM), 0.02),
        'sg_ln_g': 1.0 + nrm(ks[10], (L, BRANCH_W), 0.02),
        'sg_ln_b': nrm(ks[11], (L, BRANCH_W), 0.02),
        'sg_w': nrm(ks[12], (L, SG_GROUPS, SG_CHUNK, SG_CHUNK), SG_CHUNK ** -0.5),
        'sg_b': 1.0 + nrm(ks[13], (L, SG_GROUPS, SG_CHUNK), 0.02),
        'w_branch': nrm(ks[14], (L, N_BRANCH, BRANCH_W, D_MODEL), BRANCH_W ** -0.5),
        'w_o': nrm(ks[15], (L, D_MODEL, D_MODEL), D_MODEL ** -0.5 * DEEPNORM_BETA),
        'ln1_g': 1.0 + nrm(ks[16], (L, D_MODEL), 0.02),
        'ln1_b': nrm(ks[17], (L, D_MODEL), 0.02),
        'w_rg': nrm(ks[18], (L, D_MODEL, N_GROUPS), D_MODEL ** -0.5),
        'b_rg': nrm(ks[19], (L, N_GROUPS), 0.01),
        'w_re': nrm(ks[20], (L, N_GROUPS, D_MODEL, EXPERTS_PER_GROUP), D_MODEL ** -0.5),
        'b_re': nrm(ks[21], (L, N_GROUPS, EXPERTS_PER_GROUP), 0.01),
        'w_gate': nrm(ks[22], (L, N_EXPERTS, D_MODEL, EXPERT_HIDDEN), D_MODEL ** -0.5),
        'w_up': nrm(ks[23], (L, N_EXPERTS, D_MODEL, EXPERT_HIDDEN), D_MODEL ** -0.5),
        'w_down': nrm(ks[24], (L, N_EXPERTS, EXPERT_HIDDEN, D_MODEL), EXPERT_HIDDEN ** -0.5 * DEEPNORM_BETA),
        'ln2_g': 1.0 + nrm(ks[25], (L, D_MODEL), 0.02),
        'ln2_b': nrm(ks[26], (L, D_MODEL), 0.02),
    }


def reference(x, w_in, pool_w, pool_scale, conv_w, lam_q1, lam_k1, lam_q2, lam_k2, subln_g, sg_ln_g, sg_ln_b,
              sg_w, sg_b, w_branch, w_o, ln1_g, ln1_b, w_rg, b_rg, w_re, b_re, w_gate, w_up, w_down, ln2_g, ln2_b):
    S = x.shape[1]
    half = DA_HEAD_DIM // 2
    inv_freq = ROPE_THETA ** (-jnp.arange(half, dtype=jnp.float32) / half)
    ang = jnp.arange(S, dtype=jnp.float32)[:, None] * inv_freq[None, :]
    cos, sin = jnp.cos(ang), jnp.sin(ang)
    for l in range(DEPTH):
        lam_init = 0.8 - 0.6 * math.exp(-0.3 * l)
        mix = token_mixer(x, cos, sin, lam_init, w_in[l], pool_w[l], pool_scale[l], conv_w[l],
                          lam_q1[l], lam_k1[l], lam_q2[l], lam_k2[l], subln_g[l], sg_ln_g[l], sg_ln_b[l],
                          sg_w[l], sg_b[l], w_branch[l], w_o[l])
        x = layer_norm(DEEPNORM_ALPHA * x + mix, ln1_g[l], ln1_b[l])
        ffn = hierarchical_moe(x, w_rg[l], b_rg[l], w_re[l], b_re[l], w_gate[l], w_up[l], w_down[l])
        x = layer_norm(DEEPNORM_ALPHA * x + ffn, ln2_g[l], ln2_b[l])
    return x
```

```cpp
#include <hip/hip_runtime.h>
#include <hip/hip_bf16.h>
#include <cstdio>
#include <cstdint>
#include <cmath>

#ifndef MK_PER_PHASE
#define MK_PER_PHASE 1
#endif

constexpr int BATCH = 8, SEQ = 4096, DMODEL = 1024, M = BATCH * SEQ, DEPTH = 2;
constexpr int NPB = 2304;
constexpr int NGATE = 4096, NIN = NPB + NGATE;
constexpr int PC_POOL = 0, PC_GB = 256, PC_GC = 512, PC_H = 768, PC_Q = 1024, PC_K = 1280, PC_V = 1536, PC_U = 1792, PC_VV = 2048;
constexpr float LN_EPS = 1e-5f;
constexpr float ALPHA = 1.41421356237309515f;
constexpr int NCLS = 24;
constexpr int MAXROWS = 40960;

namespace pg8 {
#define PG8_LAS __attribute__((address_space(3)))
typedef unsigned short bf16_t;
typedef short bf16x8 __attribute__((ext_vector_type(8)));
typedef float f32x4 __attribute__((ext_vector_type(4)));
typedef unsigned u32x4 __attribute__((ext_vector_type(4)));
constexpr int BM = 256, BK = 64, HALF = 128, HTB = HALF * BK * 2  , STAGE_BYTES = 8 * HTB, NXCD = 8, WGM = 8;

__host__ __device__ __forceinline__ int lds_byte(int r, int c) { const int st = (r >> 4) * 2 + (c >> 5), rr = r & 15, cc = c & 31, ob = rr * 64 + cc * 2; return st * 1024 + (ob ^ (((ob >> 9) & 1) << 5)); }
__host__ __device__ __forceinline__ void stage_rc(int b, int& R, int& C) { const int st = b / 1024, sb = b % 1024, swz = sb ^ (((sb >> 9) & 1) << 5); R = (st >> 1) * 16 + swz / 64; C = (st & 1) * 32 + (swz % 64) / 2; }
__host__ __device__ __forceinline__ int perm32(int rho) { const int n = rho >> 4, i = rho & 15; return 8 * (i >> 2) + 4 * n + (i & 3); }

struct Unit { int pm, pn, x, y; };

struct StdOrder {
    const char* A; const char* B; size_t tsA, tsB;
    int nM, nN, nwg, G, c;
    __device__ __forceinline__ void init(const void* A_, const void* B_, int M_, int N_, int K_, int G_, int c_) {
        A = (const char*)A_; B = (const char*)B_; tsA = (size_t)BM * K_ * 2; tsB = tsA; nM = M_ / BM; nN = N_ / BM; nwg = nM * nN; G = G_; c = c_; }
    __device__ __forceinline__ bool next(int i, Unit& u) const {
        const long L = (long)i * G + c; if (L >= nwg) return false;
        int wgid = (int)L; { const int q = nwg / NXCD, r = nwg % NXCD, xcd = wgid % NXCD, off = wgid / NXCD; wgid = (xcd < r ? xcd * (q + 1) : r * (q + 1) + (xcd - r) * q) + off; }
        const int nig = WGM * nN, gid = wgid / nig, fm = gid * WGM, gsz = (nM - fm) < WGM ? (nM - fm) : WGM;
        u.pm = fm + ((wgid % nig) % gsz); u.pn = (wgid % nig) / gsz; u.x = 0; u.y = 0; return true;
    }
    __device__ __forceinline__ const char* aptr(const Unit& u) const { return A + (size_t)u.pm * tsA; }
    __device__ __forceinline__ const char* bptr(const Unit& u, int t) const { return B + (size_t)u.pn * tsB + (size_t)t * (BK * 2); }
};

__device__ __forceinline__ unsigned cvt_pk_bf16(float lo, float hi) { unsigned r; asm volatile("v_cvt_pk_bf16_f32 %0, %1, %2" : "=v"(r) : "v"(lo), "v"(hi)); return r; }
typedef float f32x2 __attribute__((ext_vector_type(2)));
typedef unsigned u32x2 __attribute__((ext_vector_type(2)));
__device__ __forceinline__ float bf_lo(unsigned w) { return __uint_as_float(w << 16); }
__device__ __forceinline__ float bf_hi(unsigned w) { return __uint_as_float(w & 0xffff0000u); }
__device__ __forceinline__ float sigmoidf_(float x) { return __builtin_amdgcn_rcpf(1.0f + __builtin_amdgcn_exp2f(x * -1.4426950408889634f)); }
__device__ __forceinline__ float gelu_tanh(float x) { const float u = x * (1.0f + 0.044715f * x * x); return x * __builtin_amdgcn_rcpf(1.0f + __builtin_amdgcn_exp2f(u * -2.3022082f)); }
__device__ __forceinline__ float ubf(unsigned w, int n) { return (float)((w >> (8 * n)) & 0xffu); }
__device__ __forceinline__ unsigned sig_u8(float x) { return (unsigned)(sigmoidf_(x) * 255.0f + 0.5f); }

struct EpiProj {
    static constexpr bool PERM = true, AFTER_DRAIN = false;
    bf16_t* P; unsigned char* G8;
    __device__ __forceinline__ void operator()(const f32x4 (&acc)[2][2][4][2], const Unit& u, int wr, int wc, int fr, int fq) const {
        const int row0 = u.pm * BM + wr * 64 + fr, col0 = wc * 32 + 8 * fq;
        if (u.pn < 9) {
            const bool act = u.pn >= 7; bf16_t* base = P + u.pn * BM + col0;
#pragma unroll
            for (int ai = 0; ai < 2; ++ai)
#pragma unroll
                for (int m = 0; m < 4; ++m) { bf16_t* rowp = base + (size_t)(row0 + ai * HALF + m * 16) * NPB;
#pragma unroll
                    for (int bj = 0; bj < 2; ++bj) { f32x4 v0 = acc[ai][bj][m][0], v1 = acc[ai][bj][m][1];
                        if (act) { v0 = (f32x4){gelu_tanh(v0[0]), gelu_tanh(v0[1]), gelu_tanh(v0[2]), gelu_tanh(v0[3])}; v1 = (f32x4){gelu_tanh(v1[0]), gelu_tanh(v1[1]), gelu_tanh(v1[2]), gelu_tanh(v1[3])}; }
                        u32x4 w; w.x = cvt_pk_bf16(v0[0], v0[1]); w.y = cvt_pk_bf16(v0[2], v0[3]); w.z = cvt_pk_bf16(v1[0], v1[1]); w.w = cvt_pk_bf16(v1[2], v1[3]);
                        *(u32x4*)(rowp + bj * HALF) = w; } }
        } else {
            unsigned char* base = G8 + (u.pn - 9) * BM + col0;
#pragma unroll
            for (int ai = 0; ai < 2; ++ai)
#pragma unroll
                for (int m = 0; m < 4; ++m) { unsigned char* rowp = base + (size_t)(row0 + ai * HALF + m * 16) * NGATE;
#pragma unroll
                    for (int bj = 0; bj < 2; ++bj) { const f32x4 v0 = acc[ai][bj][m][0], v1 = acc[ai][bj][m][1];
                        u32x2 w; w.x = sig_u8(v0[0]) | (sig_u8(v0[1]) << 8) | (sig_u8(v0[2]) << 16) | (sig_u8(v0[3]) << 24);
                        w.y = sig_u8(v1[0]) | (sig_u8(v1[1]) << 8) | (sig_u8(v1[2]) << 16) | (sig_u8(v1[3]) << 24);
                        *(u32x2*)(rowp + bj * HALF) = w; } }
        }
    }
};
struct EpiMerge {
    static constexpr bool PERM = true, AFTER_DRAIN = false;
    const unsigned char* G8; bf16_t* MG;
    __device__ __forceinline__ void operator()(const f32x4 (&acc)[2][2][4][2], const Unit& u, int wr, int wc, int fr, int fq) const {
        const int row0 = u.pm * BM + wr * 64 + fr, col0 = u.pn * BM + wc * 32 + 8 * fq; const int br = u.x; const float s = 1.0f / 255.0f;
#pragma unroll
        for (int ai = 0; ai < 2; ++ai)
#pragma unroll
            for (int m = 0; m < 4; ++m) { const size_t row = (size_t)(row0 + ai * HALF + m * 16);
#pragma unroll
                for (int bj = 0; bj < 2; ++bj) { const f32x4 v0 = acc[ai][bj][m][0], v1 = acc[ai][bj][m][1];
                    const u32x2 g = *(const u32x2*)(G8 + row * NGATE + br * DMODEL + col0 + bj * HALF);
                    bf16_t* mp = MG + row * DMODEL + col0 + bj * HALF;
                    float o[8];
                    o[0] = ubf(g.x, 0) * s * v0[0]; o[1] = ubf(g.x, 1) * s * v0[1]; o[2] = ubf(g.x, 2) * s * v0[2]; o[3] = ubf(g.x, 3) * s * v0[3];
                    o[4] = ubf(g.y, 0) * s * v1[0]; o[5] = ubf(g.y, 1) * s * v1[1]; o[6] = ubf(g.y, 2) * s * v1[2]; o[7] = ubf(g.y, 3) * s * v1[3];
                    if (br > 0) { const u32x4 p = *(const u32x4*)mp;
                        o[0] += bf_lo(p.x); o[1] += bf_hi(p.x); o[2] += bf_lo(p.y); o[3] += bf_hi(p.y); o[4] += bf_lo(p.z); o[5] += bf_hi(p.z); o[6] += bf_lo(p.w); o[7] += bf_hi(p.w); }
                    u32x4 w; w.x = cvt_pk_bf16(o[0], o[1]); w.y = cvt_pk_bf16(o[2], o[3]); w.z = cvt_pk_bf16(o[4], o[5]); w.w = cvt_pk_bf16(o[6], o[7]);
                    *(u32x4*)mp = w; } }
    }
};
struct EpiRes {
    static constexpr bool PERM = false, AFTER_DRAIN = false;
    const float* res; float* out;
    __device__ __forceinline__ void operator()(const f32x4 (&acc)[2][2][4][2], const Unit& u, int wr, int wc, int fr, int fq) const {
        const int row0 = u.pm * BM + wr * 64 + fr, col0 = u.pn * BM + wc * 32 + 4 * fq;
#pragma unroll
        for (int ai = 0; ai < 2; ++ai)
#pragma unroll
            for (int m = 0; m < 4; ++m) { const size_t off = (size_t)(row0 + ai * HALF + m * 16) * DMODEL + col0;
#pragma unroll
                for (int bj = 0; bj < 2; ++bj)
#pragma unroll
                    for (int n = 0; n < 2; ++n) { const f32x4 r = *(const f32x4*)(res + off + bj * HALF + n * 16); *(f32x4*)(out + off + bj * HALF + n * 16) = r * ALPHA + acc[ai][bj][m][n]; } }
    }
};
struct EpiAct {
    static constexpr bool PERM = true, AFTER_DRAIN = false;
    bf16_t* H; const f32x2* roww;
    __device__ __forceinline__ void operator()(const f32x4 (&acc)[2][2][4][2], const Unit& u, int wr, int wc, int fr, int fq) const {
        const int row0 = u.pm * BM + wr * 64 + fr, col0 = u.x + wc * 32 + 8 * fq;
#pragma unroll
        for (int ai = 0; ai < 2; ++ai)
#pragma unroll
            for (int m = 0; m < 4; ++m) { const size_t row = (size_t)(row0 + ai * HALF + m * 16); const f32x2 rw = roww[row]; const float w = u.y ? rw.y : rw.x;
                float o[8];
#pragma unroll
                for (int n = 0; n < 2; ++n)
#pragma unroll
                    for (int e = 0; e < 4; ++e) { const float g = acc[ai][0][m][n][e], up = acc[ai][1][m][n][e]; o[n * 4 + e] = g * sigmoidf_(g) * up * w; }
                u32x4 q; q.x = cvt_pk_bf16(o[0], o[1]); q.y = cvt_pk_bf16(o[2], o[3]); q.z = cvt_pk_bf16(o[4], o[5]); q.w = cvt_pk_bf16(o[6], o[7]);
                *(u32x4*)(H + row * 512 + col0) = q; }
    }
};
struct EpiDown {
    static constexpr bool PERM = false, AFTER_DRAIN = false;
    const int* rowtok; float* hx;
    __device__ __forceinline__ void operator()(const f32x4 (&acc)[2][2][4][2], const Unit& u, int wr, int wc, int fr, int fq) const {
        const int row0 = u.pm * BM + wr * 64 + fr, col0 = u.pn * BM + wc * 32 + 4 * fq;
#pragma unroll
        for (int ai = 0; ai < 2; ++ai)
#pragma unroll
            for (int m = 0; m < 4; ++m) { const int tok = rowtok[row0 + ai * HALF + m * 16];
                if (tok >= 0) { float* p = hx + (size_t)tok * DMODEL + col0;
#pragma unroll
                    for (int bj = 0; bj < 2; ++bj)
#pragma unroll
                        for (int n = 0; n < 2; ++n) { f32x4* q = (f32x4*)(p + bj * HALF + n * 16); *q = *q * ALPHA + acc[ai][bj][m][n]; } } }
    }
};

template <class Epi, class Sched, bool ALIGN_EPI = false>
__device__ __forceinline__ void gemm_phase(PG8_LAS unsigned char* lds, int tid, const int K, const int ldb, const Sched& S, const Epi& E) {
    asm volatile("" : "+v"(tid));
    const int wid = __builtin_amdgcn_readfirstlane(tid >> 6), lane = tid & 63, wr = wid >> 2, wc = wid & 3, fr = lane & 15, fq = lane >> 4;
    const int nt = K / BK;
    unsigned voffA[2], voffB[2];
#pragma unroll
    for (int i = 0; i < 2; ++i) { int R, C; stage_rc(tid * 16 + i * 8192, R, C); const int Rb = Epi::PERM ? ((R & ~31) + perm32(R & 31)) : R;
        voffA[i] = (unsigned)(R * K + C) * 2u; voffB[i] = (unsigned)(Rb * ldb + C) * 2u; }
    const size_t kstep = (size_t)(BK * 2);
    const size_t hsA = (size_t)HALF * K * 2, hsB = (size_t)HALF * ldb * 2;
    const unsigned ldsw = (unsigned)wid * 1024u;
    const int aoff = lds_byte(wr * 64 + fr, fq * 8), boff = lds_byte(wc * 32 + fr, fq * 8);
#define PG8_SA(b, h) (((b) * 2 + (h)) * HTB)
#define PG8_SB(b, h) ((4 + (b) * 2 + (h)) * HTB)
#define PG8_STAGE(bufoff, gbase, voff) do { _Pragma("unroll") for (int _i = 0; _i < 2; ++_i) \
        __builtin_amdgcn_global_load_lds((const unsigned*)((const char*)(gbase) + (voff)[_i]), (PG8_LAS unsigned*)(lds + (bufoff) + ldsw + _i * 8192), 16, 0, 0); } while (0)
#define PG8_LDA(dst, b, h) do { _Pragma("unroll") for (int m = 0; m < 4; ++m) _Pragma("unroll") for (int k = 0; k < 2; ++k) dst[m][k] = *(const PG8_LAS bf16x8*)(lds + PG8_SA(b, h) + aoff + m * 2048 + k * 1024); } while (0)
#define PG8_LDB(dst, b, h) do { _Pragma("unroll") for (int n = 0; n < 2; ++n) _Pragma("unroll") for (int k = 0; k < 2; ++k) dst[n][k] = *(const PG8_LAS bf16x8*)(lds + PG8_SB(b, h) + boff + n * 2048 + k * 1024); } while (0)
#define PG8_MMA(ai, bj, At, Bt) do { __builtin_amdgcn_s_setprio(1); _Pragma("unroll") for (int m = 0; m < 4; ++m) _Pragma("unroll") for (int n = 0; n < 2; ++n) _Pragma("unroll") for (int k = 0; k < 2; ++k) \
        acc[ai][bj][m][n] = __builtin_amdgcn_mfma_f32_16x16x32_bf16(Bt[n][k], At[m][k], acc[ai][bj][m][n], 0, 0, 0); __builtin_amdgcn_s_setprio(0); } while (0)
#define PG8_WAIT_V(n) asm volatile("s_waitcnt vmcnt(" #n ")" ::: "memory")
#define PG8_WAIT_L(n) asm volatile("s_waitcnt lgkmcnt(" #n ")" ::: "memory")
#define PG8_BAR __builtin_amdgcn_s_barrier()
#define PG8_SCHED __builtin_amdgcn_sched_barrier(0)
    Unit cur, nxt; int ui = 0;
    if (!S.next(0, cur)) return;
    f32x4 acc[2][2][4][2];
#pragma unroll
    for (int a = 0; a < 2; ++a)
#pragma unroll
        for (int b = 0; b < 2; ++b)
#pragma unroll
            for (int m = 0; m < 4; ++m)
#pragma unroll
                for (int n = 0; n < 2; ++n) acc[a][b][m][n] = (f32x4){0.f, 0.f, 0.f, 0.f};
    bf16x8 At[4][2], B0[2][2], B1[2][2];
    const char* cA = S.aptr(cur);
    {   const char* cB0 = S.bptr(cur, 0); const char* cB1 = S.bptr(cur, 1);
        PG8_STAGE(PG8_SB(0, 0), cB0, voffB); PG8_STAGE(PG8_SB(0, 1), cB0 + hsB, voffB); PG8_STAGE(PG8_SA(0, 0), cA, voffA); PG8_STAGE(PG8_SA(0, 1), cA + hsA, voffA);
        if (wr == 1) PG8_BAR;
        PG8_WAIT_V(2); PG8_BAR;
        PG8_STAGE(PG8_SB(1, 0), cB1, voffB); PG8_STAGE(PG8_SA(1, 0), cA + kstep, voffA); PG8_STAGE(PG8_SB(1, 1), cB1 + hsB, voffB);
        PG8_WAIT_V(6); PG8_BAR;
    }
    for (;;) {
        const bool has_next = S.next(ui + 1, nxt);
        const char* nA = has_next ? S.aptr(nxt) : cA;
        const char* nB0 = has_next ? S.bptr(nxt, 0) : S.bptr(cur, 0); const char* nB1 = has_next ? S.bptr(nxt, 1) : S.bptr(cur, 1);
        for (int t = 0; t < nt; t += 2) {
            const bool last = (t == nt - 2);
            const char* a1 = cA + (size_t)(t + 1) * kstep;
            const char* a2 = last ? nA : cA + (size_t)(t + 2) * kstep; const char* a3 = a2 + kstep;
            const char* b2 = last ? nB0 : S.bptr(cur, t + 2); const char* b3 = last ? nB1 : S.bptr(cur, t + 3);
            PG8_LDB(B0, 0, 0); PG8_LDB(B1, 0, 1); PG8_SCHED; PG8_LDA(At, 0, 0); PG8_STAGE(PG8_SA(1, 1), a1 + hsA, voffA);
            PG8_WAIT_V(8); PG8_WAIT_L(0); PG8_BAR; PG8_MMA(0, 0, At, B0); PG8_MMA(0, 1, At, B1); PG8_BAR; PG8_SCHED;
            PG8_LDA(At, 0, 1); PG8_STAGE(PG8_SB(0, 0), b2, voffB); PG8_STAGE(PG8_SB(0, 1), b2 + hsB, voffB); PG8_STAGE(PG8_SA(0, 0), a2, voffA);
            PG8_WAIT_V(8); PG8_WAIT_L(0); PG8_BAR; PG8_MMA(1, 0, At, B0); PG8_MMA(1, 1, At, B1); PG8_BAR; PG8_SCHED;
            PG8_LDB(B0, 1, 0); PG8_LDB(B1, 1, 1); PG8_SCHED; PG8_LDA(At, 1, 0); PG8_STAGE(PG8_SA(0, 1), a2 + hsA, voffA);
            PG8_WAIT_V(8); PG8_WAIT_L(0); PG8_BAR; PG8_MMA(0, 0, At, B0); PG8_MMA(0, 1, At, B1); PG8_BAR; PG8_SCHED;
            PG8_LDA(At, 1, 1); PG8_STAGE(PG8_SB(1, 0), b3, voffB); PG8_STAGE(PG8_SB(1, 1), b3 + hsB, voffB); PG8_STAGE(PG8_SA(1, 0), a3, voffA);
            PG8_WAIT_V(8); PG8_WAIT_L(0); PG8_BAR; PG8_MMA(1, 0, At, B0); PG8_MMA(1, 1, At, B1); PG8_BAR; PG8_SCHED;
        }
        if constexpr (ALIGN_EPI) { if (wr == 0) PG8_BAR; }
        E(acc, cur, wr, wc, fr, fq);
        if (!has_next) break;
#pragma unroll
        for (int a = 0; a < 2; ++a)
#pragma unroll
            for (int b = 0; b < 2; ++b)
#pragma unroll
                for (int m = 0; m < 4; ++m)
#pragma unroll
                    for (int n = 0; n < 2; ++n) acc[a][b][m][n] = (f32x4){0.f, 0.f, 0.f, 0.f};
        cur = nxt; cA = nA; ++ui;
        if constexpr (ALIGN_EPI) { if (wr == 1) PG8_BAR; }
    }
    PG8_WAIT_V(0);
    if constexpr (!ALIGN_EPI) { if (wr == 0) PG8_BAR; }
    PG8_BAR;
#undef PG8_SA
#undef PG8_SB
#undef PG8_STAGE
#undef PG8_LDA
#undef PG8_LDB
#undef PG8_MMA
#undef PG8_WAIT_V
#undef PG8_WAIT_L
#undef PG8_BAR
#undef PG8_SCHED
}
}

namespace attn_body {
using bf16=unsigned short;
using bf16x8=__attribute__((ext_vector_type(8)))short;
using s16x4=__attribute__((ext_vector_type(4)))short;
using f32x16=__attribute__((ext_vector_type(16)))float;
using u32x4=__attribute__((ext_vector_type(4)))unsigned;
using f32x4=__attribute__((ext_vector_type(4)))float;
constexpr int BATCH=8,NHEAD=8,SEQ=4096,D=64,DM=NHEAD*D;
constexpr int VP=NPB;
constexpr int NW=8,QBLK=32,QB=QBLK*NW,KVBLK=64,NQB=SEQ/QB;
__device__ __forceinline__ int crow(int r,int hi){return (r&3)+8*(r>>2)+4*hi;}
#define SBAR() __builtin_amdgcn_sched_barrier(0)
__device__ __forceinline__ void cmask(f32x16&p0,f32x16&p1,int jb,int qrel,int hi){
  const float NEG=-INFINITY; int kb=64*jb+4*hi;
  #pragma unroll
  for(int r=0;r<16;++r){int kv=kb+(r&3)+8*(r>>2); if(kv>qrel)p0[r]=NEG; if(kv+32>qrel)p1[r]=NEG;}
}

constexpr int NSLOT=3, SLOTB=8192;
constexpr int LDS_K=0, LDS_V=NSLOT*SLOTB, LDS_WS=2*NSLOT*SLOTB, LDS_OST=LDS_WS+NW*64*4, LDS_BYTES=LDS_OST+NW*4096;
constexpr float C2=0.17677669529663687f*1.4426950408889634f;
__device__ __forceinline__ void glds16(const void*gsrc,unsigned lds_dst){unsigned keep;
  asm volatile("s_mov_b32 %0, m0\n\ts_mov_b32 m0, %2\n\ts_nop 0\n\tglobal_load_lds_dwordx4 %1, off\n\ts_mov_b32 m0, %0":"=&s"(keep):"v"(gsrc),"s"(lds_dst):"memory");}
__device__ __forceinline__ float max3f(float a,float b,float c){float r;asm("v_max3_f32 %0, %1, %2, %3":"=v"(r):"v"(a),"v"(b),"v"(c));return r;}
__device__ __forceinline__ float max2f(float a,float b){float r;asm("v_max_f32_e32 %0, %1, %2":"=v"(r):"v"(a),"v"(b));return r;}
__device__ __forceinline__ float fadd_s(float a,float b){float r;asm("v_add_f32_e32 %0, %1, %2":"=v"(r):"v"(a),"v"(b));return r;}
__device__ __forceinline__ float fsub_s(float a,float b){float r;asm("v_sub_f32_e32 %0, %1, %2":"=v"(r):"v"(a),"v"(b));return r;}
typedef float f32x2_t __attribute__((ext_vector_type(2))); typedef __bf16 bf16x2_t __attribute__((ext_vector_type(2)));
__device__ __forceinline__ unsigned cvtpk_s(float lo,float hi){f32x2_t v={lo,hi};bf16x2_t b=__builtin_convertvector(v,bf16x2_t);return __builtin_bit_cast(unsigned,b);}
#define WAIT_BAR(N) asm volatile("s_waitcnt vmcnt(" #N ") lgkmcnt(0)\n\ts_barrier":::"memory")

__device__ __forceinline__ void qkt(f32x16&p0,f32x16&p1,const char*Kslot,const bf16x8*qr,const f32x16&negm,int r32,int hi){
  const char*kb=Kslot+hi*1024+r32*16;
  #pragma unroll
  for(int d0=0;d0<4;++d0){
    const bf16x8 b0=*reinterpret_cast<const bf16x8*>(kb+d0*2048);
    const bf16x8 b1=*reinterpret_cast<const bf16x8*>(kb+d0*2048+512);
    if(d0==0){p0=__builtin_amdgcn_mfma_f32_32x32x16_bf16(b0,qr[0],negm,0,0,0);p1=__builtin_amdgcn_mfma_f32_32x32x16_bf16(b1,qr[0],negm,0,0,0);}
    else{p0=__builtin_amdgcn_mfma_f32_32x32x16_bf16(b0,qr[d0],p0,0,0,0);p1=__builtin_amdgcn_mfma_f32_32x32x16_bf16(b1,qr[d0],p1,0,0,0);}}
}
typedef __attribute__((address_space(3))) const char* lds_cptr;
typedef short v4i16_t __attribute__((ext_vector_type(4)));
__device__ __forceinline__ void kload8(bf16x8*kf,lds_cptr kp){
  kf[0]=*(const __attribute__((address_space(3))) bf16x8*)(kp);      kf[1]=*(const __attribute__((address_space(3))) bf16x8*)(kp+512);
  kf[2]=*(const __attribute__((address_space(3))) bf16x8*)(kp+2048); kf[3]=*(const __attribute__((address_space(3))) bf16x8*)(kp+2560);
  kf[4]=*(const __attribute__((address_space(3))) bf16x8*)(kp+4096); kf[5]=*(const __attribute__((address_space(3))) bf16x8*)(kp+4608);
  kf[6]=*(const __attribute__((address_space(3))) bf16x8*)(kp+6144); kf[7]=*(const __attribute__((address_space(3))) bf16x8*)(kp+6656);
}
__device__ __forceinline__ void kload2(bf16x8*kf,lds_cptr kp,int j){ kf[2*j]=*(const __attribute__((address_space(3))) bf16x8*)(kp+j*2048); kf[2*j+1]=*(const __attribute__((address_space(3))) bf16x8*)(kp+j*2048+512); }
__device__ __forceinline__ s16x4 vtr(lds_cptr p){ return __builtin_bit_cast(s16x4,__builtin_amdgcn_ds_read_tr16_b64_v4i16((__attribute__((address_space(3))) v4i16_t*)p)); }
__device__ __forceinline__ float rowmax(const f32x16&p0,const f32x16&p1){
  float a=max3f(p0[0],p0[1],p1[0]),b=max3f(p0[2],p0[3],p1[1]);a=max3f(a,p1[2],p1[3]);
  #pragma unroll
  for(int r=4;r<16;r+=4){a=max3f(a,p0[r],p0[r+1]);b=max3f(b,p0[r+2],p0[r+3]);a=max3f(a,p1[r],p1[r+1]);b=max3f(b,p1[r+2],p1[r+3]);}
  const float m=max2f(a,b);
  auto rr=__builtin_amdgcn_permlane32_swap(__float_as_uint(m),__float_as_uint(m),false,false);
  return max2f(__uint_as_float(rr[0]),__uint_as_float(rr[1]));
}
__device__ __forceinline__ void pv(f32x16*o,int vb,bf16x8 pa0,bf16x8 pa1,bf16x8 pa2,bf16x8 pa3){
  #pragma unroll
  for(int d0=0;d0<2;++d0){s16x4 lo[4],hi[4];
    #pragma unroll
    for(int ks=0;ks<4;++ks){
      asm volatile("ds_read_b64_tr_b16 %0,%1 offset:%c2":"=&v"(lo[ks]):"v"(vb),"i"(d0*4096+ks*1024):"memory");
      asm volatile("ds_read_b64_tr_b16 %0,%1 offset:%c2":"=&v"(hi[ks]):"v"(vb),"i"(d0*4096+ks*1024+512):"memory");}
    asm volatile("s_waitcnt lgkmcnt(0)":::"memory");SBAR();
    #define PK(k) (bf16x8){lo[k][0],lo[k][1],lo[k][2],lo[k][3],hi[k][0],hi[k][1],hi[k][2],hi[k][3]}
    o[d0]=__builtin_amdgcn_mfma_f32_32x32x16_bf16(pa0,PK(0),o[d0],0,0,0);
    o[d0]=__builtin_amdgcn_mfma_f32_32x32x16_bf16(pa1,PK(1),o[d0],0,0,0);
    o[d0]=__builtin_amdgcn_mfma_f32_32x32x16_bf16(pa2,PK(2),o[d0],0,0,0);
    o[d0]=__builtin_amdgcn_mfma_f32_32x32x16_bf16(pa3,PK(3),o[d0],0,0,0);
    #undef PK
  }
}

template<int THRL> __device__ __forceinline__ void attn_unit(int b,int h,int mp,int qb,const bf16*Q,const bf16*__restrict__ K,const bf16*__restrict__ V,bf16*Y,float lam,float osc,const float*__restrict__ sg,char*shm,int tid){
  asm volatile("":"+v"(tid)); const int lane=tid&63,r32=lane&31,hi=lane>>5; const int wid=__builtin_amdgcn_readfirstlane(tid>>6);
  const long rowbase=(long)b*SEQ; const int q0=qb*QB; const int vh=2*h+mp;
  const bf16*Qw=Q+(rowbase+q0+wid*QBLK)*DM+vh*D;
  const bf16*Kh=K+rowbase*DM+vh*D,*Vh=V+rowbase*VP+h*D;
  const unsigned lds0=(unsigned)(uintptr_t)shm;
  float*wsf=(float*)(shm+LDS_WS)+wid*64;
  const bf16*ksrc=Kh+(long)lane*DM+wid*8;
  const bf16*vsrc=Vh+(long)(16*(wid&3)+(lane>>2))*VP+(wid>>2)*32+(lane&3)*8;
  const unsigned kdst=lds0+LDS_K+wid*1024, vdst=lds0+LDS_V+wid*1024;
  #define DMA_K(t,slot) glds16(ksrc+(long)(t)*KVBLK*DM,(unsigned)__builtin_amdgcn_readfirstlane(kdst+(slot)))
  #define DMA_V(t,slot) glds16(vsrc+(long)(t)*KVBLK*VP,(unsigned)__builtin_amdgcn_readfirstlane(vdst+(slot)))
  const int vb0=(int)(lds0+LDS_V)+((lane>>4)&1)*32+(lane&3)*8+(4*hi+((lane&15)>>2))*64;
  const char*Kbase=shm+LDS_K; bf16x8 kf[8];
  const lds_cptr shm3=(lds_cptr)shm; const lds_cptr kp0=shm3+LDS_K+hi*1024+r32*16; const lds_cptr vp0=shm3+LDS_V+((lane>>4)&1)*32+(lane&3)*8+(4*hi+((lane&15)>>2))*64;
  const int NT=(q0+QB)/KVBLK;
  DMA_K(0,0);DMA_V(0,0);DMA_K(1,SLOTB);
  bf16x8 qr[4];
  #pragma unroll
  for(int d0=0;d0<4;++d0)qr[d0]=*reinterpret_cast<const bf16x8*>(&Qw[(long)r32*DM+d0*16+hi*8]);
  float zz=0.f; asm volatile("":"+v"(zz));
  float mhat=0.f,l_reg=0.f;f32x16 o[2],negm;
  #pragma unroll
  for(int r=0;r<16;++r){o[0][r]=zz;o[1][r]=zz;negm[r]=zz;}
  asm volatile("":"+v"(negm));
  const int qrel=wid*QBLK+r32;
  #define CMASK(P0,P1,t) do{int jb_=(t)-(NT-4); if(jb_>=0)cmask(P0,P1,jb_,qrel,hi);}while(0)
  bool resc=false;
  #define START(P0,P1) do{ const float rm=rowmax(P0,P1); resc=false; \
    { const float dl=rm; mhat=fadd_s(mhat,dl); \
      _Pragma("unroll") for(int r=0;r<16;++r){P0[r]=fsub_s(P0[r],dl);P1[r]=fsub_s(P1[r],dl);} \
      _Pragma("unroll") for(int r=0;r<16;++r)negm[r]=-mhat; asm volatile("":"+v"(negm)); } \
    _Pragma("unroll") for(int r=0;r<16;++r)P0[r]=__builtin_amdgcn_exp2f(P0[r]); }while(0)
  #define RESC() do{ if(resc){ asm volatile("s_waitcnt lgkmcnt(0)":::"memory"); \
      _Pragma("unroll") for(int d_=0;d_<2;++d_) _Pragma("unroll") for(int r=0;r<16;++r)o[d_][r]*=wsf[crow(r,hi)]; } }while(0)
  f32x16 pA0,pA1,pB0,pB1;
  int sl_prev=0,sl_cur=0,sl_next=SLOTB;
  #define ROT() do{sl_prev=sl_cur;sl_cur=sl_next;sl_next=(sl_next==(NSLOT-1)*SLOTB)?0:sl_next+SLOTB;}while(0)
  DMA_K(2,2*SLOTB);
  WAIT_BAR(3);
  qkt(pA0,pA1,Kbase,qr,negm,r32,hi);asm volatile("s_nop 15\n\ts_nop 7":"+v"(pA0),"+v"(pA1));CMASK(pA0,pA1,0);
  START(pA0,pA1);
  _Pragma("unroll") for(int r=0;r<16;++r)pA1[r]=__builtin_amdgcn_exp2f(pA1[r]);
  WAIT_BAR(0);
  DMA_K(3,0);DMA_V(1,SLOTB);
  ROT();
  kload8(kf,kp0+sl_cur);
  WAIT_BAR(2);
  s16x4 vlo[8],vhi[8]; u32x4 pw0,pw1,pw2,pw3;
  #define PKW(P,B) cvtpk_s(P[B],P[B+1])
  #define PAF(k) __builtin_bit_cast(bf16x8,pw##k)
  #define VFR(i) (bf16x8){vlo[i][0],vlo[i][1],vlo[i][2],vlo[i][3],vhi[i][0],vhi[i][1],vhi[i][2],vhi[i][3]}
  #define PIN(x) asm volatile("":"+v"(x))
  #define MX3(a,b,c) __builtin_fmaxf(__builtin_fmaxf((a),(b)),(c))
  #define GAPA(MF,A0,A1,A2,A3,W0,W1,PW) do{ MF; sacc+=A0; sacc+=A1; sacc+=A2; sacc+=A3; PIN(sacc); W0; W1; PIN(PW); SBAR(); }while(0)
  #define EX(v) __builtin_amdgcn_exp2f(v)
  #define GAPB(MF,X,B) do{ MF; X[B]=EX(X[B]); X[B+1]=EX(X[B+1]); X[B+2]=EX(X[B+2]); X[B+3]=EX(X[B+3]); PIN(X); SBAR(); }while(0)
  #define VRD(i) do{ vlo[i]=vtr(vp_+(((i)>>2)*4096+((i)&3)*1024)); vhi[i]=vtr(vp_+(((i)>>2)*4096+((i)&3)*1024+512)); }while(0)
  #define KRD(G,j) do{ if(G){ kload2(kf,kp0+sl_next,j); SBAR(); } }while(0)
  #define STEP(C0,C1,P0,P1,t,GK,GV,GL) do{ SBAR(); \
    const lds_cptr vp_=vp0+sl_prev; \
    VRD(0); SBAR(); float sacc=(P0[0]+P0[1]); \
    GAPA(C0=__builtin_amdgcn_mfma_f32_32x32x16_bf16(kf[0],qr[0],negm,0,0,0), P0[2],P0[3],P0[4],P0[5],     pw0[0]=PKW(P0,0), pw0[1]=PKW(P0,2), pw0); \
    VRD(4); SBAR(); GAPA(C1=__builtin_amdgcn_mfma_f32_32x32x16_bf16(kf[1],qr[0],negm,0,0,0), P0[6],P0[7],P0[8],P0[9],     pw0[2]=PKW(P0,4), pw0[3]=PKW(P0,6), pw0); \
    VRD(1); SBAR(); GAPA(C0=__builtin_amdgcn_mfma_f32_32x32x16_bf16(kf[2],qr[1],C0,0,0,0),   P0[10],P0[11],P0[12],P0[13], pw1[0]=PKW(P0,8), pw1[1]=PKW(P0,10), pw1); \
    VRD(5); SBAR(); GAPA(C1=__builtin_amdgcn_mfma_f32_32x32x16_bf16(kf[3],qr[1],C1,0,0,0),   P0[14],P0[15],P1[0],P1[1],   pw1[2]=PKW(P0,12),pw1[3]=PKW(P0,14), pw1); \
    VRD(2); SBAR(); GAPA(C0=__builtin_amdgcn_mfma_f32_32x32x16_bf16(kf[4],qr[2],C0,0,0,0),   P1[2],P1[3],P1[4],P1[5],     pw2[0]=PKW(P1,0), pw2[1]=PKW(P1,2), pw2); \
    VRD(6); SBAR(); GAPA(C1=__builtin_amdgcn_mfma_f32_32x32x16_bf16(kf[5],qr[2],C1,0,0,0),   P1[6],P1[7],P1[8],P1[9],     pw2[2]=PKW(P1,4), pw2[3]=PKW(P1,6), pw2); \
    VRD(3); SBAR(); GAPA(C0=__builtin_amdgcn_mfma_f32_32x32x16_bf16(kf[6],qr[3],C0,0,0,0),   P1[10],P1[11],P1[12],P1[13], pw3[0]=PKW(P1,8), pw3[1]=PKW(P1,10), pw3); \
    VRD(7); SBAR(); GAPA(C1=__builtin_amdgcn_mfma_f32_32x32x16_bf16(kf[7],qr[3],C1,0,0,0),   P1[14],P1[15],0.f,0.f,       pw3[2]=PKW(P1,12),pw3[3]=PKW(P1,14), pw3); \
    l_reg+=sacc; \
    if(GK){DMA_K((t)+3,sl_cur);} if(GV){DMA_V((t)+1,sl_next);} \
    CMASK(C0,C1,t); \
    { float a=MX3(C0[0],C0[1],C1[0]),b=MX3(C0[2],C0[3],C1[1]); a=MX3(a,C1[2],C1[3]); \
      _Pragma("unroll") for(int r=4;r<16;r+=4){a=MX3(a,C0[r],C0[r+1]);b=MX3(b,C0[r+2],C0[r+3]);a=MX3(a,C1[r],C1[r+1]);b=MX3(b,C1[r+2],C1[r+3]);} \
      float rm=__builtin_fmaxf(a,b); { auto rr=__builtin_amdgcn_permlane32_swap(__float_as_uint(rm),__float_as_uint(rm),false,false); rm=__builtin_fmaxf(__uint_as_float(rr[0]),__uint_as_float(rr[1])); } \
      resc=false; \
      if(__builtin_expect(__any(rm>(float)THRL),0)){ const float dl=__builtin_fmaxf(rm,0.f); mhat+=dl; \
        _Pragma("unroll") for(int r=0;r<16;++r){C0[r]-=dl;C1[r]-=dl;} \
        _Pragma("unroll") for(int r=0;r<16;++r)negm[r]=-mhat; asm volatile("":"+v"(negm)); \
        const float f=__builtin_amdgcn_exp2f(-dl); l_reg*=f; if(hi==0)wsf[r32]=f; resc=true; } } \
    SBAR(); \
    GAPB(o[0]=__builtin_amdgcn_mfma_f32_32x32x16_bf16(PAF(0),VFR(0),o[0],0,0,0), C0,0); \
    GAPB(o[1]=__builtin_amdgcn_mfma_f32_32x32x16_bf16(PAF(0),VFR(4),o[1],0,0,0), C0,4); \
    KRD(GL,0); GAPB(o[0]=__builtin_amdgcn_mfma_f32_32x32x16_bf16(PAF(1),VFR(1),o[0],0,0,0), C0,8); \
    KRD(GL,1); GAPB(o[1]=__builtin_amdgcn_mfma_f32_32x32x16_bf16(PAF(1),VFR(5),o[1],0,0,0), C0,12); \
    KRD(GL,2); GAPB(o[0]=__builtin_amdgcn_mfma_f32_32x32x16_bf16(PAF(2),VFR(2),o[0],0,0,0), C1,0); \
    KRD(GL,3); GAPB(o[1]=__builtin_amdgcn_mfma_f32_32x32x16_bf16(PAF(2),VFR(6),o[1],0,0,0), C1,4); \
    GAPB(o[0]=__builtin_amdgcn_mfma_f32_32x32x16_bf16(PAF(3),VFR(3),o[0],0,0,0), C1,8); \
    GAPB(o[1]=__builtin_amdgcn_mfma_f32_32x32x16_bf16(PAF(3),VFR(7),o[1],0,0,0), C1,12); \
    }while(0)
  int t=1;
  #undef CMASK
  #define CMASK(P0,P1,t) do{}while(0)
  for(;t+5<NT;t+=2){
    STEP(pB0,pB1,pA0,pA1,t,true,true,true);     WAIT_BAR(2); RESC(); ROT();
    STEP(pA0,pA1,pB0,pB1,t+1,true,true,true);   WAIT_BAR(2); RESC(); ROT();
  }
  #undef CMASK
  #define CMASK(P0,P1,t) do{int jb_=(t)-(NT-4); if(jb_>=0)cmask(P0,P1,jb_,qrel,hi);}while(0)
  #define ENDW(tt) do{ if((tt)+3<NT){WAIT_BAR(2);} else if((tt)+2<NT){WAIT_BAR(1);} else {WAIT_BAR(0);} }while(0)
  for(;t+1<NT;t+=2){
    STEP(pB0,pB1,pA0,pA1,t,(t+3<NT),(t+1<NT),(t+1<NT));       ENDW(t);   RESC(); ROT();
    STEP(pA0,pA1,pB0,pB1,t+1,(t+4<NT),(t+2<NT),(t+2<NT));     ENDW(t+1); RESC(); ROT();
  }
  STEP(pB0,pB1,pA0,pA1,NT-1,false,false,false); RESC();
  { float sacc=pB0[0]+pB0[1]; _Pragma("unroll") for(int r=2;r<16;++r)sacc+=pB0[r]; _Pragma("unroll") for(int r=0;r<16;++r)sacc+=pB1[r]; l_reg+=sacc;
    pw0=(u32x4){PKW(pB0,0),PKW(pB0,2),PKW(pB0,4),PKW(pB0,6)};pw1=(u32x4){PKW(pB0,8),PKW(pB0,10),PKW(pB0,12),PKW(pB0,14)};pw2=(u32x4){PKW(pB1,0),PKW(pB1,2),PKW(pB1,4),PKW(pB1,6)};pw3=(u32x4){PKW(pB1,8),PKW(pB1,10),PKW(pB1,12),PKW(pB1,14)};
    SBAR(); pv(o,vb0+sl_cur,PAF(0),PAF(1),PAF(2),PAF(3)); }
  #undef PKW
  #undef PAF
  #undef VFR
  #undef PIN
  #undef MX3
  #undef GAPA
  #undef GAPB
  #undef EX
  #undef VRD
  #undef KRD
  #undef STEP
  #undef ENDW
  {auto rr=__builtin_amdgcn_permlane32_swap(__float_as_uint(l_reg),__float_as_uint(l_reg),false,false);l_reg=__uint_as_float(rr[0])+__uint_as_float(rr[1]);}
  if(hi==0)wsf[32+r32]=l_reg;asm volatile("s_waitcnt lgkmcnt(0)":::"memory");
  float rli[16];
  #pragma unroll
  for(int r=0;r<16;++r)rli[r]=__builtin_amdgcn_rcpf(wsf[32+crow(r,hi)]);
  { bf16*stg=(bf16*)(shm+LDS_OST)+wid*2048;
    if(mp==0){
      #pragma unroll
      for(int r=0;r<16;++r){const int orow=crow(r,hi);
        #pragma unroll
        for(int d0=0;d0<2;++d0)stg[orow*64+d0*32+r32]=(bf16)(cvtpk_s(o[d0][r]*rli[r],0.f)&0xffffu);}
    } else {
      #pragma unroll
      for(int r=0;r<16;++r){const int orow=crow(r,hi);
        #pragma unroll
        for(int d0=0;d0<2;++d0){const float o1=__uint_as_float(((unsigned)stg[orow*64+d0*32+r32])<<16); stg[orow*64+d0*32+r32]=(bf16)(cvtpk_s(o1-lam*(o[d0][r]*rli[r]),0.f)&0xffffu);}}
      asm volatile("s_waitcnt lgkmcnt(0)":::"memory");
      bf16*Yw=Y+(rowbase+q0+wid*QBLK)*256+h*D;
      const int ch=lane&7; const f32x4 g0=*(const f32x4*)(sg+ch*8),g1=*(const f32x4*)(sg+ch*8+4);
      #pragma unroll
      for(int i=0;i<4;++i){const int row=i*8+(lane>>3); const u32x4 v=*(const u32x4*)(stg+row*64+ch*8);
        float f[8]; f[0]=__uint_as_float(v.x<<16);f[1]=__uint_as_float(v.x&0xffff0000u);f[2]=__uint_as_float(v.y<<16);f[3]=__uint_as_float(v.y&0xffff0000u);
        f[4]=__uint_as_float(v.z<<16);f[5]=__uint_as_float(v.z&0xffff0000u);f[6]=__uint_as_float(v.w<<16);f[7]=__uint_as_float(v.w&0xffff0000u);
        float ss=(f[0]*f[0]+f[1]*f[1])+(f[2]*f[2]+f[3]*f[3])+(f[4]*f[4]+f[5]*f[5])+(f[6]*f[6]+f[7]*f[7]);
        ss+=__shfl_xor(ss,1);ss+=__shfl_xor(ss,2);ss+=__shfl_xor(ss,4);
        const float rs=__builtin_amdgcn_rsqf(ss*(1.f/64.f)+1e-5f)*osc;
        u32x4 w; w.x=cvtpk_s(f[0]*rs*g0[0],f[1]*rs*g0[1]); w.y=cvtpk_s(f[2]*rs*g0[2],f[3]*rs*g0[3]); w.z=cvtpk_s(f[4]*rs*g1[0],f[5]*rs*g1[1]); w.w=cvtpk_s(f[6]*rs*g1[2],f[7]*rs*g1[3]);
        *(u32x4*)(Yw+(long)row*256+ch*8)=w;}
    } }
  asm volatile("s_waitcnt lgkmcnt(0)\n\ts_barrier":::"memory");
  #undef DMA_K
  #undef DMA_V
  #undef CMASK
  #undef START
  #undef RESC
  #undef ROT
}
constexpr int ATTN_LDS_BYTES=LDS_BYTES;
#undef SBAR
#undef WAIT_BAR
}
#define GAS __attribute__((address_space(1)))
#define LAS __attribute__((address_space(3)))
typedef unsigned short bf16;
typedef unsigned v4u __attribute__((ext_vector_type(4)));
typedef float f32x4 __attribute__((ext_vector_type(4)));
typedef short bf16x8 __attribute__((ext_vector_type(8)));
typedef GAS unsigned gu32;
typedef GAS unsigned long long gu64;
#define RLX_AGENT __ATOMIC_RELAXED, __HIP_MEMORY_SCOPE_AGENT
#define LDS_WAIT() asm volatile("s_waitcnt lgkmcnt(0)" ::: "memory")
#define VM_WAIT() asm volatile("s_waitcnt vmcnt(0)" ::: "memory")
__device__ __forceinline__ unsigned long long rt() { return __builtin_amdgcn_s_memrealtime(); }
__device__ __forceinline__ unsigned f2bf(float f) { unsigned u = __builtin_bit_cast(unsigned, f); return (u + 0x7fffu + ((u >> 16) & 1u)) >> 16; }
__device__ __forceinline__ unsigned pk2(float lo, float hi) { return f2bf(lo) | (f2bf(hi) << 16); }

#define XB_TMO      128
#define XB_XCNT(j)  (256  + 64 * (j))
#define XB_XSUB(j)  (1280 + 64 * (j))
#define XB_XGEN(j)  (2304 + 64 * (j))
#define XB_TOP      3328
#define XB_TOPGEN   3392
#define XCD_BAR_WORDS 3456
#define XB_SPIN_CAP (1u << 18)

__device__ __forceinline__ unsigned xb_ld(unsigned* p)              { return __hip_atomic_load(p, __ATOMIC_RELAXED, __HIP_MEMORY_SCOPE_AGENT); }
__device__ __forceinline__ unsigned xb_add(unsigned* p, unsigned v) { return __hip_atomic_fetch_add(p, v, __ATOMIC_RELAXED, __HIP_MEMORY_SCOPE_AGENT); }
__device__ __forceinline__ unsigned xb_xcc_id() { return (unsigned)__builtin_amdgcn_s_getreg((3 << 11) | 20) & 0xFu; }
#define XB_SPIN(cond, bar) do { unsigned _sp = 0; while (cond) { __builtin_amdgcn_s_sleep(1); \
    if ((++_sp & 255u) == 0u) { if (xb_ld(&(bar)[XB_TMO])) break; if (_sp > XB_SPIN_CAP) { atomicAdd(&(bar)[XB_TMO], 1u); break; } } } } while (0)

struct XcdBarrier {
    unsigned* bar; unsigned x;
    unsigned G;
    int wave;
    volatile LAS unsigned* st;
};

__device__ __forceinline__ int xb_lane_id() { int l; asm volatile("v_mbcnt_lo_u32_b32 %0, -1, 0\n\tv_mbcnt_hi_u32_b32 %0, -1, %0" : "=v"(l)); return l; }
__device__ __forceinline__ bool xb_thread0(int wave) { return wave == 0 && xb_lane_id() == 0; }
__device__ __forceinline__ XcdBarrier xcd_barrier_post(unsigned* bar, volatile LAS unsigned* st, int wave) {
    XcdBarrier b; b.bar = bar; b.x = xb_xcc_id(); b.st = st; b.wave = wave; b.G = gridDim.x * gridDim.y * gridDim.z;
    if (xb_thread0(wave)) (void)xb_add(&bar[XB_XCNT(b.x)], 1u);
    return b;
}
__device__ __forceinline__ void xcd_barrier_complete(unsigned* bar, unsigned x, unsigned G, unsigned& nloc, unsigned& nx) {
    unsigned sum, cnt, mine, sp = 0u;
    for (;;) {
        sum = 0u; cnt = 0u; mine = 0u;
#pragma unroll
        for (unsigned j = 0; j < 16; ++j) { const unsigned c = xb_ld(&bar[XB_XCNT(j)]); sum += c; cnt += (c > 0u) ? 1u : 0u; }
        mine = xb_ld(&bar[XB_XCNT(x)]);
        if (sum == G) break;
        __builtin_amdgcn_s_sleep(1);
        if ((++sp & 255u) == 0u) { if (xb_ld(&bar[XB_TMO])) break; if (sp > XB_SPIN_CAP) { atomicAdd(&bar[XB_TMO], 1u); break; } }
    }
    nloc = mine > 0u ? mine : 1u; nx = cnt > 0u ? cnt : 1u;
}

__device__ __forceinline__ void xcd_barrier(const XcdBarrier& b) {
    asm volatile("s_waitcnt vmcnt(0)" ::: "memory");
    __syncthreads();
    if (xb_thread0(b.wave)) {
        GAS unsigned* barg = (GAS unsigned*)b.bar; asm volatile("" : "+s"(barg)); unsigned* bar = (unsigned*)barg; const unsigned bx_ = xb_xcc_id();
        __builtin_amdgcn_s_waitcnt(0);
        unsigned nloc = b.st[0], nx = b.st[1];
        if (nloc == 0u) { xcd_barrier_complete(bar, bx_, b.G, nloc, nx); b.st[0] = nloc; b.st[1] = nx; }
        const unsigned old = xb_add(&bar[XB_XSUB(bx_)], 1u);
        const unsigned gen = old / nloc;
        if (old + 1u == (gen + 1u) * nloc) {
            __builtin_amdgcn_fence(__ATOMIC_RELEASE, "agent");
            asm volatile("s_waitcnt vmcnt(0)" ::: "memory");
            const unsigned og = xb_add(&bar[XB_TOP], 1u);
            const unsigned tg = og / nx;
            if (og + 1u == (tg + 1u) * nx) xb_add(&bar[XB_TOPGEN], 1u);
            else XB_SPIN(xb_ld(&bar[XB_TOPGEN]) == tg, bar);
            __builtin_amdgcn_fence(__ATOMIC_ACQUIRE, "agent");
            xb_add(&bar[XB_XGEN(bx_)], 1u);
            asm volatile("s_waitcnt vmcnt(0)" ::: "memory");
        } else {
            XB_SPIN(xb_ld(&bar[XB_XGEN(bx_)]) == gen, bar);
            __builtin_amdgcn_fence(__ATOMIC_ACQUIRE, "agent");
            asm volatile("s_waitcnt vmcnt(0)" ::: "memory");
        }
    }
    __syncthreads();
}
constexpr size_t KiB = 1u << 10, MiB = 1u << 20;
constexpr size_t WS_CTL = 0, CTL_ZERO_BYTES = 64 * KiB;
constexpr size_t TB_ROPEC = 1 * MiB, TB_ROPES = TB_ROPEC + 256 * KiB;
constexpr size_t TB_PWT = TB_ROPES + 256 * KiB;
constexpr size_t TB_SGW = TB_PWT + 64 * KiB;
constexpr size_t TB_HIST = TB_SGW + 256 * KiB;
constexpr size_t TB_TOKC = TB_HIST + 32 * KiB;
constexpr size_t TB_TOKW = TB_TOKC + 128 * KiB;
constexpr size_t TB_ROWTOK = TB_TOKW + 256 * KiB;
constexpr size_t TB_ROWW = TB_ROWTOK + 160 * KiB;
static_assert(TB_ROWW + 320 * KiB <= 3 * MiB, "tables");
constexpr size_t W_IN = 3 * MiB;
constexpr size_t W_B = W_IN + (size_t)NIN * DMODEL * 2;
constexpr size_t W_O = W_B + 2 * MiB;
constexpr size_t W_GU = W_O + 2 * MiB;
constexpr size_t W_D = W_GU + 16 * MiB;
static_assert(W_D + 8 * MiB <= 44 * MiB, "weights");
constexpr size_t WS_XB = 44 * MiB;
constexpr size_t WS_X = 108 * MiB;
constexpr size_t WS_QKY = 236 * MiB;
constexpr size_t WS_QP = WS_QKY, WS_KP = WS_QKY + 32 * MiB, WS_YA = WS_QKY + 64 * MiB;
constexpr size_t WS_P = 364 * MiB;
constexpr size_t WS_MG = WS_P, WS_XS = WS_P, WS_HB = WS_P + 80 * MiB;
constexpr size_t WS_END = 508 * MiB;
static_assert(WS_P + (size_t)M * NPB * 2 <= WS_END && WS_HB + (size_t)MAXROWS * 512 * 2 <= WS_END && WS_XS + (size_t)MAXROWS * 1024 * 2 <= WS_HB, "d_ws map");
constexpr int CW_TMO = 0, CW_BAR = 4096;
constexpr int RING_OFF = 0, RING_BYTES = 131072;
constexpr int LDSCTL_OFF = RING_BYTES, MISC_OFF = LDSCTL_OFF + 320, LDSX_OFF = LDSCTL_OFF + 1024;
constexpr int LDS_BYTES = 147456;
constexpr int NWAVES = 8;
constexpr int NPHASE = 1 + 10 * DEPTH;

struct Frame {
    LAS unsigned char* lds;
    gu32* ctl;
    int tid, lane, wave, vcu, G, bx;
    float* out; unsigned char* ws;
};
typedef const GAS float* cgfptr_t;
__device__ __forceinline__ const float* arg_in(int k) {
    const __attribute__((address_space(4))) char* ka = (const __attribute__((address_space(4))) char*)__builtin_amdgcn_kernarg_segment_ptr();
    asm volatile("" : "+s"(ka));
    const GAS float* p = *(const __attribute__((address_space(4))) cgfptr_t*)(ka + 8 * k);
    return (const float*)p;
}
__device__ __forceinline__ float wave_sum(float v) {
#pragma unroll
    for (int o = 1; o < 64; o <<= 1) v += __shfl_xor(v, o);
    return v;
}
__device__ __forceinline__ unsigned cvtpk(float lo, float hi) { unsigned r; asm volatile("v_cvt_pk_bf16_f32 %0, %1, %2" : "=v"(r) : "v"(lo), "v"(hi)); return r; }
__device__ __forceinline__ float bflo(unsigned w) { return __uint_as_float(w << 16); }
__device__ __forceinline__ float bfhi(unsigned w) { return __uint_as_float(w & 0xffff0000u); }
typedef float f32x2g __attribute__((ext_vector_type(2)));
typedef unsigned u32x2g __attribute__((ext_vector_type(2)));

__device__ __forceinline__ void transpose_item(const float* W, int N, bf16* WT, int ldt, int dst_row0, int k0, int n0, LAS float* scr, int lane) {
#pragma unroll 8
    for (int i = 0; i < 32; ++i) { const int kk = 2 * i + (lane >> 5); scr[kk * 33 + (lane & 31)] = W[(size_t)(k0 + kk) * N + n0 + (lane & 31)]; }
    LDS_WAIT(); asm volatile("" ::: "memory");
    const int c = lane & 7;
#pragma unroll
    for (int j = 0; j < 4; ++j) { const int n = (lane >> 3) + 8 * j; const LAS float* s = scr + (8 * c) * 33 + n;
        v4u o; o.x = pk2(s[0 * 33], s[1 * 33]); o.y = pk2(s[2 * 33], s[3 * 33]); o.z = pk2(s[4 * 33], s[5 * 33]); o.w = pk2(s[6 * 33], s[7 * 33]);
        *(v4u*)(WT + (size_t)(dst_row0 + n) * ldt + k0 + 8 * c) = o; }
    LDS_WAIT(); asm volatile("" ::: "memory");
}
__device__ __forceinline__ void convert_weights(Frame& F, int l) {
    LAS float* scr = (LAS float*)(F.lds + RING_OFF + F.wave * 16384);
    const int gw = F.vcu * NWAVES + F.wave, NGW = F.G * NWAVES;
    bf16* Win = (bf16*)(F.ws + W_IN); bf16* Wb = (bf16*)(F.ws + W_B); bf16* Wo = (bf16*)(F.ws + W_O); bf16* Wgu = (bf16*)(F.ws + W_GU); bf16* Wd = (bf16*)(F.ws + W_D);
    constexpr int I_IN = 16 * 200, I_B = 512, I_O = 512, I_G = 2048, I_D = 2048, NITEMS = I_IN + I_B + I_O + 2 * I_G + I_D;
    for (int it = gw; it < NITEMS; it += NGW) {
        int r = it;
        if (r < I_IN) { const int kb = r / 200, nb = r % 200; transpose_item(arg_in(1) + (size_t)l * DMODEL * NIN, NIN, Win, DMODEL, 32 * nb, 64 * kb, 32 * nb, scr, F.lane); continue; } r -= I_IN;
        if (r < I_B) { const int br = r >> 7, q = r & 127, kb = q >> 5, nb = q & 31; transpose_item(arg_in(14) + (size_t)(l * 4 + br) * 256 * DMODEL, DMODEL, Wb + (size_t)br * DMODEL * 256, 256, 32 * nb, 64 * kb, 32 * nb, scr, F.lane); continue; } r -= I_B;
        if (r < I_O) { const int kb = r >> 5, nb = r & 31; transpose_item(arg_in(15) + (size_t)l * DMODEL * DMODEL, DMODEL, Wo, DMODEL, 32 * nb, 64 * kb, 32 * nb, scr, F.lane); continue; } r -= I_O;
        if (r < 2 * I_G) { const int up = r >= I_G; if (up) r -= I_G; const int e = r >> 7, q = r & 127, kb = q >> 3, nb = q & 7, n0 = 32 * nb;
            transpose_item((up ? arg_in(23) : arg_in(22)) + (size_t)(l * 16 + e) * DMODEL * 256, 256, Wgu + (size_t)e * 512 * DMODEL, DMODEL, 256 * (n0 >> 7) + (n0 & 127) + (up ? 128 : 0), 64 * kb, n0, scr, F.lane); continue; } r -= 2 * I_G;
        { const int e = r >> 7, q = r & 127, kb = q >> 5, nb = q & 31; transpose_item(arg_in(24) + (size_t)(l * 16 + e) * 256 * DMODEL, DMODEL, Wd + (size_t)e * DMODEL * 256, 256, 32 * nb, 64 * kb, 32 * nb, scr, F.lane); }
    }
}
__device__ __forceinline__ void p0_prologue(Frame& F) {
    convert_weights(F, 0);
    const int gt = F.vcu * 512 + F.tid, NT = F.G * 512;
    { const float* x = arg_in(0); bf16* xb = (bf16*)(F.ws + WS_XB);
      for (int i = gt; i < M * DMODEL / 8; i += NT) { const f32x4 a = *(const f32x4*)(x + (size_t)i * 8), b = *(const f32x4*)(x + (size_t)i * 8 + 4);
          v4u o; o.x = cvtpk(a[0], a[1]); o.y = cvtpk(a[2], a[3]); o.z = cvtpk(b[0], b[1]); o.w = cvtpk(b[2], b[3]); *(v4u*)(xb + (size_t)i * 8) = o; } }
    { float* rc = (float*)(F.ws + TB_ROPEC); float* rs = (float*)(F.ws + TB_ROPES);
      for (int i = gt; i < SEQ * 16; i += NT) { const int pos = i >> 4, j = i & 15;
          const float inv = (float)exp2(-(double)j * (13.287712379549449 / 16.0)); const float ang = (float)pos * inv;
          const double a = (double)ang; const double k = rint(a * 0.15915494309189535); const float r = (float)(a - k * 6.283185307179586);
          rc[i] = cosf(r); rs[i] = sinf(r); } }
    { bf16* pwt = (bf16*)(F.ws + TB_PWT); const float* pw = arg_in(2);
      for (int i = gt; i < 2 * 4 * 64 * 64; i += NT) { const int c = i & 63, d = (i >> 6) & 63, lg = i >> 12; pwt[i] = (bf16)f2bf(pw[(size_t)lg * 4096 + c * 64 + d]); }
      bf16* sgw = (bf16*)(F.ws + TB_SGW); const float* sw = arg_in(12);
      for (int i = gt; i < 2 * 4 * 128 * 128; i += NT) { const int s = i & 127, t = (i >> 7) & 127; sgw[i] = (s <= t) ? (bf16)f2bf(sw[i]) : (bf16)0; } }
}

constexpr int VTP = 136;
__device__ __forceinline__ void prep_unit(Frame& F, int ch, int l) {
    const bf16* P = (const bf16*)(F.ws + WS_P);
    int tid = F.tid; asm volatile("" : "+v"(tid)); const int row0 = ch * 128, pos0 = (ch & 31) * 128, lane = tid & 63, wave = F.wave;
    { bf16* Qp = (bf16*)(F.ws + WS_QP); bf16* Kp = (bf16*)(F.ws + WS_KP); const float* rc = (const float*)(F.ws + TB_ROPEC); const float* rs = (const float*)(F.ws + TB_ROPES);
      for (int it = tid; it < 4096; it += 512) { const int r = it >> 5, q = it & 31, qk = q >> 4, vh = (q >> 1) & 7, jh = q & 1; const int row = row0 + r, pos = pos0 + r;
          const bf16* src = P + (size_t)row * NPB + PC_Q + qk * 256 + vh * 32 + jh * 8;
          const v4u a = *(const v4u*)src, b = *(const v4u*)(src + 16);
          const f32x4 c0 = *(const f32x4*)(rc + pos * 16 + jh * 8), c1 = *(const f32x4*)(rc + pos * 16 + jh * 8 + 4), s0 = *(const f32x4*)(rs + pos * 16 + jh * 8), s1 = *(const f32x4*)(rs + pos * 16 + jh * 8 + 4);
          const float x1[8] = {bflo(a.x), bfhi(a.x), bflo(a.y), bfhi(a.y), bflo(a.z), bfhi(a.z), bflo(a.w), bfhi(a.w)};
          const float x2[8] = {bflo(b.x), bfhi(b.x), bflo(b.y), bfhi(b.y), bflo(b.z), bfhi(b.z), bflo(b.w), bfhi(b.w)};
          const float cc[8] = {c0[0], c0[1], c0[2], c0[3], c1[0], c1[1], c1[2], c1[3]}, ss[8] = {s0[0], s0[1], s0[2], s0[3], s1[0], s1[1], s1[2], s1[3]};
          const float sc = qk ? 1.0f : attn_body::C2; float o1[8], o2[8];
#pragma unroll
          for (int e = 0; e < 8; ++e) { o1[e] = (x1[e] * cc[e] - x2[e] * ss[e]) * sc; o2[e] = (x2[e] * cc[e] + x1[e] * ss[e]) * sc; }
          bf16* dst = (qk ? Kp : Qp) + (size_t)row * 512 + vh * 64 + jh * 8;
          v4u w; w.x = cvtpk(o1[0], o1[1]); w.y = cvtpk(o1[2], o1[3]); w.z = cvtpk(o1[4], o1[5]); w.w = cvtpk(o1[6], o1[7]); *(v4u*)dst = w;
          w.x = cvtpk(o2[0], o2[1]); w.y = cvtpk(o2[2], o2[3]); w.z = cvtpk(o2[4], o2[5]); w.w = cvtpk(o2[6], o2[7]); *(v4u*)(dst + 16) = w;
          const v4u z = (v4u){0u, 0u, 0u, 0u}; *(v4u*)(dst - jh * 8 + 32 + jh * 16) = z; *(v4u*)(dst - jh * 8 + 40 + jh * 16) = z; } }
    { bf16* YB = (bf16*)(F.ws + WS_YA) + (size_t)1 * M * 256; const float* cw = arg_in(4) + (size_t)l * 3 * 256;
      for (int it = tid; it < 4096; it += 512) { const int r = it >> 5, c8 = (it & 31) * 8; const int row = row0 + r, pos = pos0 + r; const bf16* pr = P + (size_t)row * NPB;
          const v4u gb = *(const v4u*)(pr + PC_GB + c8); float z[3][8];
#pragma unroll
          for (int j = 0; j < 3; ++j) { if (pos - j >= 0) { const v4u gc = *(const v4u*)(pr - (size_t)j * NPB + PC_GC + c8), hh = *(const v4u*)(pr - (size_t)j * NPB + PC_H + c8);
                  z[j][0] = bflo(gc.x) * bflo(hh.x); z[j][1] = bfhi(gc.x) * bfhi(hh.x); z[j][2] = bflo(gc.y) * bflo(hh.y); z[j][3] = bfhi(gc.y) * bfhi(hh.y);
                  z[j][4] = bflo(gc.z) * bflo(hh.z); z[j][5] = bfhi(gc.z) * bfhi(hh.z); z[j][6] = bflo(gc.w) * bflo(hh.w); z[j][7] = bfhi(gc.w) * bfhi(hh.w); }
              else {
#pragma unroll
                  for (int e = 0; e < 8; ++e) z[j][e] = 0.f; } }
          const float gbf[8] = {bflo(gb.x), bfhi(gb.x), bflo(gb.y), bfhi(gb.y), bflo(gb.z), bfhi(gb.z), bflo(gb.w), bfhi(gb.w)}; float o[8];
#pragma unroll
          for (int e = 0; e < 8; ++e) o[e] = gbf[e] * (cw[c8 + e] * z[2][e] + cw[256 + c8 + e] * z[1][e] + cw[512 + c8 + e] * z[0][e]);
          v4u w; w.x = cvtpk(o[0], o[1]); w.y = cvtpk(o[2], o[3]); w.z = cvtpk(o[4], o[5]); w.w = cvtpk(o[6], o[7]); *(v4u*)(YB + (size_t)row * 256 + c8) = w; } }
    LAS bf16* VT = (LAS bf16*)(F.lds + RING_OFF);
    { const float* lg = arg_in(10) + l * 256; const float* lb = arg_in(11) + l * 256; const f32x4 g4 = *(const f32x4*)(lg + 4 * lane), b4 = *(const f32x4*)(lb + 4 * lane);
      for (int i = 0; i < 16; ++i) { const int r = wave * 16 + i; const u32x2g v = *(const u32x2g*)(P + (size_t)(row0 + r) * NPB + PC_VV + 4 * lane);
          float f[4] = {bflo(v.x), bfhi(v.x), bflo(v.y), bfhi(v.y)};
          const float mean = wave_sum((f[0] + f[1]) + (f[2] + f[3])) * (1.f / 256.f);
#pragma unroll
          for (int e = 0; e < 4; ++e) f[e] -= mean;
          const float rstd = __builtin_amdgcn_rsqf(wave_sum((f[0] * f[0] + f[1] * f[1]) + (f[2] * f[2] + f[3] * f[3])) * (1.f / 256.f) + LN_EPS);
#pragma unroll
          for (int e = 0; e < 4; ++e) VT[(4 * lane + e) * VTP + r] = (bf16)f2bf(f[e] * rstd * g4[e] + b4[e]); } }
    LDS_WAIT(); __syncthreads();
    const int r32 = lane & 31, hi = lane >> 5;
    { const int g = wave >> 1, cb = wave & 1; const bf16* sgw = (const bf16*)(F.ws + TB_SGW) + (size_t)(l * 4 + g) * 128 * 128; const float* sb = arg_in(13) + (size_t)(l * 4 + g) * 128;
      bf16* YD = (bf16*)(F.ws + WS_YA) + (size_t)3 * M * 256;
      for (int tb = 0; tb < 4; ++tb) { attn_body::f32x16 acc = {};
          for (int ks = 0; ks < 2 * (tb + 1); ++ks) { const bf16x8 a = *(const LAS bf16x8*)(VT + (64 * g + 32 * cb + r32) * VTP + 16 * ks + 8 * hi);
              const bf16x8 b = *(const bf16x8*)(sgw + (size_t)(32 * tb + r32) * 128 + 16 * ks + 8 * hi);
              acc = __builtin_amdgcn_mfma_f32_32x32x16_bf16(a, b, acc, 0, 0, 0); }
          const int t = 32 * tb + r32; const float bias = sb[t]; const size_t row = (size_t)(row0 + t);
#pragma unroll
          for (int q4 = 0; q4 < 4; ++q4) { const int c0 = 64 * g + 32 * cb + 8 * q4 + 4 * hi; const u32x2g u = *(const u32x2g*)(P + row * NPB + PC_U + c0);
              u32x2g w; w.x = cvtpk(bflo(u.x) * (acc[4 * q4 + 0] + bias), bfhi(u.x) * (acc[4 * q4 + 1] + bias)); w.y = cvtpk(bflo(u.y) * (acc[4 * q4 + 2] + bias), bfhi(u.y) * (acc[4 * q4 + 3] + bias));
              *(u32x2g*)(YD + row * 256 + c0) = w; } } }
    { const bf16* pwt = (const bf16*)(F.ws + TB_PWT) + (size_t)l * 4 * 4096; const float* psc = arg_in(3) + l * 256; bf16* YA = (bf16*)(F.ws + WS_YA);
      for (int it = wave; it < 16; it += 8) { const int tb = it >> 2, g = it & 3, win = 2 << g; const int t = 32 * tb + r32, pos = pos0 + t; const size_t row = (size_t)(row0 + t);
          const int cnt = (pos + 1 < win) ? pos + 1 : win; const float rcnt = 1.0f / (float)cnt;
          attn_body::f32x16 acc0 = {}, acc1 = {};
#pragma unroll
          for (int ks = 0; ks < 4; ++ks) { const bf16* src = P + row * NPB + PC_POOL + 64 * g + 16 * ks + 8 * hi; float s[8], a0[8];
              { const v4u v = *(const v4u*)src; a0[0] = bflo(v.x); a0[1] = bfhi(v.x); a0[2] = bflo(v.y); a0[3] = bfhi(v.y); a0[4] = bflo(v.z); a0[5] = bfhi(v.z); a0[6] = bflo(v.w); a0[7] = bfhi(v.w); }
#pragma unroll
              for (int e = 0; e < 8; ++e) s[e] = a0[e];
              for (int j = 1; j < cnt; ++j) { const v4u v = *(const v4u*)(src - (size_t)j * NPB);
                  s[0] += bflo(v.x); s[1] += bfhi(v.x); s[2] += bflo(v.y); s[3] += bfhi(v.y); s[4] += bflo(v.z); s[5] += bfhi(v.z); s[6] += bflo(v.w); s[7] += bfhi(v.w); }
              v4u dw; dw.x = cvtpk(s[0] * rcnt - a0[0], s[1] * rcnt - a0[1]); dw.y = cvtpk(s[2] * rcnt - a0[2], s[3] * rcnt - a0[3]); dw.z = cvtpk(s[4] * rcnt - a0[4], s[5] * rcnt - a0[5]); dw.w = cvtpk(s[6] * rcnt - a0[6], s[7] * rcnt - a0[7]);
              const bf16x8 dfr = __builtin_bit_cast(bf16x8, dw);
              const bf16x8 w0 = *(const bf16x8*)(pwt + (size_t)g * 4096 + (size_t)r32 * 64 + 16 * ks + 8 * hi), w1 = *(const bf16x8*)(pwt + (size_t)g * 4096 + (size_t)(32 + r32) * 64 + 16 * ks + 8 * hi);
              acc0 = __builtin_amdgcn_mfma_f32_32x32x16_bf16(w0, dfr, acc0, 0, 0, 0); acc1 = __builtin_amdgcn_mfma_f32_32x32x16_bf16(w1, dfr, acc1, 0, 0, 0); }
#pragma unroll
          for (int q4 = 0; q4 < 4; ++q4) { const int c0 = 64 * g + 8 * q4 + 4 * hi; const f32x4 p0 = *(const f32x4*)(psc + c0), p1 = *(const f32x4*)(psc + c0 + 32);
              u32x2g w; w.x = cvtpk(acc0[4 * q4 + 0] * p0[0], acc0[4 * q4 + 1] * p0[1]); w.y = cvtpk(acc0[4 * q4 + 2] * p0[2], acc0[4 * q4 + 3] * p0[3]); *(u32x2g*)(YA + row * 256 + c0) = w;
              w.x = cvtpk(acc1[4 * q4 + 0] * p1[0], acc1[4 * q4 + 1] * p1[1]); w.y = cvtpk(acc1[4 * q4 + 2] * p1[2], acc1[4 * q4 + 3] * p1[3]); *(u32x2g*)(YA + row * 256 + c0 + 32) = w; } } }
    __syncthreads();
}

__device__ __forceinline__ void route_phase(Frame& F, int l) {
    int tid = F.tid; asm volatile("" : "+v"(tid)); float* HX = F.out; bf16* XB = (bf16*)(F.ws + WS_XB); const int lane = tid & 63, wave = F.wave;
    LAS float* Wrg = (LAS float*)(F.lds + RING_OFF); LAS float* Wre = Wrg + 4096;
    LAS int* cc = (LAS int*)(F.lds + LDSCTL_OFF + 224);
    { const float* wrg = arg_in(18) + (size_t)l * 4096; const float* wre = arg_in(20) + (size_t)l * 16384;
      for (int i = tid; i < 1024; i += 512) *(LAS f32x4*)(Wrg + 4 * i) = *(const f32x4*)(wrg + 4 * i);
      for (int i = tid; i < 4096; i += 512) *(LAS f32x4*)(Wre + 4 * i) = *(const f32x4*)(wre + 4 * i); }
    const float* g1 = arg_in(16) + l * DMODEL; const float* b1 = arg_in(17) + l * DMODEL; const float* brg = arg_in(19) + l * 4; const float* bre = arg_in(21) + l * 16;
    int* hist = (int*)(F.ws + TB_HIST); int* tokc = (int*)(F.ws + TB_TOKC); f32x2g* tokw = (f32x2g*)(F.ws + TB_TOKW);
    for (int rg = F.vcu; rg < M / 128; rg += F.G) {
        if (tid < NCLS) cc[tid] = 0;
        LDS_WAIT(); __syncthreads();
        for (int i = 0; i < 16; ++i) { const size_t row = (size_t)rg * 128 + wave * 16 + i; float* hr = HX + row * DMODEL;
            f32x4 v[4]; float s = 0.f;
#pragma unroll
            for (int j = 0; j < 4; ++j) { v[j] = *(const f32x4*)(hr + 4 * lane + 256 * j); s += (v[j][0] + v[j][1]) + (v[j][2] + v[j][3]); }
            const float mean = wave_sum(s) * (1.f / DMODEL); float s2 = 0.f;
#pragma unroll
            for (int j = 0; j < 4; ++j) { v[j] = v[j] - mean; s2 += (v[j][0] * v[j][0] + v[j][1] * v[j][1]) + (v[j][2] * v[j][2] + v[j][3] * v[j][3]); }
            const float rstd = 1.f / sqrtf(wave_sum(s2) * (1.f / DMODEL) + LN_EPS);
            f32x4 gl = {0.f, 0.f, 0.f, 0.f};
#pragma unroll
            for (int j = 0; j < 4; ++j) { const f32x4 gg = *(const f32x4*)(g1 + 4 * lane + 256 * j), bb = *(const f32x4*)(b1 + 4 * lane + 256 * j); v[j] = v[j] * rstd * gg + bb;
                *(f32x4*)(hr + 4 * lane + 256 * j) = v[j];
                u32x2g w; w.x = cvtpk(v[j][0], v[j][1]); w.y = cvtpk(v[j][2], v[j][3]); *(u32x2g*)(XB + row * DMODEL + 4 * lane + 256 * j) = w;
#pragma unroll
                for (int e = 0; e < 4; ++e) gl += *(const LAS f32x4*)(Wrg + 4 * (4 * lane + 256 * j + e)) * v[j][e]; }
#pragma unroll
            for (int e = 0; e < 4; ++e) gl[e] = wave_sum(gl[e]) + brg[e];
            int gs = 0; float gm = gl[0];
#pragma unroll
            for (int e = 1; e < 4; ++e) if (gl[e] > gm) { gm = gl[e]; gs = e; }
            const float psel = 1.0f / ((expf(gl[0] - gm) + expf(gl[1] - gm)) + (expf(gl[2] - gm) + expf(gl[3] - gm)));
            gs = __builtin_amdgcn_readfirstlane(gs);
            f32x4 el = {0.f, 0.f, 0.f, 0.f}; const LAS float* wre = Wre + gs * 4096;
#pragma unroll
            for (int j = 0; j < 4; ++j)
#pragma unroll
                for (int e = 0; e < 4; ++e) el += *(const LAS f32x4*)(wre + 4 * (4 * lane + 256 * j + e)) * v[j][e];
#pragma unroll
            for (int e = 0; e < 4; ++e) el[e] = wave_sum(el[e]) + bre[gs * 4 + e];
            int i1 = 0; float v1 = el[0];
#pragma unroll
            for (int e = 1; e < 4; ++e) if (el[e] > v1) { v1 = el[e]; i1 = e; }
            int i2 = -1; float v2 = 0.f;
#pragma unroll
            for (int e = 0; e < 4; ++e) if (e != i1 && (i2 < 0 || el[e] > v2)) { v2 = el[e]; i2 = e; }
            const float w1 = psel / (1.0f + expf(v2 - v1)), w2 = psel - w1;
            const int ea = i1 < i2 ? i1 : i2, eb = i1 < i2 ? i2 : i1; const float wa = i1 < i2 ? w1 : w2, wb = i1 < i2 ? w2 : w1;
            const int pair = (ea == 0) ? (eb - 1) : (ea == 1) ? (eb + 1) : 5; const int cls = gs * 6 + pair;
            if (lane == 0) { const int lr = atomicAdd((int*)(cc + cls), 1); tokc[row] = cls * 256 + lr; tokw[row] = (f32x2g){wa, wb}; }
        }
        LDS_WAIT(); __syncthreads();
        if (tid < 32) hist[rg * 32 + tid] = (tid < NCLS) ? cc[tid] : 0;
        __syncthreads();
    }
}
__device__ __forceinline__ void moe_tables(Frame& F) {
    LAS int* cb = (LAS int*)(F.lds + LDSCTL_OFF); LAS int* tot = (LAS int*)(F.lds + LDSCTL_OFF + 128); const int* hist = (const int*)(F.ws + TB_HIST);
    if (F.tid < NCLS) { int s = 0; for (int rg = 0; rg < M / 128; ++rg) s += hist[rg * 32 + F.tid]; tot[F.tid] = s; }
    LDS_WAIT(); __syncthreads();
    if (F.tid == 0) { int b = 0; for (int c = 0; c < NCLS; ++c) { cb[c] = b; b += (tot[c] + 255) & ~255; } cb[NCLS] = b; }
    LDS_WAIT(); __syncthreads();
}
__device__ __forceinline__ void gather_phase(Frame& F) {
    moe_tables(F);
    LAS int* cb = (LAS int*)(F.lds + LDSCTL_OFF); LAS int* tot = (LAS int*)(F.lds + LDSCTL_OFF + 128); LAS int* base = (LAS int*)(F.lds + LDSX_OFF);
    const int* hist = (const int*)(F.ws + TB_HIST); const int* tokc = (const int*)(F.ws + TB_TOKC); const f32x2g* tokw = (const f32x2g*)(F.ws + TB_TOKW);
    int* rowtok = (int*)(F.ws + TB_ROWTOK); f32x2g* roww = (f32x2g*)(F.ws + TB_ROWW); const bf16* XB = (const bf16*)(F.ws + WS_XB); bf16* XS = (bf16*)(F.ws + WS_XS);
    for (int rg = F.vcu; rg < M / 128; rg += F.G) {
        if (F.tid < NCLS) { int s = 0; for (int q = 0; q < rg; ++q) s += hist[q * 32 + F.tid]; base[F.tid] = cb[F.tid] + s; }
        LDS_WAIT(); __syncthreads();
        for (int i = 0; i < 16; ++i) { const int row = rg * 128 + F.wave * 16 + i; const int tc = tokc[row]; const int dest = base[tc >> 8] + (tc & 255);
            const v4u a = *(const v4u*)(XB + (size_t)row * DMODEL + 8 * F.lane), b = *(const v4u*)(XB + (size_t)row * DMODEL + 512 + 8 * F.lane);
            *(v4u*)(XS + (size_t)dest * DMODEL + 8 * F.lane) = a; *(v4u*)(XS + (size_t)dest * DMODEL + 512 + 8 * F.lane) = b;
            if (F.lane == 0) { rowtok[dest] = row; roww[dest] = tokw[row]; } }
        if (rg < NCLS) { const int c = rg, lo = cb[c] + tot[c], hi = cb[c + 1]; for (int p = lo + F.tid; p < hi; p += 512) rowtok[p] = -1; }
        __syncthreads();
    }
}
__device__ __forceinline__ int cls_of_rowtile(const LAS int* cb, int rt) { int c = 0; for (int q = 1; q < NCLS; ++q) c += (__builtin_amdgcn_readfirstlane(cb[q]) <= rt * 256) ? 1 : 0; return c; }
__device__ __forceinline__ void cls_experts(int cls, int& e1, int& e2) { const int g = cls / 6, p = cls % 6; const int a = p < 3 ? 0 : (p < 5 ? 1 : 2), b = p < 3 ? p + 1 : (p < 5 ? p - 1 : 3); e1 = g * 4 + a; e2 = g * 4 + b; }
struct MoeUpOrder {
    const char* A; const char* B; const LAS int* cb; int G, c;
    __device__ __forceinline__ bool next(int i, pg8::Unit& u) const {
        const int L = i * G + c, nrt = __builtin_amdgcn_readfirstlane(cb[NCLS]) >> 8; if (L >= nrt * 4) return false;
        const int rt = L >> 2, j = L & 3, half = j >> 1, jj = j & 1; int e1, e2; cls_experts(cls_of_rowtile(cb, rt), e1, e2);
        u.pm = rt; u.pn = (half ? e2 : e1) * 2 + jj; u.x = half * 256 + jj * 128; u.y = half; return true; }
    __device__ __forceinline__ const char* aptr(const pg8::Unit& u) const { return A + (size_t)u.pm * (256 * 1024 * 2); }
    __device__ __forceinline__ const char* bptr(const pg8::Unit& u, int t) const { return B + (size_t)u.pn * (256 * 1024 * 2) + (size_t)t * 128; }
};
struct MoeDownOrder {
    const char* A; const char* B; const LAS int* cb; int G, c;
    __device__ __forceinline__ bool next(int i, pg8::Unit& u) const {
        const int L = i * G + c, nrt = __builtin_amdgcn_readfirstlane(cb[NCLS]) >> 8; if (L >= nrt * 4) return false;
        const int rt = L >> 2; int e1, e2; cls_experts(cls_of_rowtile(cb, rt), e1, e2);
        u.pm = rt; u.pn = L & 3; u.x = e1; u.y = e2; return true; }
    __device__ __forceinline__ const char* aptr(const pg8::Unit& u) const { return A + (size_t)u.pm * (256 * 512 * 2); }
    __device__ __forceinline__ const char* bptr(const pg8::Unit& u, int t) const { return B + ((size_t)((t < 4 ? u.x : u.y) * 1024 + u.pn * 256) * 256) * 2 + (size_t)(t & 3) * 128; }
};
struct BranchOrder {
    const char* A; const char* B; int G, c;
    __device__ __forceinline__ bool next(int i, pg8::Unit& u) const {
        const int tile = (i >> 2) * G + c; if (tile >= (M / 256) * 4) return false;
        u.pm = tile >> 2; u.pn = tile & 3; u.x = i & 3; u.y = 0; return true; }
    __device__ __forceinline__ const char* aptr(const pg8::Unit& u) const { return A + (size_t)u.x * ((size_t)M * 256 * 2) + (size_t)u.pm * (256 * 256 * 2); }
    __device__ __forceinline__ const char* bptr(const pg8::Unit& u, int t) const { return B + (size_t)u.x * (1024 * 256 * 2) + (size_t)u.pn * (256 * 256 * 2) + (size_t)t * 128; }
};
__device__ __forceinline__ void ln_row(const float* hr, const float* g, const float* b, float* of, bf16* ob, int lane) {
    f32x4 v[4]; float s = 0.f;
#pragma unroll
    for (int j = 0; j < 4; ++j) { v[j] = *(const f32x4*)(hr + 4 * lane + 256 * j); s += (v[j][0] + v[j][1]) + (v[j][2] + v[j][3]); }
    const float mean = wave_sum(s) * (1.f / DMODEL); float s2 = 0.f;
#pragma unroll
    for (int j = 0; j < 4; ++j) { v[j] = v[j] - mean; s2 += (v[j][0] * v[j][0] + v[j][1] * v[j][1]) + (v[j][2] * v[j][2] + v[j][3] * v[j][3]); }
    const float rstd = 1.f / sqrtf(wave_sum(s2) * (1.f / DMODEL) + LN_EPS);
#pragma unroll
    for (int j = 0; j < 4; ++j) { const f32x4 gg = *(const f32x4*)(g + 4 * lane + 256 * j), bb = *(const f32x4*)(b + 4 * lane + 256 * j); v[j] = v[j] * rstd * gg + bb;
        *(f32x4*)(of + 4 * lane + 256 * j) = v[j];
        u32x2g w; w.x = cvtpk(v[j][0], v[j][1]); w.y = cvtpk(v[j][2], v[j][3]); *(u32x2g*)(ob + 4 * lane + 256 * j) = w; }
}

struct Args { const float* in[27]; float* out; unsigned char* ws; int ph_lo, ph_hi; };
__device__ __forceinline__ void mkframe(Frame& F, unsigned char* ws, float* out, int G, int vcu, int bx, int wave, LAS unsigned char* lds) {
    unsigned la = (unsigned)(uintptr_t)lds; GAS unsigned char* wsg = (GAS unsigned char*)ws; GAS float* og = (GAS float*)out;
    asm volatile("" : "+s"(wsg), "+s"(og), "+s"(G), "+s"(vcu), "+s"(bx), "+s"(la), "+s"(wave));
    int tid = wave * 64 + xb_lane_id();
    F.ws = (unsigned char*)wsg; F.out = (float*)og;
    F.G = G; F.vcu = vcu; F.bx = bx; F.tid = tid; F.lane = tid & 63; F.wave = wave; F.lds = (LAS unsigned char*)(uintptr_t)la; F.ctl = (gu32*)(F.ws + WS_CTL);
}
#if MK_PER_PHASE
#define GRID_BAR() do { } while (0)
#else
#define GRID_BAR() xcd_barrier(bar)
#endif
#ifndef PHMASK
#define PHMASK 0x7ff
#endif
#define IN(k) (lo <= (k) && (k) < hi)
#define ON(j) ((PHMASK >> (j)) & 1)
#define SEAM(k) do { if (IN(k) && IN((k) + 1)) GRID_BAR(); } while (0)
#define FRAME() Frame F; mkframe(F, ws0, out0, G0, vcu0, (int)blockIdx.x, wave0, ldsb); unsigned char* const ws = F.ws; LAS unsigned char* const ring = F.lds + RING_OFF; (void)ws; (void)ring
template <int l> __device__ __forceinline__ void layer_phases(const int lo, const int hi, unsigned char* const ws0, float* const out0, const int G0, const int vcu0, const int wave0, LAS unsigned char* const ldsb, const XcdBarrier& bar) {
        const int pb = 1 + 10 * l;
        const float lam_init = l == 0 ? 0.2f : 0.35550906759096764f;
        if (ON(1) && IN(pb + 0)) { FRAME();
            pg8::StdOrder S; S.init(ws + WS_XB, ws + W_IN, M, NIN, DMODEL, F.G, F.bx);
            pg8::EpiProj E{(bf16*)(ws + WS_P), (unsigned char*)F.out};
            pg8::gemm_phase<pg8::EpiProj, pg8::StdOrder, true>(ring, F.tid, DMODEL, DMODEL, S, E);
            SEAM(pb + 0);
        }
        if (ON(2) && IN(pb + 1)) { FRAME();
            for (int ch = F.vcu; ch < M / 128; ch += F.G) prep_unit(F, ch, l);
            SEAM(pb + 1);
        }
        if (ON(3) && IN(pb + 2)) { FRAME();
            float lam;
            { const float* q1 = arg_in(5); const float* k1 = arg_in(6); const float* q2 = arg_in(7); const float* k2 = arg_in(8); const int li = l * 32 + (F.lane & 31);
              const float p1 = F.lane < 32 ? q1[li] * k1[li] : 0.f, p2 = F.lane < 32 ? q2[li] * k2[li] : 0.f;
              lam = expf(wave_sum(p1)) - expf(wave_sum(p2)) + lam_init; }
            const attn_body::bf16* Qp = (const attn_body::bf16*)(ws + WS_QP); const attn_body::bf16* Kp = (const attn_body::bf16*)(ws + WS_KP);
            const attn_body::bf16* Vb = (const attn_body::bf16*)(ws + WS_P) + PC_V; attn_body::bf16* YC = (attn_body::bf16*)(ws + WS_YA) + (size_t)2 * M * 256;
            const float* sg = arg_in(9) + l * 64;
            for (int i = 0;; ++i) { const int p = (i >> 1) * F.G + F.vcu; if (p >= 256) break;
                const int bh = p >> 3, s = p & 7, qb = (i & 1) ? 15 - s : s;
                for (int mp = 0; mp < 2; ++mp) attn_body::attn_unit<8>(bh >> 2, bh & 3, mp, qb, Qp, Kp, Vb, YC, lam, 1.0f - lam_init, sg, (char*)(unsigned char*)ring, F.tid); }
            SEAM(pb + 2);
        }
        if (ON(4) && IN(pb + 3)) { FRAME();
            BranchOrder S{(const char*)(ws + WS_YA), (const char*)(ws + W_B), F.G, F.vcu};
            pg8::EpiMerge E{(const unsigned char*)F.out, (bf16*)(ws + WS_MG)};
            pg8::gemm_phase<pg8::EpiMerge, BranchOrder, true>(ring, F.tid, 256, 256, S, E);
            SEAM(pb + 3);
        }
        if (ON(5) && IN(pb + 4)) { FRAME();
            pg8::StdOrder S; S.init(ws + WS_MG, ws + W_O, M, DMODEL, DMODEL, F.G, F.bx);
            pg8::EpiRes E{l == 0 ? arg_in(0) : (const float*)(ws + WS_X), F.out};
            pg8::gemm_phase<pg8::EpiRes, pg8::StdOrder, true>(ring, F.tid, DMODEL, DMODEL, S, E);
            SEAM(pb + 4);
        }
        if (ON(6) && IN(pb + 5)) { FRAME(); route_phase(F, l); SEAM(pb + 5); }
        if (ON(7) && IN(pb + 6)) { FRAME(); gather_phase(F); SEAM(pb + 6); }
        if (ON(8) && IN(pb + 7)) { FRAME();
            moe_tables(F);
            MoeUpOrder S{(const char*)(ws + WS_XS), (const char*)(ws + W_GU), (const LAS int*)(F.lds + LDSCTL_OFF), F.G, F.vcu};
            pg8::EpiAct E{(bf16*)(ws + WS_HB), (const pg8::f32x2*)(ws + TB_ROWW)};
            pg8::gemm_phase<pg8::EpiAct, MoeUpOrder, true>(ring, F.tid, DMODEL, DMODEL, S, E);
            SEAM(pb + 7);
        }
        if (ON(9) && IN(pb + 8)) { FRAME();
            moe_tables(F);
            MoeDownOrder S{(const char*)(ws + WS_HB), (const char*)(ws + W_D), (const LAS int*)(F.lds + LDSCTL_OFF), F.G, F.vcu};
            pg8::EpiDown E{(const int*)(ws + TB_ROWTOK), F.out};
            pg8::gemm_phase<pg8::EpiDown, MoeDownOrder, true>(ring, F.tid, 512, 256, S, E);
            SEAM(pb + 8);
        }
        if (ON(10) && IN(pb + 9)) { FRAME();
            const float* HX = F.out; float* XO = (l == DEPTH - 1) ? F.out : (float*)(ws + WS_X); bf16* XB = (bf16*)(ws + WS_XB);
            const float* g2 = arg_in(25) + l * DMODEL; const float* b2 = arg_in(26) + l * DMODEL;
            for (int m = F.vcu * NWAVES + F.wave; m < M; m += F.G * NWAVES) ln_row(HX + (size_t)m * DMODEL, g2, b2, XO + (size_t)m * DMODEL, XB + (size_t)m * DMODEL, F.lane);
            if (l + 1 < DEPTH) { convert_weights(F, l + 1); SEAM(pb + 9); }
        }
}
__global__ void __launch_bounds__(NWAVES * 64, 2) fwd(Args args) {
    extern __shared__ __attribute__((aligned(16))) unsigned char lds[];
    LAS unsigned char* const ldsb = (LAS unsigned char*)lds;
    const int G0 = gridDim.x; int vcu0; { const int bx = blockIdx.x; vcu0 = (G0 % 8 == 0) ? (bx % 8) * (G0 / 8) + bx / 8 : bx; }
    unsigned char* const ws0 = args.ws; float* const out0 = args.out; const int wave0 = __builtin_amdgcn_readfirstlane((int)threadIdx.x >> 6);
    for (int u = threadIdx.x; u < (LDS_BYTES - LDSCTL_OFF) / 4; u += NWAVES * 64) ((LAS unsigned*)(ldsb + LDSCTL_OFF))[u] = 0u;
    __syncthreads();
    volatile LAS unsigned* MISC = (volatile LAS unsigned*)(ldsb + MISC_OFF);
#if MK_PER_PHASE
    XcdBarrier bar; bar.bar = nullptr; bar.x = 0; bar.st = nullptr; bar.wave = wave0; bar.G = 0; (void)MISC;
#else
    XcdBarrier bar = xcd_barrier_post((unsigned*)((gu32*)(ws0 + WS_CTL) + CW_BAR), MISC + 8, wave0);
#endif
    const int lo = args.ph_lo, hi = args.ph_hi;
    if (ON(0) && IN(0)) { FRAME(); p0_prologue(F); SEAM(0); }
    layer_phases<0>(lo, hi, ws0, out0, G0, vcu0, wave0, ldsb, bar);
    layer_phases<1>(lo, hi, ws0, out0, G0, vcu0, wave0, ldsb, bar);
    static_assert(DEPTH == 2, "two layer instances");
}
#undef IN
#undef SEAM
#undef GRID_BAR
#undef FRAME


extern "C" void kernel_launch(void* const* d_in, const int* in_sizes, int n_in, void* d_out, int out_size, void* d_ws, size_t ws_size, hipStream_t stream) {
    static int grid = 0;
    if (grid == 0) {
        if (n_in != 27 || in_sizes[0] != M * DMODEL || out_size != M * DMODEL || ws_size < WS_END) { fprintf(stderr, "kernel_launch: built for 27 inputs, x/out of %d floats, >= %zu bytes of workspace; got n_in %d, in0 %d, out %d, ws %zu; nothing launched\n", M * DMODEL, (size_t)WS_END, n_in, n_in > 0 ? in_sizes[0] : -1, out_size, ws_size); grid = -1; return; }
        int dev = 0, cus = 0, per_cu = 0;
        if (hipGetDevice(&dev) != hipSuccess || hipDeviceGetAttribute(&cus, hipDeviceAttributeMultiprocessorCount, dev) != hipSuccess) { fprintf(stderr, "kernel_launch: device query failed\n"); grid = -1; return; }
        if (hipFuncSetAttribute((const void*)fwd, hipFuncAttributeMaxDynamicSharedMemorySize, LDS_BYTES) != hipSuccess) { fprintf(stderr, "kernel_launch: hipFuncSetAttribute failed\n"); grid = -1; return; }
        if (hipOccupancyMaxActiveBlocksPerMultiprocessor(&per_cu, (const void*)fwd, NWAVES * 64, LDS_BYTES) != hipSuccess || per_cu < 1) { fprintf(stderr, "kernel_launch: occupancy query reports %d workgroups per CU\n", per_cu); }
        (void)hipGetLastError();
        grid = cus;
    }
    if (grid < 0) return;
    if (hipMemsetAsync((char*)d_ws + WS_CTL, 0, CTL_ZERO_BYTES, stream) != hipSuccess) { fprintf(stderr, "kernel_launch: memset failed\n"); return; }
    Args a{};
    for (int i = 0; i < 27; ++i) a.in[i] = (const float*)d_in[i];
    a.out = (float*)d_out; a.ws = (unsigned char*)d_ws;
#if MK_PER_PHASE
    for (int p = 0; p < NPHASE; ++p) { a.ph_lo = p; a.ph_hi = p + 1; hipLaunchKernelGGL(fwd, dim3(grid), dim3(NWAVES * 64), LDS_BYTES, stream, a); }
#else
    a.ph_lo = 0; a.ph_hi = NPHASE; hipLaunchKernelGGL(fwd, dim3(grid), dim3(NWAVES * 64), LDS_BYTES, stream, a);
#endif
    const hipError_t le = hipPeekAtLastError();
    if (le != hipSuccess) fprintf(stderr, "kernel_launch: launch failed: %s\n", hipGetErrorName(le));
}
```

```cpp
#include <hip/hip_runtime.h>
#include <hip/hip_bf16.h>
#include <cstdio>
#include <cstdint>
#include <cmath>

#ifndef MK_PER_PHASE
#define MK_PER_PHASE 0
#endif

constexpr int BATCH = 8, SEQ = 4096, DMODEL = 1024, M = BATCH * SEQ, DEPTH = 2;
constexpr int NPB = 2304;
constexpr int NGATE = 4096, NIN = NPB + NGATE;
constexpr int PC_POOL = 0, PC_GB = 256, PC_GC = 512, PC_H = 768, PC_Q = 1024, PC_K = 1280, PC_V = 1536, PC_U = 1792, PC_VV = 2048;
constexpr float LN_EPS = 1e-5f;
constexpr float ALPHA = 1.41421356237309515f;
constexpr int NCLS = 24;
constexpr int MAXROWS = 40960;

namespace pg8 {
#define PG8_LAS __attribute__((address_space(3)))
typedef unsigned short bf16_t;
typedef short bf16x8 __attribute__((ext_vector_type(8)));
typedef float f32x4 __attribute__((ext_vector_type(4)));
typedef unsigned u32x4 __attribute__((ext_vector_type(4)));
constexpr int BM = 256, BK = 64, HALF = 128, HTB = HALF * BK * 2  , STAGE_BYTES = 8 * HTB, NXCD = 8, WGM = 8;

__host__ __device__ __forceinline__ int lds_byte(int r, int c) { const int st = (r >> 4) * 2 + (c >> 5), rr = r & 15, cc = c & 31, ob = rr * 64 + cc * 2; return st * 1024 + (ob ^ (((ob >> 9) & 1) << 5)); }
__host__ __device__ __forceinline__ void stage_rc(int b, int& R, int& C) { const int st = b / 1024, sb = b % 1024, swz = sb ^ (((sb >> 9) & 1) << 5); R = (st >> 1) * 16 + swz / 64; C = (st & 1) * 32 + (swz % 64) / 2; }
__host__ __device__ __forceinline__ int perm32(int rho) { const int n = rho >> 4, i = rho & 15; return 8 * (i >> 2) + 4 * n + (i & 3); }

struct Unit { int pm, pn, x, y, z, v; };

struct StdOrder {
    const char* A; const char* B; size_t tsA, tsB;
    int nM, nN, nwg, G, c, skew;
    __device__ __forceinline__ void init(const void* A_, const void* B_, int M_, int N_, int rowbytes, int G_, int c_) {
        A = (const char*)A_; B = (const char*)B_; tsA = (size_t)BM * rowbytes; tsB = tsA; nM = M_ / BM; nN = N_ / BM; nwg = nM * nN; G = G_; c = c_; skew = 0; }
    __device__ __forceinline__ bool next(int i, Unit& u) const {
        long L = (long)i * G + c;
        if (skew && G == 256 && nwg == 2048) { if (i >= 7) { if (c < 128 || i > 8) return false; L = 1792 + (i - 7) * 128 + (c - 128); } }
        if (L >= nwg) return false;
        int wgid = (int)L; { const int q = nwg / NXCD, r = nwg % NXCD, xcd = wgid % NXCD, off = wgid / NXCD; wgid = (xcd < r ? xcd * (q + 1) : r * (q + 1) + (xcd - r) * q) + off; }
        if (skew == 2 && nM % NXCD == 0 && nwg % NXCD == 0) { const int xcd = (int)(L % NXCD), off = (int)(L / NXCD); u.pm = xcd * (nM / NXCD) + off / nN; u.pn = off % nN; u.x = 0; u.y = 0; u.z = 0; u.v = 0; return true; }
        const int nig = WGM * nN, gid = wgid / nig, fm = gid * WGM, gsz = (nM - fm) < WGM ? (nM - fm) : WGM;
        u.pm = fm + ((wgid % nig) % gsz); u.pn = (wgid % nig) / gsz; u.x = 0; u.y = 0; u.z = 0; u.v = 0; return true;
    }
    __device__ __forceinline__ const char* aptr(const Unit& u, int t) const { return A + (size_t)u.pm * tsA + (size_t)t * (BK * 2); }
    __device__ __forceinline__ const char* bptr(const Unit& u, int t) const { return B + (size_t)u.pn * tsB + (size_t)t * (BK * 2); }
};

__device__ __forceinline__ unsigned cvt_pk_bf16(float lo, float hi) { unsigned r; asm volatile("v_cvt_pk_bf16_f32 %0, %1, %2" : "=v"(r) : "v"(lo), "v"(hi)); return r; }
typedef float f32x2 __attribute__((ext_vector_type(2)));
typedef unsigned u32x2 __attribute__((ext_vector_type(2)));
__device__ __forceinline__ float bf_lo(unsigned w) { return __uint_as_float(w << 16); }
__device__ __forceinline__ float bf_hi(unsigned w) { return __uint_as_float(w & 0xffff0000u); }
__device__ __forceinline__ float sigmoidf_(float x) { return __builtin_amdgcn_rcpf(1.0f + __builtin_amdgcn_exp2f(x * -1.4426950408889634f)); }
__device__ __forceinline__ float gelu_tanh(float x) { const float u = x * (1.0f + 0.044715f * x * x); return x * __builtin_amdgcn_rcpf(1.0f + __builtin_amdgcn_exp2f(u * -2.3022082f)); }
__device__ __forceinline__ float ubf(unsigned w, int n) { return (float)((w >> (8 * n)) & 0xffu); }
__device__ __forceinline__ unsigned sig_u8(float x) { return (unsigned)(sigmoidf_(x) * 255.0f + 0.5f); }

struct NoState {};
struct EpiProjA {
    static constexpr bool PERM = true, AFTER_DRAIN = false; static constexpr int GROUP = 0; typedef NoState State;
    bf16_t* P; bf16_t* Qp; bf16_t* Kp; const float* rc; const float* rs; float qscale;
    __device__ __forceinline__ void operator()(const f32x4 (&acc)[2][2][4][2], const Unit& u, int wr, int wc, int fr, int fq) const {
        asm volatile("" : "+v"(fr), "+v"(fq));
        const int row0 = u.pm * BM + wr * 64 + fr, col0 = wc * 32 + 8 * fq;
        if (u.pn == 4 || u.pn == 5) {
            bf16_t* dstb = (u.pn == 4 ? Qp : Kp) + wc * 64 + 8 * fq; const float sc = u.pn == 4 ? qscale : 1.0f; const bool up = fq >= 2; const int j0 = 8 * (fq & 1);
#pragma unroll
            for (int ai = 0; ai < 2; ++ai)
#pragma unroll
                for (int m = 0; m < 4; ++m) { const int row = row0 + ai * HALF + m * 16, pos = row & 4095;
                    const f32x4 c0 = *(const f32x4*)(rc + pos * 16 + j0), c1 = *(const f32x4*)(rc + pos * 16 + j0 + 4), s0 = *(const f32x4*)(rs + pos * 16 + j0), s1 = *(const f32x4*)(rs + pos * 16 + j0 + 4);
#pragma unroll
                    for (int bj = 0; bj < 2; ++bj) { const f32x4 v0 = acc[ai][bj][m][0], v1 = acc[ai][bj][m][1]; f32x4 p0, p1;
#pragma unroll
                        for (int e = 0; e < 4; ++e) { p0[e] = __shfl_xor(v0[e], 32); p1[e] = __shfl_xor(v1[e], 32); }
                        const f32x4 o0 = (v0 * c0 + (up ? p0 : -p0) * s0) * sc, o1 = (v1 * c1 + (up ? p1 : -p1) * s1) * sc;
                        u32x4 w; w.x = cvt_pk_bf16(o0[0], o0[1]); w.y = cvt_pk_bf16(o0[2], o0[3]); w.z = cvt_pk_bf16(o1[0], o1[1]); w.w = cvt_pk_bf16(o1[2], o1[3]);
                        bf16_t* d = dstb + (size_t)row * 512 + bj * 256;
                        *(u32x4*)d = w; *(u32x4*)(d + 32) = (u32x4){0u, 0u, 0u, 0u}; } }
            return;
        }
        const bool act = u.pn >= 7; bf16_t* base = P + u.pn * BM + col0;
#pragma unroll
        for (int ai = 0; ai < 2; ++ai)
#pragma unroll
            for (int m = 0; m < 4; ++m) { bf16_t* rowp = base + (size_t)(row0 + ai * HALF + m * 16) * NPB;
#pragma unroll
                for (int bj = 0; bj < 2; ++bj) { f32x4 v0 = acc[ai][bj][m][0], v1 = acc[ai][bj][m][1];
                    if (act) { v0 = (f32x4){gelu_tanh(v0[0]), gelu_tanh(v0[1]), gelu_tanh(v0[2]), gelu_tanh(v0[3])}; v1 = (f32x4){gelu_tanh(v1[0]), gelu_tanh(v1[1]), gelu_tanh(v1[2]), gelu_tanh(v1[3])}; }
                    u32x4 w; w.x = cvt_pk_bf16(v0[0], v0[1]); w.y = cvt_pk_bf16(v0[2], v0[3]); w.z = cvt_pk_bf16(v1[0], v1[1]); w.w = cvt_pk_bf16(v1[2], v1[3]);
                    *(u32x4*)(rowp + bj * HALF) = w; } }
    }
};
constexpr float FP8_XS = 16.0f, FP8_WS = 512.0f, FP8_SCALE = FP8_XS * FP8_WS;
__device__ __forceinline__ float fp8_clamp(float x) { return __builtin_fminf(__builtin_fmaxf(x, -448.0f), 448.0f); }
__device__ __forceinline__ unsigned fp8_pk4(float a, float b, float c, float d) { int q = 0; q = __builtin_amdgcn_cvt_pk_fp8_f32(fp8_clamp(a), fp8_clamp(b), q, false); q = __builtin_amdgcn_cvt_pk_fp8_f32(fp8_clamp(c), fp8_clamp(d), q, true); return (unsigned)q; }
__device__ __forceinline__ unsigned sig_u8s(float x) { return (unsigned)(__builtin_amdgcn_rcpf(1.0f + __builtin_amdgcn_exp2f(x * (-1.4426950408889634f / FP8_SCALE))) * 255.0f + 0.5f); }
struct EpiGate {
    static constexpr bool PERM = true, AFTER_DRAIN = false; static constexpr int GROUP = 0; typedef NoState State;
    unsigned char* G8;
    __device__ __forceinline__ void operator()(const f32x4 (&acc)[2][2][4][2], const Unit& u, int wr, int wc, int fr, int fq) const {
        asm volatile("" : "+v"(fr), "+v"(fq));
        const int row0 = u.pm * BM + wr * 64 + fr, col0 = wc * 32 + 8 * fq;
#pragma unroll
        for (int ai = 0; ai < 2; ++ai)
#pragma unroll
            for (int m = 0; m < 4; ++m) { unsigned char* rowp = G8 + (unsigned)((row0 + ai * HALF + m * 16) * NGATE + u.pn * BM + col0);
#pragma unroll
                for (int bj = 0; bj < 2; ++bj) { const f32x4 v0 = acc[ai][bj][m][0], v1 = acc[ai][bj][m][1];
                    u32x2 w; w.x = sig_u8s(v0[0]) | (sig_u8s(v0[1]) << 8) | (sig_u8s(v0[2]) << 16) | (sig_u8s(v0[3]) << 24);
                    w.y = sig_u8s(v1[0]) | (sig_u8s(v1[1]) << 8) | (sig_u8s(v1[2]) << 16) | (sig_u8s(v1[3]) << 24);
                    *(u32x2*)(rowp + bj * HALF) = w; } }
    }
};
struct EpiMerge2 {
    static constexpr bool PERM = true, AFTER_DRAIN = false; static constexpr int GROUP = 4;
    struct State { f32x4 mg[2][4][2]; u32x2 gq[2][4]; };
    const unsigned char* G8; bf16_t* MG;
    __device__ __forceinline__ void load_gates(State& st, const Unit& u, int g, int wr, int wc, int fr, int fq) const {
        asm volatile("" : "+v"(fr), "+v"(fq));
        const unsigned char* base = G8 + (size_t)(u.pm * BM + wr * 64 + fr) * NGATE + g * DMODEL + u.pn * HALF + wc * 32 + 8 * fq;
#pragma unroll
        for (int ai = 0; ai < 2; ++ai)
#pragma unroll
            for (int m = 0; m < 4; ++m) { const unsigned char* p = base + (size_t)(ai * HALF + m * 16) * NGATE;
                asm volatile("global_load_dwordx2 %0, %1, off" : "+v"(st.gq[ai][m]) : "v"(p) : "memory"); }
    }
    __device__ __forceinline__ void begin(State& st, const Unit& u, int wr, int wc, int fr, int fq) const {
#pragma unroll
        for (int ai = 0; ai < 2; ++ai)
#pragma unroll
            for (int m = 0; m < 4; ++m) { st.mg[ai][m][0] = (f32x4){0.f, 0.f, 0.f, 0.f}; st.mg[ai][m][1] = (f32x4){0.f, 0.f, 0.f, 0.f}; }
        load_gates(st, u, 0, wr, wc, fr, fq);
    }
    __device__ __forceinline__ void group(State& st, f32x4 (&acc)[2][1][4][2], const Unit& u, int g, int ng, int wr, int wc, int fr, int fq) const {
        asm volatile("s_waitcnt vmcnt(6)" ::: "memory");
#pragma unroll
        for (int ai = 0; ai < 2; ++ai)
#pragma unroll
            for (int m = 0; m < 4; ++m) { const u32x2 q = st.gq[ai][m];
                st.mg[ai][m][0] += (f32x4){ubf(q.x, 0), ubf(q.x, 1), ubf(q.x, 2), ubf(q.x, 3)} * acc[ai][0][m][0];
                st.mg[ai][m][1] += (f32x4){ubf(q.y, 0), ubf(q.y, 1), ubf(q.y, 2), ubf(q.y, 3)} * acc[ai][0][m][1];
                acc[ai][0][m][0] = (f32x4){0.f, 0.f, 0.f, 0.f}; acc[ai][0][m][1] = (f32x4){0.f, 0.f, 0.f, 0.f}; }
        asm volatile("" : "+v"(st.mg[0][0][0]), "+v"(st.mg[0][0][1]), "+v"(st.mg[0][1][0]), "+v"(st.mg[0][1][1]), "+v"(st.mg[0][2][0]), "+v"(st.mg[0][2][1]), "+v"(st.mg[0][3][0]), "+v"(st.mg[0][3][1]),
                          "+v"(st.mg[1][0][0]), "+v"(st.mg[1][0][1]), "+v"(st.mg[1][1][0]), "+v"(st.mg[1][1][1]), "+v"(st.mg[1][2][0]), "+v"(st.mg[1][2][1]), "+v"(st.mg[1][3][0]), "+v"(st.mg[1][3][1]));
        if (g + 1 < ng) load_gates(st, u, g + 1, wr, wc, fr, fq);
    }
    __device__ __forceinline__ void store(State& st, const Unit& u, int wr, int wc, int fr, int fq) const {
        asm volatile("" : "+v"(fr), "+v"(fq));
        bf16_t* base = MG + (size_t)(u.pm * BM + wr * 64 + fr) * DMODEL + u.pn * HALF + wc * 32 + 8 * fq; const float s = 1.0f / 255.0f;
#pragma unroll
        for (int ai = 0; ai < 2; ++ai)
#pragma unroll
            for (int m = 0; m < 4; ++m) { const f32x4 a = st.mg[ai][m][0] * s, b = st.mg[ai][m][1] * s;
                u32x4 w; w.x = cvt_pk_bf16(a[0], a[1]); w.y = cvt_pk_bf16(a[2], a[3]); w.z = cvt_pk_bf16(b[0], b[1]); w.w = cvt_pk_bf16(b[2], b[3]);
                *(u32x4*)(base + (size_t)(ai * HALF + m * 16) * DMODEL) = w; }
    }
};
template <bool RES_BF16> struct EpiRes {
    static constexpr bool PERM = true, AFTER_DRAIN = false; static constexpr int GROUP = 0; typedef NoState State;
    const void* res; bf16_t* out;
    __device__ __forceinline__ void operator()(const f32x4 (&acc)[2][2][4][2], const Unit& u, int wr, int wc, int fr, int fq) const {
        asm volatile("" : "+v"(fr), "+v"(fq));
        const int row0 = u.pm * BM + wr * 64 + fr, col0 = u.pn * BM + wc * 32 + 8 * fq;
#pragma unroll
        for (int ai = 0; ai < 2; ++ai)
#pragma unroll
            for (int m = 0; m < 4; ++m) { const size_t off = (size_t)(row0 + ai * HALF + m * 16) * DMODEL + col0;
#pragma unroll
                for (int bj = 0; bj < 2; ++bj) { f32x4 r0, r1;
                    if constexpr (RES_BF16) { const u32x4 p = *(const u32x4*)((const bf16_t*)res + off + bj * HALF); r0 = (f32x4){bf_lo(p.x), bf_hi(p.x), bf_lo(p.y), bf_hi(p.y)}; r1 = (f32x4){bf_lo(p.z), bf_hi(p.z), bf_lo(p.w), bf_hi(p.w)}; }
                    else { r0 = *(const f32x4*)((const float*)res + off + bj * HALF); r1 = *(const f32x4*)((const float*)res + off + bj * HALF + 4); }
                    const f32x4 a = r0 * ALPHA + acc[ai][bj][m][0], b = r1 * ALPHA + acc[ai][bj][m][1];
                    u32x4 w; w.x = cvt_pk_bf16(a[0], a[1]); w.y = cvt_pk_bf16(a[2], a[3]); w.z = cvt_pk_bf16(b[0], b[1]); w.w = cvt_pk_bf16(b[2], b[3]);
                    *(u32x4*)(out + off + bj * HALF) = w; } }
    }
};
struct EpiAct {
    static constexpr bool PERM = true, AFTER_DRAIN = false; static constexpr int GROUP = 0; typedef NoState State;
    unsigned char* H; const f32x2* roww;
    __device__ __forceinline__ void operator()(const f32x4 (&acc)[2][2][4][2], const Unit& u, int wr, int wc, int fr, int fq) const {
        asm volatile("" : "+v"(fr), "+v"(fq));
        const int row0 = u.pm * BM + wr * 64 + fr, col0 = u.x + wc * 32 + 8 * fq; const float ds = 1.0f / FP8_SCALE;
#pragma unroll
        for (int ai = 0; ai < 2; ++ai)
#pragma unroll
            for (int m = 0; m < 4; ++m) { const size_t row = (size_t)(row0 + ai * HALF + m * 16); const int r_ = wr * 64 + fr + ai * HALF + m * 16; const f32x2 rw = roww[u.z + (r_ < u.v ? r_ : 0)]; const float w = (u.y ? rw.y : rw.x) * FP8_XS;
                float o[8];
#pragma unroll
                for (int n = 0; n < 2; ++n)
#pragma unroll
                    for (int e = 0; e < 4; ++e) { const float g = acc[ai][0][m][n][e] * ds, up = acc[ai][1][m][n][e] * ds; o[n * 4 + e] = g * sigmoidf_(g) * up * w; }
                u32x2 q; q.x = fp8_pk4(o[0], o[1], o[2], o[3]); q.y = fp8_pk4(o[4], o[5], o[6], o[7]);
                *(u32x2*)(H + row * 512 + col0) = q; }
    }
};
struct EpiDown {
    static constexpr bool PERM = true, AFTER_DRAIN = false; static constexpr int GROUP = 0; typedef NoState State;
    const int* rowtok; bf16_t* hx;
    __device__ __forceinline__ void operator()(const f32x4 (&acc)[2][2][4][2], const Unit& u, int wr, int wc, int fr, int fq) const {
        asm volatile("" : "+v"(fr), "+v"(fq));
        const int row0 = u.pm * BM + wr * 64 + fr, col0 = u.pn * BM + wc * 32 + 8 * fq;
#pragma unroll
        for (int ai = 0; ai < 2; ++ai)
#pragma unroll
            for (int m = 0; m < 4; ++m) { const int r_ = wr * 64 + fr + ai * HALF + m * 16;
                if (r_ < u.v) { const int tok = rowtok[u.z + r_]; bf16_t* p = (bf16_t*)((char*)hx + (unsigned)(tok * (DMODEL * 2) + col0 * 2));
#pragma unroll
                    for (int bj = 0; bj < 2; ++bj) { const u32x4 q = *(const u32x4*)(p + bj * HALF);
                        const f32x4 a = (f32x4){bf_lo(q.x), bf_hi(q.x), bf_lo(q.y), bf_hi(q.y)} * ALPHA + acc[ai][bj][m][0] * (1.0f / FP8_SCALE), b = (f32x4){bf_lo(q.z), bf_hi(q.z), bf_lo(q.w), bf_hi(q.w)} * ALPHA + acc[ai][bj][m][1] * (1.0f / FP8_SCALE);
                        u32x4 w; w.x = cvt_pk_bf16(a[0], a[1]); w.y = cvt_pk_bf16(a[2], a[3]); w.z = cvt_pk_bf16(b[0], b[1]); w.w = cvt_pk_bf16(b[2], b[3]);
                        *(u32x4*)(p + bj * HALF) = w; } }
                asm volatile("" ::: "memory"); }
    }
};

typedef int i32x8 __attribute__((ext_vector_type(8)));
__device__ __forceinline__ int lane_id_now() { int l; asm volatile("v_mbcnt_lo_u32_b32 %0, -1, 0\n\tv_mbcnt_hi_u32_b32 %0, -1, %0" : "=v"(l)); return l; }
template <class Epi, class Sched, bool ALIGN_EPI = false, int MODE = 0, int NB = 2, bool GATHER = false>
__device__ __forceinline__ void gemm_phase(PG8_LAS unsigned char* lds, int tid, const int nt, const int ldaB, const int ldbB, const Sched& S, const Epi& E) {
    asm volatile("" : "+v"(tid));
    const int wid = __builtin_amdgcn_readfirstlane(tid >> 6), lane = tid & 63, wr = wid >> 2, wc = wid & 3, fr = lane & 15, fq = lane >> 4;
    unsigned voffA[2], voffB[2];
#pragma unroll
    for (int i = 0; i < 2; ++i) { int R, C; stage_rc(tid * 16 + i * 8192, R, C); const int Rb = Epi::PERM ? ((R & ~31) + perm32(R & 31)) : R;
        voffA[i] = (unsigned)(R * ldaB + C * 2); voffB[i] = (unsigned)(Rb * ldbB + C * 2); }
    const size_t hsA = (size_t)HALF * ldaB, hsB = (size_t)HALF * ldbB;
    const unsigned ldsw = (unsigned)wid * 1024u;
    const int aoff = lds_byte(wr * 64 + fr, fq * 8), boff = lds_byte(wc * 32 + fr, fq * 8);
#define PG8_SA(b, h) (((b) * 2 + (h)) * HTB)
#define PG8_SB(b, h) ((4 + (b) * 2 + (h)) * HTB)
#define PG8_STAGE(bufoff, gbase, voff) do { const __attribute__((address_space(1))) char* gb_ = (const __attribute__((address_space(1))) char*)(gbase); asm volatile("" : "+s"(gb_));   \
        _Pragma("unroll") for (int _i = 0; _i < 2; ++_i) \
        __builtin_amdgcn_global_load_lds((const __attribute__((address_space(1))) unsigned*)(gb_ + (voff)[_i]), (PG8_LAS unsigned*)(lds + (bufoff) + ldsw + _i * 8192), 16, 0, 0); } while (0)
#define PG8_STAGE_B1(bufoff, gbase) do { if constexpr (NB == 2) PG8_STAGE(bufoff, gbase, voffB); } while (0)
#define PG8_STAGE_A(bufoff, h, gbase, nx) do { if constexpr (GATHER) PG8_STAGE(bufoff, gbase, voffG[h]); else PG8_STAGE(bufoff, (gbase) + (h) * hsA, voffA); } while (0)
#define PG8_LDA(dst, b, h) do { _Pragma("unroll") for (int m = 0; m < 4; ++m) _Pragma("unroll") for (int k = 0; k < 2; ++k) dst[m][k] = *(const PG8_LAS bf16x8*)(lds + PG8_SA(b, h) + aoff + m * 2048 + k * 1024); } while (0)
#define PG8_LDB(dst, b, h) do { _Pragma("unroll") for (int n = 0; n < 2; ++n) _Pragma("unroll") for (int k = 0; k < 2; ++k) dst[n][k] = *(const PG8_LAS bf16x8*)(lds + PG8_SB(b, h) + boff + n * 2048 + k * 1024); } while (0)
#define PG8_CAT(x) __builtin_bit_cast(i32x8, __builtin_shufflevector((x)[0], (x)[1], 0, 1, 2, 3, 4, 5, 6, 7, 8, 9, 10, 11, 12, 13, 14, 15))
#define PG8_MMA(ai, bj, At, Bt) do { __builtin_amdgcn_s_setprio(1); _Pragma("unroll") for (int m = 0; m < 4; ++m) _Pragma("unroll") for (int n = 0; n < 2; ++n) { \
        if constexpr (MODE == 0) { _Pragma("unroll") for (int k = 0; k < 2; ++k) acc[ai][bj][m][n] = __builtin_amdgcn_mfma_f32_16x16x32_bf16(Bt[n][k], At[m][k], acc[ai][bj][m][n], 0, 0, 0); } \
        else acc[ai][bj][m][n] = __builtin_amdgcn_mfma_scale_f32_16x16x128_f8f6f4(PG8_CAT(Bt[n]), PG8_CAT(At[m]), acc[ai][bj][m][n], 0, 0, 0, 0, 0, 0); } \
        __builtin_amdgcn_s_setprio(0); } while (0)
#define PG8_WAIT_V(n) asm volatile("s_waitcnt vmcnt(" #n ")" ::: "memory")
#define PG8_WAIT_VS() do { if constexpr (NB == 2) PG8_WAIT_V(8); else PG8_WAIT_V(6); } while (0)
#define PG8_WAIT_L(n) asm volatile("s_waitcnt lgkmcnt(" #n ")" ::: "memory")
#define PG8_BAR __builtin_amdgcn_s_barrier()
#define PG8_SCHED __builtin_amdgcn_sched_barrier(0)
    Unit cur, nxt; int ui = 0;
    if (!S.next(0, cur)) return;
    f32x4 acc[2][NB][4][2];
#pragma unroll
    for (int a = 0; a < 2; ++a)
#pragma unroll
        for (int b = 0; b < NB; ++b)
#pragma unroll
            for (int m = 0; m < 4; ++m)
#pragma unroll
                for (int n = 0; n < 2; ++n) acc[a][b][m][n] = (f32x4){0.f, 0.f, 0.f, 0.f};
    typename Epi::State st = {};
    unsigned voffG[2][2]; int tokN[2][2];
    if constexpr (GATHER) { const int* rt = S.rowtab() + cur.z;
#pragma unroll
        for (int h = 0; h < 2; ++h)
#pragma unroll
            for (int i = 0; i < 2; ++i) { int R, C; stage_rc(tid * 16 + i * 8192, R, C); const int tk = (R + h * HALF < cur.v) ? rt[R + h * HALF] : 0; voffG[h][i] = (unsigned)(tk * ldaB + C * 2); tokN[h][i] = 0; } }
    if constexpr (Epi::GROUP > 0) E.begin(st, cur, wr, wc, fr, fq);
    bf16x8 At[4][2], B0[2][2], B1[2][2];
    {   const char* cA0 = S.aptr(cur, 0); const char* cA1 = S.aptr(cur, 1); const char* cB0 = S.bptr(cur, 0); const char* cB1 = S.bptr(cur, 1);
        PG8_STAGE(PG8_SB(0, 0), cB0, voffB); PG8_STAGE_B1(PG8_SB(0, 1), cB0 + hsB); PG8_STAGE_A(PG8_SA(0, 0), 0, cA0, false); PG8_STAGE_A(PG8_SA(0, 1), 1, cA0, false);
        if (wr == 1) PG8_BAR;
        PG8_WAIT_V(2); PG8_BAR;
        PG8_STAGE(PG8_SB(1, 0), cB1, voffB); PG8_STAGE_A(PG8_SA(1, 0), 0, cA1, false); PG8_STAGE_B1(PG8_SB(1, 1), cB1 + hsB);
        if constexpr (NB == 2) PG8_WAIT_V(6); else PG8_WAIT_V(4);
        PG8_BAR;
    }
    for (;;) {
        const bool has_next = S.next(ui + 1, nxt);
        const Unit nu = has_next ? nxt : cur;
        if constexpr (GATHER) { const int* rt = S.rowtab() + nu.z;
#pragma unroll
            for (int h = 0; h < 2; ++h)
#pragma unroll
                for (int i = 0; i < 2; ++i) { int R, C; stage_rc(tid * 16 + i * 8192, R, C); const int* p = rt + R + h * HALF;
                    asm volatile("global_load_dword %0, %1, off" : "+v"(tokN[h][i]) : "v"(p) : "memory"); } }
        const char* nA0 = S.aptr(nu, 0); const char* nA1 = S.aptr(nu, 1); const char* nB0 = S.bptr(nu, 0); const char* nB1 = S.bptr(nu, 1);
#pragma nounroll
        for (int t = 0; t < nt; t += 2) {
            const bool last = (t == nt - 2);
            const char* a1 = S.aptr(cur, t + 1);
            const char* a2 = last ? nA0 : S.aptr(cur, t + 2); const char* a3 = last ? nA1 : S.aptr(cur, t + 3);
            const char* b2 = last ? nB0 : S.bptr(cur, t + 2); const char* b3 = last ? nB1 : S.bptr(cur, t + 3);
            PG8_LDB(B0, 0, 0); if constexpr (NB == 2) PG8_LDB(B1, 0, 1); PG8_SCHED; PG8_LDA(At, 0, 0); PG8_STAGE_A(PG8_SA(1, 1), 1, a1, false);
            if constexpr (GATHER) { if (last) { asm volatile("" : "+v"(tokN[0][0]), "+v"(tokN[0][1]), "+v"(tokN[1][0]), "+v"(tokN[1][1]));
#pragma unroll
                for (int h = 0; h < 2; ++h)
#pragma unroll
                    for (int i = 0; i < 2; ++i) { int R, C; stage_rc(tid * 16 + i * 8192, R, C); const int tk = (R + h * HALF < nu.v) ? tokN[h][i] : 0; voffG[h][i] = (unsigned)(tk * ldaB + C * 2); } } }
            PG8_WAIT_VS(); PG8_WAIT_L(0); PG8_BAR; PG8_MMA(0, 0, At, B0); if constexpr (NB == 2) PG8_MMA(0, NB - 1, At, B1); PG8_BAR; PG8_SCHED;
            PG8_LDA(At, 0, 1); PG8_STAGE(PG8_SB(0, 0), b2, voffB); PG8_STAGE_B1(PG8_SB(0, 1), b2 + hsB); PG8_STAGE_A(PG8_SA(0, 0), 0, a2, last);
            PG8_WAIT_VS(); PG8_WAIT_L(0); PG8_BAR; PG8_MMA(1, 0, At, B0); if constexpr (NB == 2) PG8_MMA(1, NB - 1, At, B1); PG8_BAR; PG8_SCHED;
            PG8_LDB(B0, 1, 0); if constexpr (NB == 2) PG8_LDB(B1, 1, 1); PG8_SCHED; PG8_LDA(At, 1, 0); PG8_STAGE_A(PG8_SA(0, 1), 1, a2, last);
            PG8_WAIT_VS(); PG8_WAIT_L(0); PG8_BAR; PG8_MMA(0, 0, At, B0); if constexpr (NB == 2) PG8_MMA(0, NB - 1, At, B1); PG8_BAR; PG8_SCHED;
            PG8_LDA(At, 1, 1); PG8_STAGE(PG8_SB(1, 0), b3, voffB); PG8_STAGE_B1(PG8_SB(1, 1), b3 + hsB); PG8_STAGE_A(PG8_SA(1, 0), 0, a3, last);
            PG8_WAIT_VS(); PG8_WAIT_L(0); PG8_BAR; PG8_MMA(1, 0, At, B0); if constexpr (NB == 2) PG8_MMA(1, NB - 1, At, B1); PG8_BAR; PG8_SCHED;
            if constexpr (Epi::GROUP > 0) { if (((t + 2) % Epi::GROUP) == 0) { const int ln_ = lane_id_now(); E.group(st, acc, cur, (t + 2) / Epi::GROUP - 1, nt / Epi::GROUP, wr, wc, ln_ & 15, ln_ >> 4); } }
        }
        if constexpr (ALIGN_EPI) { if (wr == 0) PG8_BAR; }
        { const int ln_ = lane_id_now(), fr_ = ln_ & 15, fq_ = ln_ >> 4;
          if constexpr (Epi::GROUP > 0) { E.store(st, cur, wr, wc, fr_, fq_); if (has_next) E.begin(st, nxt, wr, wc, fr_, fq_); }
          else E(acc, cur, wr, wc, fr_, fq_); }
        if (!has_next) break;
        if constexpr (Epi::GROUP == 0) {
#pragma unroll
        for (int a = 0; a < 2; ++a)
#pragma unroll
            for (int b = 0; b < NB; ++b)
#pragma unroll
                for (int m = 0; m < 4; ++m)
#pragma unroll
                    for (int n = 0; n < 2; ++n) acc[a][b][m][n] = (f32x4){0.f, 0.f, 0.f, 0.f};
        }
        cur = nxt; ++ui;
        if constexpr (ALIGN_EPI) { if (wr == 1) PG8_BAR; }
    }
    PG8_WAIT_V(0);
    if constexpr (!ALIGN_EPI) { if (wr == 0) PG8_BAR; }
    PG8_BAR;
#undef PG8_SA
#undef PG8_SB
#undef PG8_STAGE
#undef PG8_STAGE_B1
#undef PG8_STAGE_A
#undef PG8_LDA
#undef PG8_LDB
#undef PG8_CAT
#undef PG8_MMA
#undef PG8_WAIT_V
#undef PG8_WAIT_VS
#undef PG8_WAIT_L
#undef PG8_BAR
#undef PG8_SCHED
}
}

namespace attn_body {
using bf16=unsigned short;
using bf16x8=__attribute__((ext_vector_type(8)))short;
using s16x4=__attribute__((ext_vector_type(4)))short;
using f32x16=__attribute__((ext_vector_type(16)))float;
using u32x4=__attribute__((ext_vector_type(4)))unsigned;
using f32x4=__attribute__((ext_vector_type(4)))float;
constexpr int BATCH=8,NHEAD=8,SEQ=4096,D=64,DM=NHEAD*D;
constexpr int VP=NPB;
constexpr int NW=8,QBLK=32,QB=QBLK*NW,KVBLK=64,NQB=SEQ/QB;
__device__ __forceinline__ int crow(int r,int hi){return (r&3)+8*(r>>2)+4*hi;}
#define SBAR() __builtin_amdgcn_sched_barrier(0)
__device__ __forceinline__ void cmask(f32x16&p0,f32x16&p1,int jb,int qrel,int hi){
  const float NEG=-INFINITY; int kb=64*jb+4*hi;
  #pragma unroll
  for(int r=0;r<16;++r){int kv=kb+(r&3)+8*(r>>2); if(kv>qrel)p0[r]=NEG; if(kv+32>qrel)p1[r]=NEG;}
}

constexpr int NSLOT=3, SLOTB=8192;
constexpr int LDS_K=0, LDS_V=NSLOT*SLOTB, LDS_WS=2*NSLOT*SLOTB, LDS_OST=LDS_WS+NW*64*4, LDS_BYTES=LDS_OST+NW*4096;
constexpr float C2=0.17677669529663687f*1.4426950408889634f;
__device__ __forceinline__ void glds16(const void*gsrc,unsigned lds_dst){unsigned keep;
  asm volatile("s_mov_b32 %0, m0\n\ts_mov_b32 m0, %2\n\ts_nop 0\n\tglobal_load_lds_dwordx4 %1, off\n\ts_mov_b32 m0, %0":"=&s"(keep):"v"(gsrc),"s"(lds_dst):"memory");}
__device__ __forceinline__ float max3f(float a,float b,float c){float r;asm("v_max3_f32 %0, %1, %2, %3":"=v"(r):"v"(a),"v"(b),"v"(c));return r;}
__device__ __forceinline__ float max2f(float a,float b){float r;asm("v_max_f32_e32 %0, %1, %2":"=v"(r):"v"(a),"v"(b));return r;}
__device__ __forceinline__ float fadd_s(float a,float b){float r;asm("v_add_f32_e32 %0, %1, %2":"=v"(r):"v"(a),"v"(b));return r;}
__device__ __forceinline__ float fsub_s(float a,float b){float r;asm("v_sub_f32_e32 %0, %1, %2":"=v"(r):"v"(a),"v"(b));return r;}
typedef float f32x2_t __attribute__((ext_vector_type(2))); typedef __bf16 bf16x2_t __attribute__((ext_vector_type(2)));
__device__ __forceinline__ unsigned cvtpk_s(float lo,float hi){f32x2_t v={lo,hi};bf16x2_t b=__builtin_convertvector(v,bf16x2_t);return __builtin_bit_cast(unsigned,b);}
#define WAIT_BAR(N) asm volatile("s_waitcnt vmcnt(" #N ") lgkmcnt(0)\n\ts_barrier":::"memory")

__device__ __forceinline__ void qkt(f32x16&p0,f32x16&p1,const char*Kslot,const bf16x8*qr,const f32x16&negm,int r32,int hi){
  const char*kb=Kslot+hi*1024+r32*16;
  #pragma unroll
  for(int d0=0;d0<2;++d0){
    const bf16x8 b0=*reinterpret_cast<const bf16x8*>(kb+d0*2048);
    const bf16x8 b1=*reinterpret_cast<const bf16x8*>(kb+d0*2048+512);
    if(d0==0){p0=__builtin_amdgcn_mfma_f32_32x32x16_bf16(b0,qr[0],negm,0,0,0);p1=__builtin_amdgcn_mfma_f32_32x32x16_bf16(b1,qr[0],negm,0,0,0);}
    else{p0=__builtin_amdgcn_mfma_f32_32x32x16_bf16(b0,qr[d0],p0,0,0,0);p1=__builtin_amdgcn_mfma_f32_32x32x16_bf16(b1,qr[d0],p1,0,0,0);}}
}
typedef __attribute__((address_space(3))) const char* lds_cptr;
typedef short v4i16_t __attribute__((ext_vector_type(4)));
__device__ __forceinline__ void kload8(bf16x8*kf,lds_cptr kp){
  kf[0]=*(const __attribute__((address_space(3))) bf16x8*)(kp);      kf[1]=*(const __attribute__((address_space(3))) bf16x8*)(kp+512);
  kf[2]=*(const __attribute__((address_space(3))) bf16x8*)(kp+2048); kf[3]=*(const __attribute__((address_space(3))) bf16x8*)(kp+2560);
}
__device__ __forceinline__ void kload2(bf16x8*kf,lds_cptr kp,int j){ kf[2*j]=*(const __attribute__((address_space(3))) bf16x8*)(kp+j*2048); kf[2*j+1]=*(const __attribute__((address_space(3))) bf16x8*)(kp+j*2048+512); }
__device__ __forceinline__ s16x4 vtr(lds_cptr p){ return __builtin_bit_cast(s16x4,__builtin_amdgcn_ds_read_tr16_b64_v4i16((__attribute__((address_space(3))) v4i16_t*)p)); }
__device__ __forceinline__ float rowmax(const f32x16&p0,const f32x16&p1){
  float a=max3f(p0[0],p0[1],p1[0]),b=max3f(p0[2],p0[3],p1[1]);a=max3f(a,p1[2],p1[3]);
  #pragma unroll
  for(int r=4;r<16;r+=4){a=max3f(a,p0[r],p0[r+1]);b=max3f(b,p0[r+2],p0[r+3]);a=max3f(a,p1[r],p1[r+1]);b=max3f(b,p1[r+2],p1[r+3]);}
  const float m=max2f(a,b);
  auto rr=__builtin_amdgcn_permlane32_swap(__float_as_uint(m),__float_as_uint(m),false,false);
  return max2f(__uint_as_float(rr[0]),__uint_as_float(rr[1]));
}
__device__ __forceinline__ void pv(f32x16*o,int vb,bf16x8 pa0,bf16x8 pa1,bf16x8 pa2,bf16x8 pa3){
  #pragma unroll
  for(int d0=0;d0<2;++d0){s16x4 lo[4],hi[4];
    #pragma unroll
    for(int ks=0;ks<4;++ks){
      asm volatile("ds_read_b64_tr_b16 %0,%1 offset:%c2":"=&v"(lo[ks]):"v"(vb),"i"(d0*4096+ks*1024):"memory");
      asm volatile("ds_read_b64_tr_b16 %0,%1 offset:%c2":"=&v"(hi[ks]):"v"(vb),"i"(d0*4096+ks*1024+512):"memory");}
    asm volatile("s_waitcnt lgkmcnt(0)":::"memory");SBAR();
    #define PK(k) (bf16x8){lo[k][0],lo[k][1],lo[k][2],lo[k][3],hi[k][0],hi[k][1],hi[k][2],hi[k][3]}
    o[d0]=__builtin_amdgcn_mfma_f32_32x32x16_bf16(pa0,PK(0),o[d0],0,0,0);
    o[d0]=__builtin_amdgcn_mfma_f32_32x32x16_bf16(pa1,PK(1),o[d0],0,0,0);
    o[d0]=__builtin_amdgcn_mfma_f32_32x32x16_bf16(pa2,PK(2),o[d0],0,0,0);
    o[d0]=__builtin_amdgcn_mfma_f32_32x32x16_bf16(pa3,PK(3),o[d0],0,0,0);
    #undef PK
  }
}

template<int THRL> __device__ __forceinline__ void attn_unit(int b,int h,int mp,int qb,const bf16*Q,const bf16*__restrict__ K,const bf16*__restrict__ V,bf16*Y,float lam,float osc,const float*__restrict__ sg,char*shm,int tid){
  asm volatile("":"+v"(tid)); const int lane=tid&63,r32=lane&31,hi=lane>>5; const int wid=__builtin_amdgcn_readfirstlane(tid>>6);
  const long rowbase=(long)b*SEQ; const int q0=qb*QB; const int vh=2*h+mp;
  const bf16*Qw=Q+(rowbase+q0+wid*QBLK)*DM+vh*D;
  const bf16*Kh=K+rowbase*DM+vh*D,*Vh=V+rowbase*VP+h*D;
  const unsigned lds0=(unsigned)(uintptr_t)shm;
  float*wsf=(float*)(shm+LDS_WS)+wid*64;
  const bf16*ksrc=Kh+(long)lane*DM+wid*8;
  const bf16*vsrc=Vh+(long)(16*(wid&3)+(lane>>2))*VP+(wid>>2)*32+(lane&3)*8;
  const unsigned kdst=lds0+LDS_K+wid*1024, vdst=lds0+LDS_V+wid*1024;
  #define DMA_K(t,slot) glds16(ksrc+(long)(t)*KVBLK*DM,(unsigned)__builtin_amdgcn_readfirstlane(kdst+(slot)))
  #define DMA_V(t,slot) glds16(vsrc+(long)(t)*KVBLK*VP,(unsigned)__builtin_amdgcn_readfirstlane(vdst+(slot)))
  const int vb0=(int)(lds0+LDS_V)+((lane>>4)&1)*32+(lane&3)*8+(4*hi+((lane&15)>>2))*64;
  const char*Kbase=shm+LDS_K; bf16x8 kf[4];
  const lds_cptr shm3=(lds_cptr)shm; const lds_cptr kp0=shm3+LDS_K+hi*1024+r32*16; const lds_cptr vp0=shm3+LDS_V+((lane>>4)&1)*32+(lane&3)*8+(4*hi+((lane&15)>>2))*64;
  const int NT=(q0+QB)/KVBLK;
  DMA_K(0,0);DMA_V(0,0);DMA_K(1,SLOTB);
  bf16x8 qr[2];
  #pragma unroll
  for(int d0=0;d0<2;++d0)qr[d0]=*reinterpret_cast<const bf16x8*>(&Qw[(long)r32*DM+d0*16+hi*8]);
  float zz=0.f; asm volatile("":"+v"(zz));
  float mhat=0.f;f32x16 o[3],negm;
  const bf16x8 ones8={(short)0x3F80,(short)0x3F80,(short)0x3F80,(short)0x3F80,(short)0x3F80,(short)0x3F80,(short)0x3F80,(short)0x3F80};
  #pragma unroll
  for(int r=0;r<16;++r){o[0][r]=zz;o[1][r]=zz;o[2][r]=zz;negm[r]=zz;}
  asm volatile("":"+v"(negm));
  const int qrel=wid*QBLK+r32;
  #define CMASK(P0,P1,t) do{int jb_=(t)-(NT-4); if(jb_>=0)cmask(P0,P1,jb_,qrel,hi);}while(0)
  bool resc=false;
  #define START(P0,P1) do{ const float rm=rowmax(P0,P1); resc=false; \
    { const float dl=rm; mhat=fadd_s(mhat,dl); \
      _Pragma("unroll") for(int r=0;r<16;++r){P0[r]=fsub_s(P0[r],dl);P1[r]=fsub_s(P1[r],dl);} \
      _Pragma("unroll") for(int r=0;r<16;++r)negm[r]=-mhat; asm volatile("":"+v"(negm)); } \
    _Pragma("unroll") for(int r=0;r<16;++r)P0[r]=__builtin_amdgcn_exp2f(P0[r]); }while(0)
  #define RESC() do{ if(resc){ asm volatile("s_waitcnt lgkmcnt(0)":::"memory"); \
      _Pragma("unroll") for(int d_=0;d_<3;++d_) _Pragma("unroll") for(int r=0;r<16;++r)o[d_][r]*=wsf[crow(r,hi)]; } }while(0)
  f32x16 pA0,pA1,pB0,pB1;
  int sl_prev=0,sl_cur=0,sl_next=SLOTB;
  #define ROT() do{sl_prev=sl_cur;sl_cur=sl_next;sl_next=(sl_next==(NSLOT-1)*SLOTB)?0:sl_next+SLOTB;}while(0)
  DMA_K(2,2*SLOTB);
  WAIT_BAR(3);
  qkt(pA0,pA1,Kbase,qr,negm,r32,hi);asm volatile("s_nop 15\n\ts_nop 7":"+v"(pA0),"+v"(pA1));CMASK(pA0,pA1,0);
  START(pA0,pA1);
  _Pragma("unroll") for(int r=0;r<16;++r)pA1[r]=__builtin_amdgcn_exp2f(pA1[r]);
  WAIT_BAR(0);
  DMA_K(3,0);DMA_V(1,SLOTB);
  ROT();
  kload8(kf,kp0+sl_cur);
  WAIT_BAR(2);
  s16x4 vlo[8],vhi[8]; u32x4 pw0,pw1,pw2,pw3;
  #define PKW(P,B) cvtpk_s(P[B],P[B+1])
  #define PAF(k) __builtin_bit_cast(bf16x8,pw##k)
  #define VFR(i) (bf16x8){vlo[i][0],vlo[i][1],vlo[i][2],vlo[i][3],vhi[i][0],vhi[i][1],vhi[i][2],vhi[i][3]}
  #define PIN(x) asm volatile("":"+v"(x))
  #define MX3(a,b,c) __builtin_fmaxf(__builtin_fmaxf((a),(b)),(c))
  #define GAPA(MF,W0,W1,PW) do{ MF; W0; W1; PIN(PW); SBAR(); }while(0)
  #define GAPN(W0,W1,PW) do{ W0; W1; PIN(PW); SBAR(); }while(0)
  #define GAPO(k) do{ o[2]=__builtin_amdgcn_mfma_f32_32x32x16_bf16(PAF(k),ones8,o[2],0,0,0); SBAR(); }while(0)
  #define EX(v) __builtin_amdgcn_exp2f(v)
  #define GAPB(MF,X,B) do{ MF; X[B]=EX(X[B]); X[B+1]=EX(X[B+1]); X[B+2]=EX(X[B+2]); X[B+3]=EX(X[B+3]); PIN(X); SBAR(); }while(0)
  #define VRD(i) do{ vlo[i]=vtr(vp_+(((i)>>2)*4096+((i)&3)*1024)); vhi[i]=vtr(vp_+(((i)>>2)*4096+((i)&3)*1024+512)); }while(0)
  #define KRD(G,j) do{ if(G){ kload2(kf,kp0+sl_next,j); SBAR(); } }while(0)
  #define STEP(C0,C1,P0,P1,t,GK,GV,GL) do{ SBAR(); \
    const lds_cptr vp_=vp0+sl_prev; \
    VRD(0); SBAR(); \
    GAPA(C0=__builtin_amdgcn_mfma_f32_32x32x16_bf16(kf[0],qr[0],negm,0,0,0), pw0[0]=PKW(P0,0), pw0[1]=PKW(P0,2), pw0); \
    VRD(4); SBAR(); GAPA(C1=__builtin_amdgcn_mfma_f32_32x32x16_bf16(kf[1],qr[0],negm,0,0,0), pw0[2]=PKW(P0,4), pw0[3]=PKW(P0,6), pw0); \
    VRD(1); SBAR(); GAPA(C0=__builtin_amdgcn_mfma_f32_32x32x16_bf16(kf[2],qr[1],C0,0,0,0),   pw1[0]=PKW(P0,8), pw1[1]=PKW(P0,10), pw1); \
    VRD(5); SBAR(); GAPA(C1=__builtin_amdgcn_mfma_f32_32x32x16_bf16(kf[3],qr[1],C1,0,0,0),   pw1[2]=PKW(P0,12),pw1[3]=PKW(P0,14), pw1); \
    VRD(2); SBAR(); GAPN(pw2[0]=PKW(P1,0), pw2[1]=PKW(P1,2), pw2); \
    VRD(6); SBAR(); GAPN(pw2[2]=PKW(P1,4), pw2[3]=PKW(P1,6), pw2); \
    VRD(3); SBAR(); GAPN(pw3[0]=PKW(P1,8), pw3[1]=PKW(P1,10), pw3); \
    VRD(7); SBAR(); GAPN(pw3[2]=PKW(P1,12),pw3[3]=PKW(P1,14), pw3); \
    if(GK){DMA_K((t)+3,sl_cur);} if(GV){DMA_V((t)+1,sl_next);} \
    CMASK(C0,C1,t); \
    { float a=MX3(C0[0],C0[1],C1[0]),b=MX3(C0[2],C0[3],C1[1]); a=MX3(a,C1[2],C1[3]); \
      _Pragma("unroll") for(int r=4;r<16;r+=4){a=MX3(a,C0[r],C0[r+1]);b=MX3(b,C0[r+2],C0[r+3]);a=MX3(a,C1[r],C1[r+1]);b=MX3(b,C1[r+2],C1[r+3]);} \
      float rm=__builtin_fmaxf(a,b); { auto rr=__builtin_amdgcn_permlane32_swap(__float_as_uint(rm),__float_as_uint(rm),false,false); rm=__builtin_fmaxf(__uint_as_float(rr[0]),__uint_as_float(rr[1])); } \
      resc=false; \
      if(__builtin_expect(__any(rm>(float)THRL),0)){ const float dl=__builtin_fmaxf(rm,0.f); mhat+=dl; \
        _Pragma("unroll") for(int r=0;r<16;++r){C0[r]-=dl;C1[r]-=dl;} \
        _Pragma("unroll") for(int r=0;r<16;++r)negm[r]=-mhat; asm volatile("":"+v"(negm)); \
        const float f=__builtin_amdgcn_exp2f(-dl); if(hi==0)wsf[r32]=f; resc=true; } } \
    SBAR(); \
    GAPB(o[0]=__builtin_amdgcn_mfma_f32_32x32x16_bf16(PAF(0),VFR(0),o[0],0,0,0), C0,0); \
    GAPB(o[1]=__builtin_amdgcn_mfma_f32_32x32x16_bf16(PAF(0),VFR(4),o[1],0,0,0), C0,4); GAPO(0); \
    KRD(GL,0); GAPB(o[0]=__builtin_amdgcn_mfma_f32_32x32x16_bf16(PAF(1),VFR(1),o[0],0,0,0), C0,8); \
    KRD(GL,1); GAPB(o[1]=__builtin_amdgcn_mfma_f32_32x32x16_bf16(PAF(1),VFR(5),o[1],0,0,0), C0,12); GAPO(1); \
    GAPB(o[0]=__builtin_amdgcn_mfma_f32_32x32x16_bf16(PAF(2),VFR(2),o[0],0,0,0), C1,0); \
    GAPB(o[1]=__builtin_amdgcn_mfma_f32_32x32x16_bf16(PAF(2),VFR(6),o[1],0,0,0), C1,4); GAPO(2); \
    GAPB(o[0]=__builtin_amdgcn_mfma_f32_32x32x16_bf16(PAF(3),VFR(3),o[0],0,0,0), C1,8); \
    GAPB(o[1]=__builtin_amdgcn_mfma_f32_32x32x16_bf16(PAF(3),VFR(7),o[1],0,0,0), C1,12); GAPO(3); \
    }while(0)
  int t=1;
  #undef CMASK
  #define CMASK(P0,P1,t) do{}while(0)
  for(;t+5<NT;t+=2){
    STEP(pB0,pB1,pA0,pA1,t,true,true,true);     WAIT_BAR(2); RESC(); ROT();
    STEP(pA0,pA1,pB0,pB1,t+1,true,true,true);   WAIT_BAR(2); RESC(); ROT();
  }
  #undef CMASK
  #define CMASK(P0,P1,t) do{int jb_=(t)-(NT-4); if(jb_>=0)cmask(P0,P1,jb_,qrel,hi);}while(0)
  #define ENDW(tt) do{ if((tt)+3<NT){WAIT_BAR(2);} else if((tt)+2<NT){WAIT_BAR(1);} else {WAIT_BAR(0);} }while(0)
  for(;t+1<NT;t+=2){
    STEP(pB0,pB1,pA0,pA1,t,(t+3<NT),(t+1<NT),(t+1<NT));       ENDW(t);   RESC(); ROT();
    STEP(pA0,pA1,pB0,pB1,t+1,(t+4<NT),(t+2<NT),(t+2<NT));     ENDW(t+1); RESC(); ROT();
  }
  STEP(pB0,pB1,pA0,pA1,NT-1,false,false,false); RESC();
  {
    pw0=(u32x4){PKW(pB0,0),PKW(pB0,2),PKW(pB0,4),PKW(pB0,6)};pw1=(u32x4){PKW(pB0,8),PKW(pB0,10),PKW(pB0,12),PKW(pB0,14)};pw2=(u32x4){PKW(pB1,0),PKW(pB1,2),PKW(pB1,4),PKW(pB1,6)};pw3=(u32x4){PKW(pB1,8),PKW(pB1,10),PKW(pB1,12),PKW(pB1,14)};
    SBAR(); pv(o,vb0+sl_cur,PAF(0),PAF(1),PAF(2),PAF(3));
    o[2]=__builtin_amdgcn_mfma_f32_32x32x16_bf16(PAF(0),ones8,o[2],0,0,0); o[2]=__builtin_amdgcn_mfma_f32_32x32x16_bf16(PAF(1),ones8,o[2],0,0,0);
    o[2]=__builtin_amdgcn_mfma_f32_32x32x16_bf16(PAF(2),ones8,o[2],0,0,0); o[2]=__builtin_amdgcn_mfma_f32_32x32x16_bf16(PAF(3),ones8,o[2],0,0,0); }
  #undef PKW
  #undef PAF
  #undef VFR
  #undef PIN
  #undef MX3
  #undef GAPA
  #undef GAPN
  #undef GAPO
  #undef GAPB
  #undef EX
  #undef VRD
  #undef KRD
  #undef STEP
  #undef ENDW
  float rli[16];
  #pragma unroll
  for(int r=0;r<16;++r)rli[r]=__builtin_amdgcn_rcpf(o[2][r]);
  { bf16*stg=(bf16*)(shm+LDS_OST)+wid*2048;
    if(mp==0){
      #pragma unroll
      for(int r=0;r<16;++r){const int orow=crow(r,hi);
        #pragma unroll
        for(int d0=0;d0<2;++d0)stg[orow*64+d0*32+r32]=(bf16)(cvtpk_s(o[d0][r]*rli[r],0.f)&0xffffu);}
    } else {
      #pragma unroll
      for(int r=0;r<16;++r){const int orow=crow(r,hi);
        #pragma unroll
        for(int d0=0;d0<2;++d0){const float o1=__uint_as_float(((unsigned)stg[orow*64+d0*32+r32])<<16); stg[orow*64+d0*32+r32]=(bf16)(cvtpk_s(o1-lam*(o[d0][r]*rli[r]),0.f)&0xffffu);}}
      asm volatile("s_waitcnt lgkmcnt(0)":::"memory");
      bf16*Yw=Y+(rowbase+q0+wid*QBLK)*256+h*D;
      const int ch=lane&7; const f32x4 g0=*(const f32x4*)(sg+ch*8),g1=*(const f32x4*)(sg+ch*8+4);
      #pragma unroll
      for(int i=0;i<4;++i){const int row=i*8+(lane>>3); const u32x4 v=*(const u32x4*)(stg+row*64+ch*8);
        float f[8]; f[0]=__uint_as_float(v.x<<16);f[1]=__uint_as_float(v.x&0xffff0000u);f[2]=__uint_as_float(v.y<<16);f[3]=__uint_as_float(v.y&0xffff0000u);
        f[4]=__uint_as_float(v.z<<16);f[5]=__uint_as_float(v.z&0xffff0000u);f[6]=__uint_as_float(v.w<<16);f[7]=__uint_as_float(v.w&0xffff0000u);
        float ss=(f[0]*f[0]+f[1]*f[1])+(f[2]*f[2]+f[3]*f[3])+(f[4]*f[4]+f[5]*f[5])+(f[6]*f[6]+f[7]*f[7]);
        ss+=__shfl_xor(ss,1);ss+=__shfl_xor(ss,2);ss+=__shfl_xor(ss,4);
        const float rs=__builtin_amdgcn_rsqf(ss*(1.f/64.f)+1e-5f)*osc;
        u32x4 w; w.x=cvtpk_s(f[0]*rs*g0[0],f[1]*rs*g0[1]); w.y=cvtpk_s(f[2]*rs*g0[2],f[3]*rs*g0[3]); w.z=cvtpk_s(f[4]*rs*g1[0],f[5]*rs*g1[1]); w.w=cvtpk_s(f[6]*rs*g1[2],f[7]*rs*g1[3]);
        *(u32x4*)(Yw+(long)row*256+ch*8)=w;}
    } }
  asm volatile("s_waitcnt lgkmcnt(0)\n\ts_barrier":::"memory");
  #undef DMA_K
  #undef DMA_V
  #undef CMASK
  #undef START
  #undef RESC
  #undef ROT
}
constexpr int ATTN_LDS_BYTES=LDS_BYTES;
#undef SBAR
#undef WAIT_BAR
}
#define GAS __attribute__((address_space(1)))
#define LAS __attribute__((address_space(3)))
typedef unsigned short bf16;
typedef unsigned v4u __attribute__((ext_vector_type(4)));
typedef float f32x4 __attribute__((ext_vector_type(4)));
typedef short bf16x8 __attribute__((ext_vector_type(8)));
typedef GAS unsigned gu32;
typedef GAS unsigned long long gu64;
#define RLX_AGENT __ATOMIC_RELAXED, __HIP_MEMORY_SCOPE_AGENT
#define LDS_WAIT() asm volatile("s_waitcnt lgkmcnt(0)" ::: "memory")
#define VM_WAIT() asm volatile("s_waitcnt vmcnt(0)" ::: "memory")
__device__ __forceinline__ unsigned long long rt() { return __builtin_amdgcn_s_memrealtime(); }
__device__ __forceinline__ unsigned f2bf(float f) { unsigned u = __builtin_bit_cast(unsigned, f); return (u + 0x7fffu + ((u >> 16) & 1u)) >> 16; }
__device__ __forceinline__ unsigned pk2(float lo, float hi) { return f2bf(lo) | (f2bf(hi) << 16); }

#define XB_TMO      128
#define XB_XCNT(j)  (256  + 64 * (j))
#define XB_XSUB(j)  (1280 + 64 * (j))
#define XB_XGEN(j)  (2304 + 64 * (j))
#define XB_TOP      3328
#define XB_TOPGEN   3392
#define XCD_BAR_WORDS 3456
#define XB_SPIN_CAP (1u << 18)

__device__ __forceinline__ unsigned xb_ld(unsigned* p)              { return __hip_atomic_load(p, __ATOMIC_RELAXED, __HIP_MEMORY_SCOPE_AGENT); }
__device__ __forceinline__ unsigned xb_add(unsigned* p, unsigned v) { return __hip_atomic_fetch_add(p, v, __ATOMIC_RELAXED, __HIP_MEMORY_SCOPE_AGENT); }
__device__ __forceinline__ unsigned xb_xcc_id() { return (unsigned)__builtin_amdgcn_s_getreg((3 << 11) | 20) & 0xFu; }
#define XB_SPIN(cond, bar) do { unsigned _sp = 0; while (cond) { __builtin_amdgcn_s_sleep(1); \
    if ((++_sp & 255u) == 0u) { if (xb_ld(&(bar)[XB_TMO])) break; if (_sp > XB_SPIN_CAP) { atomicAdd(&(bar)[XB_TMO], 1u); break; } } } } while (0)

struct XcdBarrier {
    unsigned* bar; unsigned x;
    unsigned off;
    unsigned G;
    int wave;
    volatile LAS unsigned* st;
};

__device__ __forceinline__ int xb_lane_id() { int l; asm volatile("v_mbcnt_lo_u32_b32 %0, -1, 0\n\tv_mbcnt_hi_u32_b32 %0, -1, %0" : "=v"(l)); return l; }
__device__ __forceinline__ bool xb_thread0(int wave) { asm volatile("" : "+s"(wave)); return wave == 0 && xb_lane_id() == 0; }
__device__ __forceinline__ XcdBarrier xcd_barrier_post(unsigned* bar, unsigned off, volatile LAS unsigned* st, int wave) {
    XcdBarrier b; b.bar = bar; b.off = off; b.x = xb_xcc_id(); b.st = st; b.wave = wave; b.G = gridDim.x * gridDim.y * gridDim.z;
    if (xb_thread0(wave)) (void)xb_add(&bar[off + XB_XCNT(b.x)], 1u);
    return b;
}
__device__ __forceinline__ void xcd_barrier_complete(unsigned* bar, unsigned x, unsigned G, unsigned& nloc, unsigned& nx) {
    unsigned sum, cnt, mine, sp = 0u;
    for (;;) {
        sum = 0u; cnt = 0u; mine = 0u;
#pragma unroll
        for (unsigned j = 0; j < 16; ++j) { const unsigned c = xb_ld(&bar[XB_XCNT(j)]); sum += c; cnt += (c > 0u) ? 1u : 0u; }
        mine = xb_ld(&bar[XB_XCNT(x)]);
        if (sum == G) break;
        __builtin_amdgcn_s_sleep(1);
        if ((++sp & 255u) == 0u) { if (xb_ld(&bar[XB_TMO])) break; if (sp > XB_SPIN_CAP) { atomicAdd(&bar[XB_TMO], 1u); break; } }
    }
    nloc = mine > 0u ? mine : 1u; nx = cnt > 0u ? cnt : 1u;
}

__device__ __forceinline__ void xcd_barrier(const XcdBarrier& b) {
    asm volatile("s_waitcnt vmcnt(0)" ::: "memory");
    __syncthreads();
    if (xb_thread0(b.wave)) {
        GAS unsigned* barg = (GAS unsigned*)b.bar; asm volatile("" : "+s"(barg)); unsigned* bar = (unsigned*)barg + b.off; const unsigned bx_ = xb_xcc_id();
        __builtin_amdgcn_s_waitcnt(0);
        unsigned nloc = b.st[0], nx = b.st[1];
        if (nloc == 0u) { xcd_barrier_complete(bar, bx_, b.G, nloc, nx); b.st[0] = nloc; b.st[1] = nx; }
        const unsigned old = xb_add(&bar[XB_XSUB(bx_)], 1u);
        const unsigned gen = old / nloc;
        if (old + 1u == (gen + 1u) * nloc) {
            __builtin_amdgcn_fence(__ATOMIC_RELEASE, "agent");
            asm volatile("s_waitcnt vmcnt(0)" ::: "memory");
            const unsigned og = xb_add(&bar[XB_TOP], 1u);
            const unsigned tg = og / nx;
            if (og + 1u == (tg + 1u) * nx) xb_add(&bar[XB_TOPGEN], 1u);
            else XB_SPIN(xb_ld(&bar[XB_TOPGEN]) == tg, bar);
            __builtin_amdgcn_fence(__ATOMIC_ACQUIRE, "agent");
            xb_add(&bar[XB_XGEN(bx_)], 1u);
            asm volatile("s_waitcnt vmcnt(0)" ::: "memory");
        } else {
            XB_SPIN(xb_ld(&bar[XB_XGEN(bx_)]) == gen, bar);
            __builtin_amdgcn_fence(__ATOMIC_ACQUIRE, "agent");
            asm volatile("s_waitcnt vmcnt(0)" ::: "memory");
        }
    }
    __syncthreads();
}
constexpr size_t KiB = 1u << 10, MiB = 1u << 20;
constexpr size_t WS_CTL = 0, CTL_ZERO_BYTES = 64 * KiB;
constexpr size_t TB_ROPEC = 1 * MiB, TB_ROPES = TB_ROPEC + 256 * KiB;
constexpr size_t TB_PWT = TB_ROPES + 256 * KiB;
constexpr size_t TB_SGW = TB_PWT + 64 * KiB;
constexpr size_t TB_HIST = TB_SGW + 256 * KiB;
constexpr size_t TB_TOKC = TB_HIST + 32 * KiB;
constexpr size_t TB_TOKW = TB_TOKC + 128 * KiB;
constexpr size_t TB_ROWTOK = TB_TOKW + 256 * KiB;
constexpr size_t TB_ROWW = TB_ROWTOK + 160 * KiB;
static_assert(TB_ROWW + 320 * KiB <= 3 * MiB, "tables");
constexpr size_t W_IN = 3 * MiB;
constexpr size_t W_G8 = W_IN + (size_t)NPB * DMODEL * 2;
constexpr size_t W_B = W_G8 + 4 * MiB;
constexpr size_t W_O = W_B + 2 * MiB;
constexpr size_t W_GU = W_O + 2 * MiB;
constexpr size_t W_D = W_GU + 16 * MiB;
static_assert(W_D + 8 * MiB <= 44 * MiB, "weights");
constexpr size_t WS_XB = 44 * MiB;
constexpr size_t WS_X = 108 * MiB;
constexpr size_t WS_QKY = 236 * MiB;
constexpr size_t WS_QP = WS_QKY, WS_KP = WS_QKY + 32 * MiB, WS_YA = WS_QKY + 64 * MiB;
constexpr size_t WS_X8 = WS_X, WS_X18 = WS_X + 32 * MiB;
constexpr size_t WS_P = 364 * MiB;
constexpr size_t WS_MG = WS_P, WS_XS = WS_P, WS_HB = WS_P + 80 * MiB;
constexpr size_t WS_END = 508 * MiB;
static_assert(WS_P + (size_t)M * NPB * 2 <= WS_END && WS_HB + (size_t)MAXROWS * 512 * 2 <= WS_END && WS_XS + (size_t)MAXROWS * 1024 * 2 <= WS_HB, "d_ws map");
constexpr int CW_TMO = 0, CW_BAR = 4096, CW_CNT = 8192;
constexpr int CAP = 32768;
constexpr size_t TB2_ROWTOK = WS_X + 64 * MiB, TB2_ROWW = WS_X + 68 * MiB;
static_assert((CW_CNT + 2 * 2048) * 4 <= (int)CTL_ZERO_BYTES && TB2_ROWW + (size_t)NCLS * CAP * 8 <= WS_X + 128 * MiB, "class tables");
constexpr int RING_OFF = 0, RING_BYTES = 131072;
constexpr int LDSCTL_OFF = RING_BYTES, MISC_OFF = LDSCTL_OFF + 320, LDSX_OFF = LDSCTL_OFF + 1024;
constexpr int LDS_BYTES = 147456;
constexpr int NWAVES = 8;
constexpr int NPHASE = 1 + 10 * DEPTH;

struct Frame {
    LAS unsigned char* lds;
    gu32* ctl;
    int tid, lane, wave, vcu, G, bx;
    float* out; unsigned char* ws;
};
typedef const GAS float* cgfptr_t;
__device__ __forceinline__ const float* arg_in(int k) {
    const __attribute__((address_space(4))) char* ka = (const __attribute__((address_space(4))) char*)__builtin_amdgcn_kernarg_segment_ptr();
    asm volatile("" : "+s"(ka));
    const GAS float* p = *(const __attribute__((address_space(4))) cgfptr_t*)(ka + 8 * k);
    return (const float*)p;
}
__device__ __forceinline__ float dpp_add(float v, const int ctrl_sel) {
    const int x = __builtin_bit_cast(int, v); int y;
    if (ctrl_sel == 0) y = __builtin_amdgcn_update_dpp(0, x, 0xB1, 0xf, 0xf, true);
    else if (ctrl_sel == 1) y = __builtin_amdgcn_update_dpp(0, x, 0x4E, 0xf, 0xf, true);
    else if (ctrl_sel == 2) y = __builtin_amdgcn_update_dpp(0, x, 0x141, 0xf, 0xf, true);
    else y = __builtin_amdgcn_update_dpp(0, x, 0x140, 0xf, 0xf, true);
    return v + __builtin_bit_cast(float, y);
}
__device__ __forceinline__ float wave_sum(float v) {
    v = dpp_add(v, 0); v = dpp_add(v, 1); v = dpp_add(v, 2); v = dpp_add(v, 3);
    const int x = __builtin_bit_cast(int, v);
    const float a = __builtin_bit_cast(float, __builtin_amdgcn_readlane(x, 0)), b = __builtin_bit_cast(float, __builtin_amdgcn_readlane(x, 16));
    const float c = __builtin_bit_cast(float, __builtin_amdgcn_readlane(x, 32)), d = __builtin_bit_cast(float, __builtin_amdgcn_readlane(x, 48));
    return (a + b) + (c + d);
}
__device__ __forceinline__ unsigned cvtpk(float lo, float hi) { unsigned r; asm volatile("v_cvt_pk_bf16_f32 %0, %1, %2" : "=v"(r) : "v"(lo), "v"(hi)); return r; }
__device__ __forceinline__ float bflo(unsigned w) { return __uint_as_float(w << 16); }
__device__ __forceinline__ float bfhi(unsigned w) { return __uint_as_float(w & 0xffff0000u); }
typedef float f32x2g __attribute__((ext_vector_type(2)));
typedef unsigned u32x2g __attribute__((ext_vector_type(2)));

__device__ __forceinline__ void transpose_item(const float* W, int N, bf16* WT, int ldt, int dst_row0, int k0, int n0, LAS float* scr, int lane) {
#pragma unroll 8
    for (int i = 0; i < 32; ++i) { const int kk = 2 * i + (lane >> 5); scr[kk * 33 + (lane & 31)] = W[(size_t)(k0 + kk) * N + n0 + (lane & 31)]; }
    LDS_WAIT(); asm volatile("" ::: "memory");
    const int c = lane & 7;
#pragma unroll
    for (int j = 0; j < 4; ++j) { const int n = (lane >> 3) + 8 * j; const LAS float* s = scr + (8 * c) * 33 + n;
        v4u o; o.x = pk2(s[0 * 33], s[1 * 33]); o.y = pk2(s[2 * 33], s[3 * 33]); o.z = pk2(s[4 * 33], s[5 * 33]); o.w = pk2(s[6 * 33], s[7 * 33]);
        *(v4u*)(WT + (size_t)(dst_row0 + n) * ldt + k0 + 8 * c) = o; }
    LDS_WAIT(); asm volatile("" ::: "memory");
}
__device__ __forceinline__ void transpose_item8(const float* W, int N, unsigned char* WT, int ldt, int dst_row0, int k0, int n0, float scale, LAS float* scr, int lane) {
#pragma unroll 8
    for (int i = 0; i < 32; ++i) { const int kk = 2 * i + (lane >> 5); scr[kk * 33 + (lane & 31)] = W[(size_t)(k0 + kk) * N + n0 + (lane & 31)]; }
    LDS_WAIT(); asm volatile("" ::: "memory");
    const int c = lane & 7;
#pragma unroll
    for (int j = 0; j < 4; ++j) { const int n = (lane >> 3) + 8 * j; const LAS float* s = scr + (8 * c) * 33 + n;
        int lo = 0, hi = 0;
        lo = __builtin_amdgcn_cvt_pk_fp8_f32(s[0 * 33] * scale, s[1 * 33] * scale, lo, false); lo = __builtin_amdgcn_cvt_pk_fp8_f32(s[2 * 33] * scale, s[3 * 33] * scale, lo, true);
        hi = __builtin_amdgcn_cvt_pk_fp8_f32(s[4 * 33] * scale, s[5 * 33] * scale, hi, false); hi = __builtin_amdgcn_cvt_pk_fp8_f32(s[6 * 33] * scale, s[7 * 33] * scale, hi, true);
        *(u32x2g*)(WT + (size_t)(dst_row0 + n) * ldt + k0 + 8 * c) = (u32x2g){(unsigned)lo, (unsigned)hi}; }
    LDS_WAIT(); asm volatile("" ::: "memory");
}
__device__ __forceinline__ void convert_weights(Frame& F, int l, int w0 = 0, int nw = NWAVES) {
    if (F.wave < w0 || F.wave >= w0 + nw) return;
    LAS float* scr = (LAS float*)(F.lds + RING_OFF + F.wave * 16384);
    const int gw = F.vcu * nw + (F.wave - w0), NGW = F.G * nw;
    bf16* Win = (bf16*)(F.ws + W_IN); unsigned char* Wg8 = F.ws + W_G8; bf16* Wb = (bf16*)(F.ws + W_B); bf16* Wo = (bf16*)(F.ws + W_O); bf16* Wgu = (bf16*)(F.ws + W_GU); bf16* Wd = (bf16*)(F.ws + W_D);
    constexpr int I_IN = 16 * 200, I_B = 512, I_O = 512, I_G = 2048, I_D = 2048, NITEMS = I_IN + I_B + I_O + 2 * I_G + I_D;
    for (int it = gw; it < NITEMS; it += NGW) {
        int r = it;
        if (r < I_IN) { const int kb = r / 200, nb = r % 200; const float* w = arg_in(1) + (size_t)l * DMODEL * NIN;
            if (nb < NPB / 32) transpose_item(w, NIN, Win, DMODEL, 32 * nb, 64 * kb, 32 * nb, scr, F.lane);
            else transpose_item8(w, NIN, Wg8, DMODEL, 32 * nb - NPB, 64 * kb, 32 * nb, pg8::FP8_WS, scr, F.lane);
            continue; } r -= I_IN;
        if (r < I_B) { const int br = r >> 7, q = r & 127, kb = q >> 5, nb = q & 31; transpose_item(arg_in(14) + (size_t)(l * 4 + br) * 256 * DMODEL, DMODEL, Wb + (size_t)br * DMODEL * 256, 256, 32 * nb, 64 * kb, 32 * nb, scr, F.lane); continue; } r -= I_B;
        if (r < I_O) { const int kb = r >> 5, nb = r & 31; transpose_item(arg_in(15) + (size_t)l * DMODEL * DMODEL, DMODEL, Wo, DMODEL, 32 * nb, 64 * kb, 32 * nb, scr, F.lane); continue; } r -= I_O;
        if (r < 2 * I_G) { const int up = r >= I_G; if (up) r -= I_G; const int e = r >> 7, q = r & 127, kb = q >> 3, nb = q & 7, n0 = 32 * nb;
            transpose_item8((up ? arg_in(23) : arg_in(22)) + (size_t)(l * 16 + e) * DMODEL * 256, 256, (unsigned char*)Wgu + (size_t)e * 512 * DMODEL, DMODEL, 256 * (n0 >> 7) + (n0 & 127) + (up ? 128 : 0), 64 * kb, n0, pg8::FP8_WS, scr, F.lane); continue; } r -= 2 * I_G;
        { const int e = r >> 7, q = r & 127, kb = q >> 5, nb = q & 31; transpose_item8(arg_in(24) + (size_t)(l * 16 + e) * 256 * DMODEL, DMODEL, (unsigned char*)Wd + (size_t)e * DMODEL * 256, 256, 32 * nb, 64 * kb, 32 * nb, pg8::FP8_WS, scr, F.lane); }
    }
}
__device__ __forceinline__ void p0_prologue(Frame& F) {
    constexpr int XW = 8;
    convert_weights(F, 0);
    const int gt = F.vcu * 512 + F.tid, NT = F.G * 512;
    if (F.wave < XW) { const float* x = arg_in(0); bf16* xb = (bf16*)(F.ws + WS_XB); unsigned char* x8 = F.ws + WS_X8; const int gx = (F.vcu * XW + F.wave) * 64 + F.lane, NX = F.G * XW * 64, NI = M * DMODEL / 8;
      for (int i0 = gx; i0 < NI; i0 += 4 * NX) { f32x4 a[4], b[4];
#pragma unroll
          for (int u = 0; u < 4; ++u) { const int i = i0 + u * NX; if (i < NI) { a[u] = *(const f32x4*)(x + (size_t)i * 8); b[u] = *(const f32x4*)(x + (size_t)i * 8 + 4); } }
#pragma unroll
          for (int u = 0; u < 4; ++u) { const int i = i0 + u * NX; if (i < NI) {
              v4u o; o.x = cvtpk(a[u][0], a[u][1]); o.y = cvtpk(a[u][2], a[u][3]); o.z = cvtpk(b[u][0], b[u][1]); o.w = cvtpk(b[u][2], b[u][3]); *(v4u*)(xb + (size_t)i * 8) = o;
              const float s = pg8::FP8_XS;
              *(u32x2g*)(x8 + (size_t)i * 8) = (u32x2g){pg8::fp8_pk4(a[u][0] * s, a[u][1] * s, a[u][2] * s, a[u][3] * s), pg8::fp8_pk4(b[u][0] * s, b[u][1] * s, b[u][2] * s, b[u][3] * s)}; } } } }
    { float* rc = (float*)(F.ws + TB_ROPEC); float* rs = (float*)(F.ws + TB_ROPES);
      for (int i = gt; i < SEQ * 16; i += NT) { const int pos = i >> 4, j = i & 15;
          const float inv = (float)exp2(-(double)j * (13.287712379549449 / 16.0)); const float ang = (float)pos * inv;
          const double a = (double)ang; const double k = rint(a * 0.15915494309189535); const float r = (float)(a - k * 6.283185307179586);
          rc[i] = cosf(r); rs[i] = sinf(r); } }
    { bf16* pwt = (bf16*)(F.ws + TB_PWT); const float* pw = arg_in(2);
      for (int i = gt; i < 2 * 4 * 64 * 64; i += NT) { const int c = i & 63, d = (i >> 6) & 63, lg = i >> 12; pwt[i] = (bf16)f2bf(pw[(size_t)lg * 4096 + c * 64 + d]); }
      bf16* sgw = (bf16*)(F.ws + TB_SGW); const float* sw = arg_in(12);
      for (int i = gt; i < 2 * 4 * 128 * 128; i += NT) { const int s = i & 127, t = (i >> 7) & 127; sgw[i] = (s <= t) ? (bf16)f2bf(sw[i]) : (bf16)0; } }
}

constexpr int VTP = 136;
__device__ __forceinline__ void unpack8(const v4u v, float (&f)[8]) { f[0] = bflo(v.x); f[1] = bfhi(v.x); f[2] = bflo(v.y); f[3] = bfhi(v.y); f[4] = bflo(v.z); f[5] = bfhi(v.z); f[6] = bflo(v.w); f[7] = bfhi(v.w); }
__device__ __forceinline__ v4u pack8(const float (&f)[8]) { v4u w; w.x = cvtpk(f[0], f[1]); w.y = cvtpk(f[2], f[3]); w.z = cvtpk(f[4], f[5]); w.w = cvtpk(f[6], f[7]); return w; }
template <int WIN> __device__ __forceinline__ void pool_item(const bf16* P, const bf16* pwt_g, const float* psc, bf16* YA, int g, int row0, int pos0, int tb, int r32, int hi) {
    const int t = 32 * tb + r32, pos = pos0 + t; const size_t row = (size_t)(row0 + t);
    const int cnt = (pos + 1 < WIN) ? pos + 1 : WIN; const float rcnt = 1.0f / (float)cnt;
    attn_body::f32x16 acc0 = {}, acc1 = {};
#pragma unroll
    for (int ks = 0; ks < 4; ++ks) { const bf16* src = P + row * NPB + PC_POOL + 64 * g + 16 * ks + 8 * hi;
        v4u v[WIN];
#pragma unroll
        for (int j = 0; j < WIN; ++j) v[j] = *(const v4u*)(src - (size_t)(j < cnt ? j : 0) * NPB);
        float s[8], a0[8]; unpack8(v[0], a0);
#pragma unroll
        for (int e = 0; e < 8; ++e) s[e] = a0[e];
#pragma unroll
        for (int j = 1; j < WIN; ++j) { float x[8]; unpack8(v[j], x); const float m = j < cnt ? 1.f : 0.f;
#pragma unroll
            for (int e = 0; e < 8; ++e) s[e] += m * x[e]; }
        float d[8];
#pragma unroll
        for (int e = 0; e < 8; ++e) d[e] = s[e] * rcnt - a0[e];
        const bf16x8 dfr = __builtin_bit_cast(bf16x8, pack8(d));
        const bf16x8 w0 = *(const bf16x8*)(pwt_g + (size_t)r32 * 64 + 16 * ks + 8 * hi), w1 = *(const bf16x8*)(pwt_g + (size_t)(32 + r32) * 64 + 16 * ks + 8 * hi);
        acc0 = __builtin_amdgcn_mfma_f32_32x32x16_bf16(w0, dfr, acc0, 0, 0, 0); acc1 = __builtin_amdgcn_mfma_f32_32x32x16_bf16(w1, dfr, acc1, 0, 0, 0); }
#pragma unroll
    for (int q4 = 0; q4 < 4; ++q4) { const int c0 = 64 * g + 8 * q4 + 4 * hi; const f32x4 p0 = *(const f32x4*)(psc + c0), p1 = *(const f32x4*)(psc + c0 + 32);
        u32x2g w; w.x = cvtpk(acc0[4 * q4 + 0] * p0[0], acc0[4 * q4 + 1] * p0[1]); w.y = cvtpk(acc0[4 * q4 + 2] * p0[2], acc0[4 * q4 + 3] * p0[3]); *(u32x2g*)(YA + row * 256 + c0) = w;
        w.x = cvtpk(acc1[4 * q4 + 0] * p1[0], acc1[4 * q4 + 1] * p1[1]); w.y = cvtpk(acc1[4 * q4 + 2] * p1[2], acc1[4 * q4 + 3] * p1[3]); *(u32x2g*)(YA + row * 256 + c0 + 32) = w; }
}
__device__ __forceinline__ void prep_unit(Frame& F, int ch, int l) {
    const bf16* P = (const bf16*)(F.ws + WS_P);
    int tid = F.tid; asm volatile("" : "+v"(tid)); const int row0 = ch * 128, pos0 = (ch & 31) * 128, lane = tid & 63, wave = F.wave;
    { bf16* YB = (bf16*)(F.ws + WS_YA) + (size_t)1 * M * 256; const float* cw = arg_in(4) + (size_t)l * 3 * 256; const int c8 = (tid & 31) * 8;
      float w0[8], w1[8], w2[8];
      { const f32x4 a = *(const f32x4*)(cw + c8), b = *(const f32x4*)(cw + c8 + 4), c = *(const f32x4*)(cw + 256 + c8), d = *(const f32x4*)(cw + 256 + c8 + 4), e = *(const f32x4*)(cw + 512 + c8), g = *(const f32x4*)(cw + 512 + c8 + 4);
#pragma unroll
        for (int i = 0; i < 4; ++i) { w0[i] = a[i]; w0[4 + i] = b[i]; w1[i] = c[i]; w1[4 + i] = d[i]; w2[i] = e[i]; w2[4 + i] = g[i]; } }
      for (int bt = 0; bt < 2; ++bt) { v4u gb[4], gc[4][3], hh[4][3];
#pragma unroll
          for (int u = 0; u < 4; ++u) { const int r = (tid >> 5) + 16 * (bt * 4 + u); const int pos = pos0 + r; const bf16* pr = P + (size_t)(row0 + r) * NPB;
              gb[u] = *(const v4u*)(pr + PC_GB + c8);
#pragma unroll
              for (int j = 0; j < 3; ++j) { const bf16* pj = pr - (size_t)(pos - j >= 0 ? j : 0) * NPB; gc[u][j] = *(const v4u*)(pj + PC_GC + c8); hh[u][j] = *(const v4u*)(pj + PC_H + c8); } }
#pragma unroll
          for (int u = 0; u < 4; ++u) { const int r = (tid >> 5) + 16 * (bt * 4 + u); const int pos = pos0 + r;
              float g[8], z0[8], z1[8], z2[8], a[8], b[8]; unpack8(gb[u], g);
              unpack8(gc[u][0], a); unpack8(hh[u][0], b);
#pragma unroll
              for (int e = 0; e < 8; ++e) z0[e] = a[e] * b[e];
              unpack8(gc[u][1], a); unpack8(hh[u][1], b); const float m1 = pos >= 1 ? 1.f : 0.f;
#pragma unroll
              for (int e = 0; e < 8; ++e) z1[e] = a[e] * b[e] * m1;
              unpack8(gc[u][2], a); unpack8(hh[u][2], b); const float m2 = pos >= 2 ? 1.f : 0.f;
#pragma unroll
              for (int e = 0; e < 8; ++e) z2[e] = a[e] * b[e] * m2;
              float o[8];
#pragma unroll
              for (int e = 0; e < 8; ++e) o[e] = g[e] * (w0[e] * z2[e] + w1[e] * z1[e] + w2[e] * z0[e]);
              *(v4u*)(YB + (size_t)(row0 + r) * 256 + c8) = pack8(o); } } }
    LAS bf16* VT = (LAS bf16*)(F.lds + RING_OFF);
    { const float* lg = arg_in(10) + l * 256; const float* lb = arg_in(11) + l * 256; const f32x4 g4 = *(const f32x4*)(lg + 4 * lane), b4 = *(const f32x4*)(lb + 4 * lane);
      for (int bt = 0; bt < 4; ++bt) { u32x2g v[4];
#pragma unroll
          for (int u = 0; u < 4; ++u) v[u] = *(const u32x2g*)(P + (size_t)(row0 + wave * 16 + bt * 4 + u) * NPB + PC_VV + 4 * lane);
#pragma unroll
          for (int u = 0; u < 4; ++u) { const int r = wave * 16 + bt * 4 + u; float f[4] = {bflo(v[u].x), bfhi(v[u].x), bflo(v[u].y), bfhi(v[u].y)};
              const float mean = wave_sum((f[0] + f[1]) + (f[2] + f[3])) * (1.f / 256.f);
#pragma unroll
              for (int e = 0; e < 4; ++e) f[e] -= mean;
              const float rstd = __builtin_amdgcn_rsqf(wave_sum((f[0] * f[0] + f[1] * f[1]) + (f[2] * f[2] + f[3] * f[3])) * (1.f / 256.f) + LN_EPS);
#pragma unroll
              for (int e = 0; e < 4; ++e) VT[(4 * lane + e) * VTP + r] = (bf16)f2bf(f[e] * rstd * g4[e] + b4[e]); } } }
    LDS_WAIT(); __syncthreads();
    const int r32 = lane & 31, hi = lane >> 5;
    { const int g = wave >> 1, cb = wave & 1; const bf16* sgw = (const bf16*)(F.ws + TB_SGW) + (size_t)(l * 4 + g) * 128 * 128; const float* sb = arg_in(13) + (size_t)(l * 4 + g) * 128;
      bf16* YD = (bf16*)(F.ws + WS_YA) + (size_t)3 * M * 256;
#pragma unroll
      for (int tb = 0; tb < 4; ++tb) { attn_body::f32x16 acc = {}; bf16x8 bfr[8]; u32x2g uu[4]; const int t = 32 * tb + r32; const size_t row = (size_t)(row0 + t);
#pragma unroll
          for (int ks = 0; ks < 2 * (tb + 1); ++ks) bfr[ks] = *(const bf16x8*)(sgw + (size_t)t * 128 + 16 * ks + 8 * hi);
#pragma unroll
          for (int q4 = 0; q4 < 4; ++q4) uu[q4] = *(const u32x2g*)(P + row * NPB + PC_U + 64 * g + 32 * cb + 8 * q4 + 4 * hi);
          const float bias = sb[t];
#pragma unroll
          for (int ks = 0; ks < 2 * (tb + 1); ++ks) { const bf16x8 a = *(const LAS bf16x8*)(VT + (64 * g + 32 * cb + r32) * VTP + 16 * ks + 8 * hi);
              acc = __builtin_amdgcn_mfma_f32_32x32x16_bf16(a, bfr[ks], acc, 0, 0, 0); }
#pragma unroll
          for (int q4 = 0; q4 < 4; ++q4) { const int c0 = 64 * g + 32 * cb + 8 * q4 + 4 * hi; const u32x2g u = uu[q4];
              u32x2g w; w.x = cvtpk(bflo(u.x) * (acc[4 * q4 + 0] + bias), bfhi(u.x) * (acc[4 * q4 + 1] + bias)); w.y = cvtpk(bflo(u.y) * (acc[4 * q4 + 2] + bias), bfhi(u.y) * (acc[4 * q4 + 3] + bias));
              *(u32x2g*)(YD + row * 256 + c0) = w; } } }
    { const int g = wave & 3; const bf16* pwt_g = (const bf16*)(F.ws + TB_PWT) + (size_t)(l * 4 + g) * 4096; const float* psc = arg_in(3) + l * 256; bf16* YA = (bf16*)(F.ws + WS_YA);
      for (int tb = wave >> 2; tb < 4; tb += 2) {
          if (g == 0) pool_item<2>(P, pwt_g, psc, YA, g, row0, pos0, tb, r32, hi); else if (g == 1) pool_item<4>(P, pwt_g, psc, YA, g, row0, pos0, tb, r32, hi);
          else if (g == 2) pool_item<8>(P, pwt_g, psc, YA, g, row0, pos0, tb, r32, hi); else pool_item<16>(P, pwt_g, psc, YA, g, row0, pos0, tb, r32, hi); } }
    __syncthreads();
}

__device__ __forceinline__ void route_phase(Frame& F, int l) {
    int tid = F.tid; asm volatile("" : "+v"(tid)); const bf16* H1 = (const bf16*)F.out; bf16* XB = (bf16*)(F.ws + WS_XB); unsigned char* X18 = F.ws + WS_X18; const int lane = tid & 63, wave = F.wave;
    LAS float* Wrg = (LAS float*)(F.lds + RING_OFF); LAS float* Wre = Wrg + 4096;
    LAS int* cc = (LAS int*)(F.lds + LDSCTL_OFF + 224);
    { const float* wrg = arg_in(18) + (size_t)l * 4096; const float* wre = arg_in(20) + (size_t)l * 16384;
      for (int k = tid; k < 1024; k += 512) { const int dst = (((k >> 8) * 4 + (k & 3)) * 64 + ((k & 255) >> 2)) * 4; *(LAS f32x4*)(Wrg + dst) = *(const f32x4*)(wrg + 4 * k);
#pragma unroll
          for (int g = 0; g < 4; ++g) *(LAS f32x4*)(Wre + g * 4096 + dst) = *(const f32x4*)(wre + (size_t)g * 4096 + 4 * k); } }
    const float* g1 = arg_in(16) + l * DMODEL; const float* b1 = arg_in(17) + l * DMODEL; const float* brg = arg_in(19) + l * 4; const float* bre = arg_in(21) + l * 16;
    int* rowtok = (int*)(F.ws + TB2_ROWTOK); f32x2g* roww = (f32x2g*)(F.ws + TB2_ROWW); gu32* gcnt = F.ctl + CW_CNT + 2048 * l;
    LAS int* ent = (LAS int*)(F.lds + LDSX_OFF); LAS int* cbase = (LAS int*)(F.lds + LDSX_OFF + 2048);
    f32x4 gg[4], bb[4];
#pragma unroll
    for (int j = 0; j < 4; ++j) { gg[j] = *(const f32x4*)(g1 + 4 * lane + 256 * j); bb[j] = *(const f32x4*)(b1 + 4 * lane + 256 * j); }
    const f32x4 brg4 = *(const f32x4*)brg;
    for (int rg = F.vcu; rg < M / 128; rg += F.G) {
        if (tid < NCLS) cc[tid] = 0;
        LDS_WAIT(); __syncthreads();
        constexpr int NR = 2;
        for (int i = 0; i < 16; i += NR) {
            f32x4 v[NR][4]; float mean[NR], rstd[NR];
#pragma unroll
            for (int r = 0; r < NR; ++r) { const bf16* hr = H1 + ((size_t)rg * 128 + wave * 16 + i + r) * DMODEL;
#pragma unroll
                for (int j = 0; j < 4; ++j) { const u32x2g q = *(const u32x2g*)(hr + 4 * lane + 256 * j); v[r][j] = (f32x4){bflo(q.x), bfhi(q.x), bflo(q.y), bfhi(q.y)}; } }
#pragma unroll
            for (int r = 0; r < NR; ++r) { float s = 0.f;
#pragma unroll
                for (int j = 0; j < 4; ++j) s += (v[r][j][0] + v[r][j][1]) + (v[r][j][2] + v[r][j][3]);
                mean[r] = wave_sum(s) * (1.f / DMODEL); }
#pragma unroll
            for (int r = 0; r < NR; ++r) { float s2 = 0.f;
#pragma unroll
                for (int j = 0; j < 4; ++j) { v[r][j] = v[r][j] - mean[r]; s2 += (v[r][j][0] * v[r][j][0] + v[r][j][1] * v[r][j][1]) + (v[r][j][2] * v[r][j][2] + v[r][j][3] * v[r][j][3]); }
                rstd[r] = 1.f / sqrtf(wave_sum(s2) * (1.f / DMODEL) + LN_EPS); }
            f32x4 gl[NR];
#pragma unroll
            for (int r = 0; r < NR; ++r) gl[r] = (f32x4){0.f, 0.f, 0.f, 0.f};
#pragma unroll
            for (int r = 0; r < NR; ++r) { const size_t row = (size_t)rg * 128 + wave * 16 + i + r;
#pragma unroll
                for (int j = 0; j < 4; ++j) { v[r][j] = v[r][j] * rstd[r] * gg[j] + bb[j];
                    u32x2g w; w.x = cvtpk(v[r][j][0], v[r][j][1]); w.y = cvtpk(v[r][j][2], v[r][j][3]); *(u32x2g*)(XB + row * DMODEL + 4 * lane + 256 * j) = w;
                    *(unsigned*)(X18 + row * DMODEL + 4 * lane + 256 * j) = pg8::fp8_pk4(v[r][j][0] * pg8::FP8_XS, v[r][j][1] * pg8::FP8_XS, v[r][j][2] * pg8::FP8_XS, v[r][j][3] * pg8::FP8_XS); } }
#pragma unroll
            for (int j = 0; j < 4; ++j)
#pragma unroll
                for (int e = 0; e < 4; ++e) { const f32x4 w = *(const LAS f32x4*)(Wrg + ((j * 4 + e) * 64 + lane) * 4);
#pragma unroll
                    for (int r = 0; r < NR; ++r) gl[r] += w * v[r][j][e]; }
            int gs[NR]; float psel[NR];
#pragma unroll
            for (int r = 0; r < NR; ++r) {
#pragma unroll
                for (int e = 0; e < 4; ++e) gl[r][e] = wave_sum(gl[r][e]) + brg4[e];
                int g_ = 0; float gm = gl[r][0];
#pragma unroll
                for (int e = 1; e < 4; ++e) if (gl[r][e] > gm) { gm = gl[r][e]; g_ = e; }
                psel[r] = 1.0f / ((expf(gl[r][0] - gm) + expf(gl[r][1] - gm)) + (expf(gl[r][2] - gm) + expf(gl[r][3] - gm)));
                gs[r] = __builtin_amdgcn_readfirstlane(g_); }
            f32x4 el[NR];
#pragma unroll
            for (int r = 0; r < NR; ++r) el[r] = (f32x4){0.f, 0.f, 0.f, 0.f};
#pragma unroll
            for (int r = 0; r < NR; ++r) { const LAS float* wre = Wre + gs[r] * 4096;
#pragma unroll
                for (int j = 0; j < 4; ++j)
#pragma unroll
                    for (int e = 0; e < 4; ++e) el[r] += *(const LAS f32x4*)(wre + ((j * 4 + e) * 64 + lane) * 4) * v[r][j][e]; }
#pragma unroll
            for (int r = 0; r < NR; ++r) { const size_t row = (size_t)rg * 128 + wave * 16 + i + r; const f32x4 bre4 = *(const f32x4*)(bre + gs[r] * 4);
#pragma unroll
                for (int e = 0; e < 4; ++e) el[r][e] = wave_sum(el[r][e]) + bre4[e];
                int i1 = 0; float v1 = el[r][0];
#pragma unroll
                for (int e = 1; e < 4; ++e) if (el[r][e] > v1) { v1 = el[r][e]; i1 = e; }
                int i2 = -1; float v2 = 0.f;
#pragma unroll
                for (int e = 0; e < 4; ++e) if (e != i1 && (i2 < 0 || el[r][e] > v2)) { v2 = el[r][e]; i2 = e; }
                const float w1 = psel[r] / (1.0f + expf(v2 - v1)), w2 = psel[r] - w1;
                const int ea = i1 < i2 ? i1 : i2, eb = i1 < i2 ? i2 : i1; const float wa = i1 < i2 ? w1 : w2, wb = i1 < i2 ? w2 : w1;
                const int pair = (ea == 0) ? (eb - 1) : (ea == 1) ? (eb + 1) : 5; const int cls = gs[r] * 6 + pair;
                if (lane == 0) { const int lr = atomicAdd((int*)(cc + cls), 1); LAS int* e_ = ent + 4 * (wave * 16 + i + r); e_[0] = cls; e_[1] = lr; e_[2] = __float_as_int(wa); e_[3] = __float_as_int(wb); } }
        }
        LDS_WAIT(); __syncthreads();
        if (tid < NCLS) { const int n = cc[tid]; cbase[tid] = n ? (int)__hip_atomic_fetch_add(gcnt + 64 * tid, (unsigned)n, RLX_AGENT) : 0; }
        LDS_WAIT(); __syncthreads();
        if (tid < 128) { const LAS int* e_ = ent + 4 * tid; const int idx = e_[0] * CAP + cbase[e_[0]] + e_[1]; rowtok[idx] = rg * 128 + tid; roww[idx] = (f32x2g){__int_as_float(e_[2]), __int_as_float(e_[3])}; }
        __syncthreads();
    }
}
__device__ __forceinline__ void moe_tables(Frame& F, int l) {
    LAS int* cb = (LAS int*)(F.lds + LDSCTL_OFF); LAS int* tot = (LAS int*)(F.lds + LDSCTL_OFF + 128);
    if (F.tid < NCLS) tot[F.tid] = (int)__hip_atomic_load(F.ctl + CW_CNT + 2048 * l + 64 * F.tid, RLX_AGENT);
    LDS_WAIT(); __syncthreads();
    if (F.tid == 0) { int b = 0; for (int c = 0; c < NCLS; ++c) { cb[c] = b; b += (tot[c] + 255) & ~255; } cb[NCLS] = b; }
    LDS_WAIT(); __syncthreads();
}
__device__ __forceinline__ int cls_of_rowtile_(const LAS int* cb, int rt) { int c = 0; for (int q = 1; q < NCLS; ++q) c += (__builtin_amdgcn_readfirstlane(cb[q]) <= rt * 256) ? 1 : 0; return c; }
__device__ __forceinline__ int rowtile_info(const LAS int* cb, int rt, int& z, int& v) {
    const int c = cls_of_rowtile_(cb, rt); const int s0 = rt * 256 - __builtin_amdgcn_readfirstlane(cb[c]); const int n = __builtin_amdgcn_readfirstlane(cb[32 + c]) - s0;
    z = c * CAP + s0; v = n < 256 ? n : 256; return c; }
__device__ __forceinline__ void cls_experts(int cls, int& e1, int& e2) { const int g = cls / 6, p = cls % 6; const int a = p < 3 ? 0 : (p < 5 ? 1 : 2), b = p < 3 ? p + 1 : (p < 5 ? p - 1 : 3); e1 = g * 4 + a; e2 = g * 4 + b; }
struct MoeUpOrder {
    const char* A; const char* B; const int* rt; const LAS int* cb; int G, c;
    __device__ __forceinline__ bool next(int i, pg8::Unit& u) const {
        const int L = i * G + c, nrt = __builtin_amdgcn_readfirstlane(cb[NCLS]) >> 8; if (L >= nrt * 4) return false;
        const int rt_ = L >> 2, j = L & 3, half = j >> 1, jj = j & 1; int e1, e2; cls_experts(rowtile_info(cb, rt_, u.z, u.v), e1, e2);
        u.pm = rt_; u.pn = (half ? e2 : e1) * 2 + jj; u.x = half * 256 + jj * 128; u.y = half; return true; }
    __device__ __forceinline__ const int* rowtab() const { return rt; }
    __device__ __forceinline__ const char* aptr(const pg8::Unit& u, int t) const { return A + (size_t)t * 128; }
    __device__ __forceinline__ const char* bptr(const pg8::Unit& u, int t) const { return B + (size_t)u.pn * (256 * 1024) + (size_t)t * 128; }
};
struct MoeDownOrder {
    const char* A; const char* B; const LAS int* cb; int G, c;
    __device__ __forceinline__ bool next(int i, pg8::Unit& u) const {
        const int L = i * G + c, nrt = __builtin_amdgcn_readfirstlane(cb[NCLS]) >> 8; if (L >= nrt * 4) return false;
        const int rt = L >> 2; int e1, e2; cls_experts(rowtile_info(cb, rt, u.z, u.v), e1, e2);
        u.pm = rt; u.pn = L & 3; u.x = e1; u.y = e2; return true; }
    __device__ __forceinline__ const char* aptr(const pg8::Unit& u, int t) const { return A + (size_t)u.pm * (256 * 512) + (size_t)t * 128; }
    __device__ __forceinline__ const char* bptr(const pg8::Unit& u, int t) const { return B + ((size_t)((t < 2 ? u.x : u.y) * 1024 + u.pn * 256) * 256) + (size_t)(t & 1) * 128; }
};
struct MergeOrder {
    const char* A; const char* B; int G, c;
    __device__ __forceinline__ bool next(int i, pg8::Unit& u) const {
        const int L = i * G + c; if (L >= (M / 256) * 8) return false;
        u.pm = L >> 3; u.pn = L & 7; u.x = 0; u.y = 0; u.z = 0; u.v = 0; return true; }
    __device__ __forceinline__ const char* aptr(const pg8::Unit& u, int t) const { return A + (size_t)(t >> 2) * ((size_t)M * 512) + (size_t)u.pm * (256 * 512) + (size_t)(t & 3) * 128; }
    __device__ __forceinline__ const char* bptr(const pg8::Unit& u, int t) const { return B + (size_t)(t >> 2) * (1024 * 512) + (size_t)u.pn * (128 * 512) + (size_t)(t & 3) * 128; }
};
template <int NR> __device__ __forceinline__ void ln_rows(const bf16* hr, const float* g, const float* b, float* of, bf16* ob, unsigned char* o8, size_t rstride, int lane) {
    f32x4 v[NR][4]; float mean[NR], rstd[NR];
#pragma unroll
    for (int r = 0; r < NR; ++r)
#pragma unroll
        for (int j = 0; j < 4; ++j) { const u32x2g q = *(const u32x2g*)(hr + r * rstride + 4 * lane + 256 * j); v[r][j] = (f32x4){bflo(q.x), bfhi(q.x), bflo(q.y), bfhi(q.y)}; }
    f32x4 gg[4], bb[4];
#pragma unroll
    for (int j = 0; j < 4; ++j) { gg[j] = *(const f32x4*)(g + 4 * lane + 256 * j); bb[j] = *(const f32x4*)(b + 4 * lane + 256 * j); }
#pragma unroll
    for (int r = 0; r < NR; ++r) { float s = 0.f;
#pragma unroll
        for (int j = 0; j < 4; ++j) s += (v[r][j][0] + v[r][j][1]) + (v[r][j][2] + v[r][j][3]);
        mean[r] = wave_sum(s) * (1.f / DMODEL); }
#pragma unroll
    for (int r = 0; r < NR; ++r) { float s2 = 0.f;
#pragma unroll
        for (int j = 0; j < 4; ++j) { v[r][j] = v[r][j] - mean[r]; s2 += (v[r][j][0] * v[r][j][0] + v[r][j][1] * v[r][j][1]) + (v[r][j][2] * v[r][j][2] + v[r][j][3] * v[r][j][3]); }
        rstd[r] = 1.f / sqrtf(wave_sum(s2) * (1.f / DMODEL) + LN_EPS); }
#pragma unroll
    for (int r = 0; r < NR; ++r)
#pragma unroll
        for (int j = 0; j < 4; ++j) { const f32x4 o = v[r][j] * rstd[r] * gg[j] + bb[j];
            if (of) *(f32x4*)(of + r * rstride + 4 * lane + 256 * j) = o;
            else { u32x2g w; w.x = cvtpk(o[0], o[1]); w.y = cvtpk(o[2], o[3]); *(u32x2g*)(ob + r * rstride + 4 * lane + 256 * j) = w;
                const float sc = pg8::FP8_XS; *(unsigned*)(o8 + r * rstride + 4 * lane + 256 * j) = pg8::fp8_pk4(o[0] * sc, o[1] * sc, o[2] * sc, o[3] * sc); } }
}

struct Args { const float* in[27]; float* out; unsigned char* ws; int ph_lo, ph_hi; };
__device__ __forceinline__ void mkframe(Frame& F, int wave, LAS unsigned char* lds) {
    unsigned la = (unsigned)(uintptr_t)lds; asm volatile("" : "+s"(la), "+s"(wave));
    LAS unsigned char* l = (LAS unsigned char*)(uintptr_t)la; volatile LAS unsigned* mi = (volatile LAS unsigned*)(l + MISC_OFF);
    const unsigned w0 = __builtin_amdgcn_readfirstlane(mi[10]), w1 = __builtin_amdgcn_readfirstlane(mi[11]), o0 = __builtin_amdgcn_readfirstlane(mi[12]), o1 = __builtin_amdgcn_readfirstlane(mi[13]);
    GAS unsigned char* wsg = (GAS unsigned char*)(uintptr_t)(((unsigned long long)w1 << 32) | w0); GAS float* og = (GAS float*)(uintptr_t)(((unsigned long long)o1 << 32) | o0);
    const int tid = wave * 64 + xb_lane_id();
    F.ws = (unsigned char*)wsg; F.out = (float*)og;
    F.G = (int)__builtin_amdgcn_readfirstlane(mi[14]); F.vcu = (int)__builtin_amdgcn_readfirstlane(mi[15]); F.bx = (int)__builtin_amdgcn_readfirstlane(mi[16]);
    F.tid = tid; F.lane = tid & 63; F.wave = wave; F.lds = l; F.ctl = (gu32*)(F.ws + WS_CTL);
}
#if MK_PER_PHASE
#define GRID_BAR() do { } while (0)
#else
#define GRID_BAR() do { XcdBarrier b_; b_.bar = (unsigned*)F.ws; b_.off = (unsigned)(WS_CTL / 4 + CW_BAR); b_.x = 0; b_.st = (volatile LAS unsigned*)(F.lds + MISC_OFF) + 8; b_.wave = F.wave; b_.G = (unsigned)F.G; xcd_barrier(b_); } while (0)
#endif
#ifndef PHMASK
#define PHMASK 0x7ff
#endif
#define IN(k) (lo <= (k) && (k) < hi)
#define ON(j) ((PHMASK >> (j)) & 1)
#ifndef REPMASK
#define REPMASK 0
#endif
#define REP(j) for (int rep_ = 0; rep_ < 1 + ((REPMASK >> (j)) & 1); ++rep_)
#ifndef BARX
#define BARX 1
#endif
#define SEAM(k) do { if (IN(k) && IN((k) + 1)) { for (int bx_ = 0; bx_ < BARX; ++bx_) GRID_BAR(); } } while (0)
#define FRAME() Frame F; mkframe(F, wave0, ldsb); unsigned char* const ws = F.ws; LAS unsigned char* const ring = F.lds + RING_OFF; (void)ws; (void)ring
template <int l> __device__ __forceinline__ void layer_phases(const int lo, const int hi, const int wave0, LAS unsigned char* const ldsb) {
        const int pb = 1 + 10 * l;
        const float lam_init = l == 0 ? 0.2f : 0.35550906759096764f;
        if (ON(1) && IN(pb + 0)) { FRAME();
            { pg8::StdOrder S; S.init(ws + WS_XB, ws + W_IN, M, NPB, DMODEL * 2, F.G, F.bx); S.skew = 2;
              pg8::EpiProjA E{(bf16*)(ws + WS_P), (bf16*)(ws + WS_QP), (bf16*)(ws + WS_KP), (const float*)(ws + TB_ROPEC), (const float*)(ws + TB_ROPES), attn_body::C2};
              REP(1) pg8::gemm_phase<pg8::EpiProjA, pg8::StdOrder, false, 0, 2>(ring, F.tid, DMODEL / 64, DMODEL * 2, DMODEL * 2, S, E); }
            { pg8::StdOrder S; S.init(ws + WS_X8, ws + W_G8, M, NGATE, DMODEL, F.G, F.bx); S.skew = 1;
              pg8::EpiGate E{(unsigned char*)F.out};
              REP(1) pg8::gemm_phase<pg8::EpiGate, pg8::StdOrder, false, 1, 2>(ring, F.tid, DMODEL / 128, DMODEL, DMODEL, S, E); }
            SEAM(pb + 0);
        }
        if (ON(2) && IN(pb + 1)) { FRAME();
            REP(2) for (int ch = F.vcu; ch < M / 128; ch += F.G) prep_unit(F, ch, l);
            if (MK_PER_PHASE) SEAM(pb + 1);
        }
        if (ON(3) && IN(pb + 2)) { FRAME();
            float lam;
            { const float* q1 = arg_in(5); const float* k1 = arg_in(6); const float* q2 = arg_in(7); const float* k2 = arg_in(8); const int li = l * 32 + (F.lane & 31);
              const float p1 = F.lane < 32 ? q1[li] * k1[li] : 0.f, p2 = F.lane < 32 ? q2[li] * k2[li] : 0.f;
              lam = expf(wave_sum(p1)) - expf(wave_sum(p2)) + lam_init; }
            const attn_body::bf16* Qp = (const attn_body::bf16*)(ws + WS_QP); const attn_body::bf16* Kp = (const attn_body::bf16*)(ws + WS_KP);
            const attn_body::bf16* Vb = (const attn_body::bf16*)(ws + WS_P) + PC_V; attn_body::bf16* YC = (attn_body::bf16*)(ws + WS_YA) + (size_t)2 * M * 256;
            const float* sg = arg_in(9) + l * 64;
            REP(3) for (int i = 0;; ++i) { const int p = (i >> 1) * F.G + F.vcu; if (p >= 256) break;
                const int bh = p >> 3, s = p & 7, qb = (i & 1) ? 15 - s : s;
                for (int mp = 0; mp < 2; ++mp) attn_body::attn_unit<8>(bh >> 2, bh & 3, mp, qb, Qp, Kp, Vb, YC, lam, 1.0f - lam_init, sg, (char*)(unsigned char*)ring, F.tid); }
            SEAM(pb + 2);
        }
        if (ON(4) && IN(pb + 3)) { FRAME();
            MergeOrder S{(const char*)(ws + WS_YA), (const char*)(ws + W_B), F.G, F.vcu};
            pg8::EpiMerge2 E{(const unsigned char*)F.out, (bf16*)(ws + WS_MG)};
            REP(4) pg8::gemm_phase<pg8::EpiMerge2, MergeOrder, true, 0, 1>(ring, F.tid, 16, 512, 512, S, E);
            SEAM(pb + 3);
        }
        if (ON(5) && IN(pb + 4)) { FRAME();
            pg8::StdOrder S; S.init(ws + WS_MG, ws + W_O, M, DMODEL, DMODEL * 2, F.G, F.bx);
            { pg8::EpiRes<true> E{(const void*)(ws + WS_XB), (bf16*)F.out};
                REP(5) pg8::gemm_phase<pg8::EpiRes<true>, pg8::StdOrder, true, 0, 2>(ring, F.tid, DMODEL / 64, DMODEL * 2, DMODEL * 2, S, E); }
            SEAM(pb + 4);
        }
        if (ON(6) && IN(pb + 5)) { FRAME(); route_phase(F, l); if (IN(pb + 5) && IN(pb + 7)) GRID_BAR(); }
        if (ON(8) && IN(pb + 7)) { FRAME();
            moe_tables(F, l);
            MoeUpOrder S{(const char*)(ws + WS_X18), (const char*)(ws + W_GU), (const int*)(ws + TB2_ROWTOK), (const LAS int*)(F.lds + LDSCTL_OFF), F.G, F.vcu};
            pg8::EpiAct E{(unsigned char*)(ws + WS_HB), (const pg8::f32x2*)(ws + TB2_ROWW)};
            REP(8) pg8::gemm_phase<pg8::EpiAct, MoeUpOrder, true, 1, 2, true>(ring, F.tid, DMODEL / 128, DMODEL, DMODEL, S, E);
            SEAM(pb + 7);
        }
        if (ON(9) && IN(pb + 8)) { FRAME();
            moe_tables(F, l);
            MoeDownOrder S{(const char*)(ws + WS_HB), (const char*)(ws + W_D), (const LAS int*)(F.lds + LDSCTL_OFF), F.G, F.vcu};
            pg8::EpiDown E{(const int*)(ws + TB2_ROWTOK), (bf16*)(ws + WS_XB)};
            pg8::gemm_phase<pg8::EpiDown, MoeDownOrder, true, 1, 2>(ring, F.tid, 4, 512, 256, S, E);
            if ((REPMASK >> 9) & 1) { pg8::EpiDown E2{(const int*)(ws + TB2_ROWTOK), (bf16*)(ws + WS_X + 96 * MiB)}; pg8::gemm_phase<pg8::EpiDown, MoeDownOrder, true, 1, 2>(ring, F.tid, 4, 512, 256, S, E2); }
            SEAM(pb + 8);
        }
        if (ON(10) && IN(pb + 9)) { FRAME();
            bf16* XB = (bf16*)(ws + WS_XB);
            const float* g2 = arg_in(25) + l * DMODEL; const float* b2 = arg_in(26) + l * DMODEL;
            for (int m = 4 * (F.vcu * NWAVES + F.wave); m < M; m += 4 * F.G * NWAVES)
                ln_rows<4>(XB + (size_t)m * DMODEL, g2, b2, (l == DEPTH - 1) ? F.out + (size_t)m * DMODEL : nullptr, XB + (size_t)m * DMODEL, ws + WS_X8 + (size_t)m * DMODEL, (size_t)DMODEL, F.lane);
            if (l + 1 < DEPTH) { REP(11) convert_weights(F, l + 1); SEAM(pb + 9); }
        }
}
__global__ void __launch_bounds__(NWAVES * 64, 2) fwd(Args args) {
    extern __shared__ __attribute__((aligned(16))) unsigned char lds[];
    LAS unsigned char* const ldsb = (LAS unsigned char*)lds;
    const int G0 = gridDim.x; int vcu0; { const int bx = blockIdx.x; vcu0 = (G0 % 8 == 0) ? (bx % 8) * (G0 / 8) + bx / 8 : bx; }
    unsigned char* const ws0 = args.ws; float* const out0 = args.out; const int wave0 = __builtin_amdgcn_readfirstlane((int)threadIdx.x >> 6);
    for (int u = threadIdx.x; u < (LDS_BYTES - LDSCTL_OFF) / 4; u += NWAVES * 64) ((LAS unsigned*)(ldsb + LDSCTL_OFF))[u] = 0u;
    __syncthreads();
    volatile LAS unsigned* MISC = (volatile LAS unsigned*)(ldsb + MISC_OFF);
    if (threadIdx.x == 0) { const unsigned long long w = (unsigned long long)(uintptr_t)ws0, o = (unsigned long long)(uintptr_t)out0;
        MISC[10] = (unsigned)w; MISC[11] = (unsigned)(w >> 32); MISC[12] = (unsigned)o; MISC[13] = (unsigned)(o >> 32); MISC[14] = (unsigned)G0; MISC[15] = (unsigned)vcu0; MISC[16] = blockIdx.x; }
    __syncthreads();
#if !MK_PER_PHASE
    (void)xcd_barrier_post((unsigned*)ws0, (unsigned)(WS_CTL / 4 + CW_BAR), MISC + 8, wave0);
#endif
    const int lo = args.ph_lo, hi = args.ph_hi;
    if (ON(0) && IN(0)) { FRAME(); REP(0) p0_prologue(F); SEAM(0); }
    layer_phases<0>(lo, hi, wave0, ldsb);
    layer_phases<1>(lo, hi, wave0, ldsb);
    static_assert(DEPTH == 2, "two layer instances");
}
#undef IN
#undef SEAM
#undef GRID_BAR
#undef FRAME


extern "C" void kernel_launch(void* const* d_in, const int* in_sizes, int n_in, void* d_out, int out_size, void* d_ws, size_t ws_size, hipStream_t stream) {
    static int grid = 0;
    if (grid == 0) {
        if (n_in != 27 || in_sizes[0] != M * DMODEL || out_size != M * DMODEL || ws_size < WS_END) { fprintf(stderr, "kernel_launch: built for 27 inputs, x/out of %d floats, >= %zu bytes of workspace; got n_in %d, in0 %d, out %d, ws %zu; nothing launched\n", M * DMODEL, (size_t)WS_END, n_in, n_in > 0 ? in_sizes[0] : -1, out_size, ws_size); grid = -1; return; }
        int dev = 0, cus = 0, per_cu = 0;
        if (hipGetDevice(&dev) != hipSuccess || hipDeviceGetAttribute(&cus, hipDeviceAttributeMultiprocessorCount, dev) != hipSuccess) { fprintf(stderr, "kernel_launch: device query failed\n"); grid = -1; return; }
        if (hipFuncSetAttribute((const void*)fwd, hipFuncAttributeMaxDynamicSharedMemorySize, LDS_BYTES) != hipSuccess) { fprintf(stderr, "kernel_launch: hipFuncSetAttribute failed\n"); grid = -1; return; }
        if (hipOccupancyMaxActiveBlocksPerMultiprocessor(&per_cu, (const void*)fwd, NWAVES * 64, LDS_BYTES) != hipSuccess || per_cu < 1) { fprintf(stderr, "kernel_launch: occupancy query reports %d workgroups per CU\n", per_cu); }
        (void)hipGetLastError();
        grid = cus;
    }
    if (grid < 0) return;
    if (hipMemsetAsync((char*)d_ws + WS_CTL, 0, CTL_ZERO_BYTES, stream) != hipSuccess) { fprintf(stderr, "kernel_launch: memset failed\n"); return; }
    Args a{};
    for (int i = 0; i < 27; ++i) a.in[i] = (const float*)d_in[i];
    a.out = (float*)d_out; a.ws = (unsigned char*)d_ws;
#if MK_PER_PHASE
    for (int p = 0; p < NPHASE; ++p) { a.ph_lo = p; a.ph_hi = p + 1; hipLaunchKernelGGL(fwd, dim3(grid), dim3(NWAVES * 64), LDS_BYTES, stream, a); }
#else
    a.ph_lo = 0; a.ph_hi = NPHASE; hipLaunchKernelGGL(fwd, dim3(grid), dim3(NWAVES * 64), LDS_BYTES, stream, a);
#endif
    const hipError_t le = hipPeekAtLastError();
    if (le != hipSuccess) fprintf(stderr, "kernel_launch: launch failed: %s\n", hipGetErrorName(le));
}
```

```cpp
#include <hip/hip_runtime.h>
#include <hip/hip_bf16.h>
#include <cstdio>
#include <cstdint>
#include <cmath>

#ifndef MK_PER_PHASE
#define MK_PER_PHASE 0
#endif

constexpr int BATCH = 8, SEQ = 4096, DMODEL = 1024, M = BATCH * SEQ, DEPTH = 2;
constexpr int NPB = 2304;
constexpr int NGATE = 4096, NIN = NPB + NGATE;
constexpr int PC_POOL = 0, PC_GB = 256, PC_GC = 512, PC_H = 768, PC_Q = 1024, PC_K = 1280, PC_V = 1536, PC_U = 1792, PC_VV = 2048;
constexpr float LN_EPS = 1e-5f;
constexpr float ALPHA = 1.41421356237309515f;
constexpr int NCLS = 24;
constexpr int MAXROWS = 40960;

namespace pg8 {
#define PG8_LAS __attribute__((address_space(3)))
typedef unsigned short bf16_t;
typedef short bf16x8 __attribute__((ext_vector_type(8)));
typedef float f32x4 __attribute__((ext_vector_type(4)));
typedef unsigned u32x4 __attribute__((ext_vector_type(4)));
constexpr int BM = 256, BK = 64, HALF = 128, HTB = HALF * BK * 2  , STAGE_BYTES = 8 * HTB, NXCD = 8, WGM = 8;

__host__ __device__ __forceinline__ int lds_byte(int r, int c) { const int st = (r >> 4) * 2 + (c >> 5), rr = r & 15, cc = c & 31, ob = rr * 64 + cc * 2; return st * 1024 + (ob ^ (((ob >> 9) & 1) << 5)); }
__host__ __device__ __forceinline__ void stage_rc(int b, int& R, int& C) { const int st = b / 1024, sb = b % 1024, swz = sb ^ (((sb >> 9) & 1) << 5); R = (st >> 1) * 16 + swz / 64; C = (st & 1) * 32 + (swz % 64) / 2; }
__host__ __device__ __forceinline__ int perm32(int rho) { const int n = rho >> 4, i = rho & 15; return 8 * (i >> 2) + 4 * n + (i & 3); }

struct Unit { int pm, pn, x, y, z, v; };

struct StdOrder {
    const char* A; const char* B; size_t tsA, tsB;
    int nM, nN, nwg, G, c, skew;
    __device__ __forceinline__ void init(const void* A_, const void* B_, int M_, int N_, int rowbytes, int G_, int c_) {
        A = (const char*)A_; B = (const char*)B_; tsA = (size_t)BM * rowbytes; tsB = tsA; nM = M_ / BM; nN = N_ / BM; nwg = nM * nN; G = G_; c = c_; skew = 0; }
    __device__ __forceinline__ bool next(int i, Unit& u) const {
        long L = (long)i * G + c;
        if (skew && G == 256 && nwg == 2048) { if (i >= 7) { if (c < 128 || i > 8) return false; L = 1792 + (i - 7) * 128 + (c - 128); } }
        if (L >= nwg) return false;
        int wgid = (int)L; { const int q = nwg / NXCD, r = nwg % NXCD, xcd = wgid % NXCD, off = wgid / NXCD; wgid = (xcd < r ? xcd * (q + 1) : r * (q + 1) + (xcd - r) * q) + off; }
        if (skew == 2 && nM % NXCD == 0 && nwg % NXCD == 0) { const int xcd = (int)(L % NXCD), off = (int)(L / NXCD); u.pm = xcd * (nM / NXCD) + off / nN; u.pn = off % nN; u.x = 0; u.y = 0; u.z = 0; u.v = 0; return true; }
        const int nig = WGM * nN, gid = wgid / nig, fm = gid * WGM, gsz = (nM - fm) < WGM ? (nM - fm) : WGM;
        u.pm = fm + ((wgid % nig) % gsz); u.pn = (wgid % nig) / gsz; u.x = 0; u.y = 0; u.z = 0; u.v = 0; return true;
    }
    __device__ __forceinline__ const char* aptr(const Unit& u, int t) const { return A + (size_t)u.pm * tsA + (size_t)t * (BK * 2); }
    __device__ __forceinline__ const char* bptr(const Unit& u, int t) const { return B + (size_t)u.pn * tsB + (size_t)t * (BK * 2); }
};

__device__ __forceinline__ unsigned cvt_pk_bf16(float lo, float hi) { unsigned r; asm volatile("v_cvt_pk_bf16_f32 %0, %1, %2" : "=v"(r) : "v"(lo), "v"(hi)); return r; }
typedef float f32x2 __attribute__((ext_vector_type(2)));
typedef unsigned u32x2 __attribute__((ext_vector_type(2)));
__device__ __forceinline__ float bf_lo(unsigned w) { return __uint_as_float(w << 16); }
__device__ __forceinline__ float bf_hi(unsigned w) { return __uint_as_float(w & 0xffff0000u); }
__device__ __forceinline__ float sigmoidf_(float x) { return __builtin_amdgcn_rcpf(1.0f + __builtin_amdgcn_exp2f(x * -1.4426950408889634f)); }
__device__ __forceinline__ float gelu_tanh(float x) { const float u = x * (1.0f + 0.044715f * x * x); return x * __builtin_amdgcn_rcpf(1.0f + __builtin_amdgcn_exp2f(u * -2.3022082f)); }
__device__ __forceinline__ float ubf(unsigned w, int n) { return (float)((w >> (8 * n)) & 0xffu); }
__device__ __forceinline__ unsigned sig_u8(float x) { return (unsigned)(sigmoidf_(x) * 255.0f + 0.5f); }

struct NoState {};
#ifndef EPI_WT
#define EPI_WT 0
#endif
__device__ __forceinline__ void st16(void* p, u32x4 v) {
#if EPI_WT
    asm volatile("global_store_dwordx4 %0, %1, off sc1" :: "v"((__attribute__((address_space(1))) void*)p), "v"(v) : "memory");
#else
    *(u32x4*)p = v;
#endif
}
__device__ __forceinline__ void st8(void* p, u32x2 v) {
#if EPI_WT
    asm volatile("global_store_dwordx2 %0, %1, off sc1" :: "v"((__attribute__((address_space(1))) void*)p), "v"(v) : "memory");
#else
    *(u32x2*)p = v;
#endif
}
struct EpiProjA {
    static constexpr bool PERM = true, AFTER_DRAIN = false; static constexpr int GROUP = 0; typedef NoState State;
    bf16_t* P; bf16_t* Qp; bf16_t* Kp; const float* rc; const float* rs; float qscale;
    __device__ __forceinline__ void operator()(const f32x4 (&acc)[2][2][4][2], const Unit& u, int wr, int wc, int fr, int fq) const {
        asm volatile("" : "+v"(fr), "+v"(fq));
        const int row0 = u.pm * BM + wr * 64 + fr, col0 = wc * 32 + 8 * fq;
        if (u.pn == 4 || u.pn == 5) {
            bf16_t* dstb = (u.pn == 4 ? Qp : Kp) + wc * 64 + 8 * fq; const float sc = u.pn == 4 ? qscale : 1.0f; const bool up = fq >= 2; const int j0 = 8 * (fq & 1);
#pragma unroll
            for (int ai = 0; ai < 2; ++ai)
#pragma unroll
                for (int m = 0; m < 4; ++m) { const int row = row0 + ai * HALF + m * 16, pos = row & 4095;
                    const f32x4 c0 = *(const f32x4*)(rc + pos * 16 + j0), c1 = *(const f32x4*)(rc + pos * 16 + j0 + 4), s0 = *(const f32x4*)(rs + pos * 16 + j0), s1 = *(const f32x4*)(rs + pos * 16 + j0 + 4);
#pragma unroll
                    for (int bj = 0; bj < 2; ++bj) { const f32x4 v0 = acc[ai][bj][m][0], v1 = acc[ai][bj][m][1]; f32x4 p0, p1;
#pragma unroll
                        for (int e = 0; e < 4; ++e) { p0[e] = __shfl_xor(v0[e], 32); p1[e] = __shfl_xor(v1[e], 32); }
                        const f32x4 o0 = (v0 * c0 + (up ? p0 : -p0) * s0) * sc, o1 = (v1 * c1 + (up ? p1 : -p1) * s1) * sc;
                        u32x4 w; w.x = cvt_pk_bf16(o0[0], o0[1]); w.y = cvt_pk_bf16(o0[2], o0[3]); w.z = cvt_pk_bf16(o1[0], o1[1]); w.w = cvt_pk_bf16(o1[2], o1[3]);
                        bf16_t* d = dstb + (size_t)row * 512 + bj * 256;
                        st16(d, w); st16(d + 32, (u32x4){0u, 0u, 0u, 0u}); } }
            return;
        }
        const bool act = u.pn >= 7; bf16_t* base = P + u.pn * BM + col0;
#pragma unroll
        for (int ai = 0; ai < 2; ++ai)
#pragma unroll
            for (int m = 0; m < 4; ++m) { bf16_t* rowp = base + (size_t)(row0 + ai * HALF + m * 16) * NPB;
#pragma unroll
                for (int bj = 0; bj < 2; ++bj) { f32x4 v0 = acc[ai][bj][m][0], v1 = acc[ai][bj][m][1];
                    if (act) { v0 = (f32x4){gelu_tanh(v0[0]), gelu_tanh(v0[1]), gelu_tanh(v0[2]), gelu_tanh(v0[3])}; v1 = (f32x4){gelu_tanh(v1[0]), gelu_tanh(v1[1]), gelu_tanh(v1[2]), gelu_tanh(v1[3])}; }
                    u32x4 w; w.x = cvt_pk_bf16(v0[0], v0[1]); w.y = cvt_pk_bf16(v0[2], v0[3]); w.z = cvt_pk_bf16(v1[0], v1[1]); w.w = cvt_pk_bf16(v1[2], v1[3]);
                    st16(rowp + bj * HALF, w); } }
    }
};
constexpr float FP8_XS = 16.0f, FP8_WS = 512.0f, FP8_SCALE = FP8_XS * FP8_WS;
__device__ __forceinline__ float fp8_clamp(float x) { return __builtin_fminf(__builtin_fmaxf(x, -448.0f), 448.0f); }
__device__ __forceinline__ unsigned fp8_pk4(float a, float b, float c, float d) { int q = 0; q = __builtin_amdgcn_cvt_pk_fp8_f32(fp8_clamp(a), fp8_clamp(b), q, false); q = __builtin_amdgcn_cvt_pk_fp8_f32(fp8_clamp(c), fp8_clamp(d), q, true); return (unsigned)q; }
__device__ __forceinline__ unsigned sig_u8s(float x) { return (unsigned)(__builtin_amdgcn_rcpf(1.0f + __builtin_amdgcn_exp2f(x * (-1.4426950408889634f / FP8_SCALE))) * 255.0f + 0.5f); }
struct EpiGate {
    static constexpr bool PERM = true, AFTER_DRAIN = false; static constexpr int GROUP = 0; typedef NoState State;
    unsigned char* G8;
    __device__ __forceinline__ void operator()(const f32x4 (&acc)[2][2][4][2], const Unit& u, int wr, int wc, int fr, int fq) const {
        asm volatile("" : "+v"(fr), "+v"(fq));
        const int row0 = u.pm * BM + wr * 64 + fr, col0 = wc * 32 + 8 * fq;
#pragma unroll
        for (int ai = 0; ai < 2; ++ai)
#pragma unroll
            for (int m = 0; m < 4; ++m) { unsigned char* rowp = G8 + (unsigned)((row0 + ai * HALF + m * 16) * NGATE + u.pn * BM + col0);
#pragma unroll
                for (int bj = 0; bj < 2; ++bj) { const f32x4 v0 = acc[ai][bj][m][0], v1 = acc[ai][bj][m][1];
                    u32x2 w; w.x = sig_u8s(v0[0]) | (sig_u8s(v0[1]) << 8) | (sig_u8s(v0[2]) << 16) | (sig_u8s(v0[3]) << 24);
                    w.y = sig_u8s(v1[0]) | (sig_u8s(v1[1]) << 8) | (sig_u8s(v1[2]) << 16) | (sig_u8s(v1[3]) << 24);
                    *(u32x2*)(rowp + bj * HALF) = w; } }
    }
};
struct EpiMerge2 {
    static constexpr bool PERM = true, AFTER_DRAIN = false; static constexpr int GROUP = 4;
    struct State { f32x4 mg[2][4][2]; u32x2 gq[2][4]; };
    const unsigned char* G8; bf16_t* MG;
    __device__ __forceinline__ void load_gates(State& st, const Unit& u, int g, int wr, int wc, int fr, int fq) const {
        asm volatile("" : "+v"(fr), "+v"(fq));
        const unsigned char* base = G8 + (size_t)(u.pm * BM + wr * 64 + fr) * NGATE + g * DMODEL + u.pn * HALF + wc * 32 + 8 * fq;
#pragma unroll
        for (int ai = 0; ai < 2; ++ai)
#pragma unroll
            for (int m = 0; m < 4; ++m) { const unsigned char* p = base + (size_t)(ai * HALF + m * 16) * NGATE;
                asm volatile("global_load_dwordx2 %0, %1, off" : "+v"(st.gq[ai][m]) : "v"(p) : "memory"); }
    }
    __device__ __forceinline__ void begin(State& st, const Unit& u, int wr, int wc, int fr, int fq) const {
#pragma unroll
        for (int ai = 0; ai < 2; ++ai)
#pragma unroll
            for (int m = 0; m < 4; ++m) { st.mg[ai][m][0] = (f32x4){0.f, 0.f, 0.f, 0.f}; st.mg[ai][m][1] = (f32x4){0.f, 0.f, 0.f, 0.f}; }
        load_gates(st, u, 0, wr, wc, fr, fq);
    }
    __device__ __forceinline__ void group(State& st, f32x4 (&acc)[2][1][4][2], const Unit& u, int g, int ng, int wr, int wc, int fr, int fq) const {
        asm volatile("s_waitcnt vmcnt(6)" ::: "memory");
#pragma unroll
        for (int ai = 0; ai < 2; ++ai)
#pragma unroll
            for (int m = 0; m < 4; ++m) { const u32x2 q = st.gq[ai][m];
                st.mg[ai][m][0] += (f32x4){ubf(q.x, 0), ubf(q.x, 1), ubf(q.x, 2), ubf(q.x, 3)} * acc[ai][0][m][0];
                st.mg[ai][m][1] += (f32x4){ubf(q.y, 0), ubf(q.y, 1), ubf(q.y, 2), ubf(q.y, 3)} * acc[ai][0][m][1];
                acc[ai][0][m][0] = (f32x4){0.f, 0.f, 0.f, 0.f}; acc[ai][0][m][1] = (f32x4){0.f, 0.f, 0.f, 0.f}; }
        asm volatile("" : "+v"(st.mg[0][0][0]), "+v"(st.mg[0][0][1]), "+v"(st.mg[0][1][0]), "+v"(st.mg[0][1][1]), "+v"(st.mg[0][2][0]), "+v"(st.mg[0][2][1]), "+v"(st.mg[0][3][0]), "+v"(st.mg[0][3][1]),
                          "+v"(st.mg[1][0][0]), "+v"(st.mg[1][0][1]), "+v"(st.mg[1][1][0]), "+v"(st.mg[1][1][1]), "+v"(st.mg[1][2][0]), "+v"(st.mg[1][2][1]), "+v"(st.mg[1][3][0]), "+v"(st.mg[1][3][1]));
        if (g + 1 < ng) load_gates(st, u, g + 1, wr, wc, fr, fq);
    }
    __device__ __forceinline__ void store(State& st, const Unit& u, int wr, int wc, int fr, int fq) const {
        asm volatile("" : "+v"(fr), "+v"(fq));
        bf16_t* base = MG + (size_t)(u.pm * BM + wr * 64 + fr) * DMODEL + u.pn * HALF + wc * 32 + 8 * fq; const float s = 1.0f / 255.0f;
#pragma unroll
        for (int ai = 0; ai < 2; ++ai)
#pragma unroll
            for (int m = 0; m < 4; ++m) { const f32x4 a = st.mg[ai][m][0] * s, b = st.mg[ai][m][1] * s;
                u32x4 w; w.x = cvt_pk_bf16(a[0], a[1]); w.y = cvt_pk_bf16(a[2], a[3]); w.z = cvt_pk_bf16(b[0], b[1]); w.w = cvt_pk_bf16(b[2], b[3]);
                st16(base + (size_t)(ai * HALF + m * 16) * DMODEL, w); }
    }
};
template <bool RES_BF16> struct EpiRes {
    static constexpr bool PERM = true, AFTER_DRAIN = false; static constexpr int GROUP = 0; typedef NoState State;
    const void* res; bf16_t* out;
    __device__ __forceinline__ void operator()(const f32x4 (&acc)[2][2][4][2], const Unit& u, int wr, int wc, int fr, int fq) const {
        asm volatile("" : "+v"(fr), "+v"(fq));
        const int row0 = u.pm * BM + wr * 64 + fr, col0 = u.pn * BM + wc * 32 + 8 * fq;
#pragma unroll
        for (int ai = 0; ai < 2; ++ai)
#pragma unroll
            for (int m = 0; m < 4; ++m) { const size_t off = (size_t)(row0 + ai * HALF + m * 16) * DMODEL + col0;
#pragma unroll
                for (int bj = 0; bj < 2; ++bj) { f32x4 r0, r1;
                    if constexpr (RES_BF16) { const u32x4 p = *(const u32x4*)((const bf16_t*)res + off + bj * HALF); r0 = (f32x4){bf_lo(p.x), bf_hi(p.x), bf_lo(p.y), bf_hi(p.y)}; r1 = (f32x4){bf_lo(p.z), bf_hi(p.z), bf_lo(p.w), bf_hi(p.w)}; }
                    else { r0 = *(const f32x4*)((const float*)res + off + bj * HALF); r1 = *(const f32x4*)((const float*)res + off + bj * HALF + 4); }
                    const f32x4 a = r0 * ALPHA + acc[ai][bj][m][0], b = r1 * ALPHA + acc[ai][bj][m][1];
                    u32x4 w; w.x = cvt_pk_bf16(a[0], a[1]); w.y = cvt_pk_bf16(a[2], a[3]); w.z = cvt_pk_bf16(b[0], b[1]); w.w = cvt_pk_bf16(b[2], b[3]);
                    st16(out + off + bj * HALF, w); } }
    }
};
struct EpiAct {
    static constexpr bool PERM = true, AFTER_DRAIN = false; static constexpr int GROUP = 0; typedef NoState State;
    unsigned char* H; const f32x2* roww;
    __device__ __forceinline__ void operator()(const f32x4 (&acc)[2][2][4][2], const Unit& u, int wr, int wc, int fr, int fq) const {
        asm volatile("" : "+v"(fr), "+v"(fq));
        const int row0 = u.pm * BM + wr * 64 + fr, col0 = u.x + wc * 32 + 8 * fq; const float ds = 1.0f / FP8_SCALE;
#pragma unroll
        for (int ai = 0; ai < 2; ++ai)
#pragma unroll
            for (int m = 0; m < 4; ++m) { const size_t row = (size_t)(row0 + ai * HALF + m * 16); const int r_ = wr * 64 + fr + ai * HALF + m * 16; const f32x2 rw = roww[u.z + (r_ < u.v ? r_ : 0)]; const float w = (u.y ? rw.y : rw.x) * FP8_XS;
                float o[8];
#pragma unroll
                for (int n = 0; n < 2; ++n)
#pragma unroll
                    for (int e = 0; e < 4; ++e) { const float g = acc[ai][0][m][n][e] * ds, up = acc[ai][1][m][n][e] * ds; o[n * 4 + e] = g * sigmoidf_(g) * up * w; }
                u32x2 q; q.x = fp8_pk4(o[0], o[1], o[2], o[3]); q.y = fp8_pk4(o[4], o[5], o[6], o[7]);
                st8(H + row * 512 + col0, q); }
    }
};
struct EpiDown {
    static constexpr bool PERM = true, AFTER_DRAIN = false; static constexpr int GROUP = 0; typedef NoState State;
    const int* rowtok; bf16_t* hx;
    __device__ __forceinline__ void operator()(const f32x4 (&acc)[2][2][4][2], const Unit& u, int wr, int wc, int fr, int fq) const {
        asm volatile("" : "+v"(fr), "+v"(fq));
        const int row0 = u.pm * BM + wr * 64 + fr, col0 = u.pn * BM + wc * 32 + 8 * fq;
#pragma unroll
        for (int ai = 0; ai < 2; ++ai)
#pragma unroll
            for (int m = 0; m < 4; ++m) { const int r_ = wr * 64 + fr + ai * HALF + m * 16;
                if (r_ < u.v) { const int tok = rowtok[u.z + r_]; bf16_t* p = (bf16_t*)((char*)hx + (unsigned)(tok * (DMODEL * 2) + col0 * 2));
#pragma unroll
                    for (int bj = 0; bj < 2; ++bj) { const u32x4 q = *(const u32x4*)(p + bj * HALF);
                        const f32x4 a = (f32x4){bf_lo(q.x), bf_hi(q.x), bf_lo(q.y), bf_hi(q.y)} * ALPHA + acc[ai][bj][m][0] * (1.0f / FP8_SCALE), b = (f32x4){bf_lo(q.z), bf_hi(q.z), bf_lo(q.w), bf_hi(q.w)} * ALPHA + acc[ai][bj][m][1] * (1.0f / FP8_SCALE);
                        u32x4 w; w.x = cvt_pk_bf16(a[0], a[1]); w.y = cvt_pk_bf16(a[2], a[3]); w.z = cvt_pk_bf16(b[0], b[1]); w.w = cvt_pk_bf16(b[2], b[3]);
                        *(u32x4*)(p + bj * HALF) = w; } }
                asm volatile("" ::: "memory"); }
    }
};

typedef int i32x8 __attribute__((ext_vector_type(8)));
__device__ __forceinline__ int lane_id_now() { int l; asm volatile("v_mbcnt_lo_u32_b32 %0, -1, 0\n\tv_mbcnt_hi_u32_b32 %0, -1, %0" : "=v"(l)); return l; }
template <class Epi, class Sched, bool ALIGN_EPI = false, int MODE = 0, int NB = 2, bool GATHER = false>
__device__ __forceinline__ void gemm_phase(PG8_LAS unsigned char* lds, int tid, const int nt, const int ldaB, const int ldbB, const Sched& S, const Epi& E) {
    asm volatile("" : "+v"(tid));
    const int wid = __builtin_amdgcn_readfirstlane(tid >> 6), lane = tid & 63, wr = wid >> 2, wc = wid & 3, fr = lane & 15, fq = lane >> 4;
    unsigned voffA[2], voffB[2];
#pragma unroll
    for (int i = 0; i < 2; ++i) { int R, C; stage_rc(tid * 16 + i * 8192, R, C); const int Rb = Epi::PERM ? ((R & ~31) + perm32(R & 31)) : R;
        voffA[i] = (unsigned)(R * ldaB + C * 2); voffB[i] = (unsigned)(Rb * ldbB + C * 2); }
    const size_t hsA = (size_t)HALF * ldaB, hsB = (size_t)HALF * ldbB;
    const unsigned ldsw = (unsigned)wid * 1024u;
    const int aoff = lds_byte(wr * 64 + fr, fq * 8), boff = lds_byte(wc * 32 + fr, fq * 8);
#define PG8_SA(b, h) (((b) * 2 + (h)) * HTB)
#define PG8_SB(b, h) ((4 + (b) * 2 + (h)) * HTB)
#define PG8_STAGE(bufoff, gbase, voff) do { const __attribute__((address_space(1))) char* gb_ = (const __attribute__((address_space(1))) char*)(gbase); asm volatile("" : "+s"(gb_));   \
        _Pragma("unroll") for (int _i = 0; _i < 2; ++_i) \
        __builtin_amdgcn_global_load_lds((const __attribute__((address_space(1))) unsigned*)(gb_ + (voff)[_i]), (PG8_LAS unsigned*)(lds + (bufoff) + ldsw + _i * 8192), 16, 0, 0); } while (0)
#define PG8_STAGE_B1(bufoff, gbase) do { if constexpr (NB == 2) PG8_STAGE(bufoff, gbase, voffB); } while (0)
#define PG8_STAGE_A(bufoff, h, gbase, nx) do { if constexpr (GATHER) PG8_STAGE(bufoff, gbase, voffG[h]); else PG8_STAGE(bufoff, (gbase) + (h) * hsA, voffA); } while (0)
#define PG8_LDA(dst, b, h) do { _Pragma("unroll") for (int m = 0; m < 4; ++m) _Pragma("unroll") for (int k = 0; k < 2; ++k) dst[m][k] = *(const PG8_LAS bf16x8*)(lds + PG8_SA(b, h) + aoff + m * 2048 + k * 1024); } while (0)
#define PG8_LDB(dst, b, h) do { _Pragma("unroll") for (int n = 0; n < 2; ++n) _Pragma("unroll") for (int k = 0; k < 2; ++k) dst[n][k] = *(const PG8_LAS bf16x8*)(lds + PG8_SB(b, h) + boff + n * 2048 + k * 1024); } while (0)
#define PG8_CAT(x) __builtin_bit_cast(i32x8, __builtin_shufflevector((x)[0], (x)[1], 0, 1, 2, 3, 4, 5, 6, 7, 8, 9, 10, 11, 12, 13, 14, 15))
#define PG8_MMA(ai, bj, At, Bt) do { __builtin_amdgcn_s_setprio(1); _Pragma("unroll") for (int m = 0; m < 4; ++m) _Pragma("unroll") for (int n = 0; n < 2; ++n) { \
        if constexpr (MODE == 0) { _Pragma("unroll") for (int k = 0; k < 2; ++k) acc[ai][bj][m][n] = __builtin_amdgcn_mfma_f32_16x16x32_bf16(Bt[n][k], At[m][k], acc[ai][bj][m][n], 0, 0, 0); } \
        else acc[ai][bj][m][n] = __builtin_amdgcn_mfma_scale_f32_16x16x128_f8f6f4(PG8_CAT(Bt[n]), PG8_CAT(At[m]), acc[ai][bj][m][n], 0, 0, 0, 0, 0, 0); } \
        __builtin_amdgcn_s_setprio(0); } while (0)
#define PG8_WAIT_V(n) asm volatile("s_waitcnt vmcnt(" #n ")" ::: "memory")
#define PG8_WAIT_VS() do { if constexpr (NB == 2) PG8_WAIT_V(8); else PG8_WAIT_V(6); } while (0)
#define PG8_WAIT_L(n) asm volatile("s_waitcnt lgkmcnt(" #n ")" ::: "memory")
#define PG8_BAR __builtin_amdgcn_s_barrier()
#define PG8_SCHED __builtin_amdgcn_sched_barrier(0)
    Unit cur, nxt; int ui = 0;
    if (!S.next(0, cur)) return;
    f32x4 acc[2][NB][4][2];
#pragma unroll
    for (int a = 0; a < 2; ++a)
#pragma unroll
        for (int b = 0; b < NB; ++b)
#pragma unroll
            for (int m = 0; m < 4; ++m)
#pragma unroll
                for (int n = 0; n < 2; ++n) acc[a][b][m][n] = (f32x4){0.f, 0.f, 0.f, 0.f};
    typename Epi::State st = {};
    unsigned voffG[2][2]; int tokN[2][2];
    if constexpr (GATHER) { const int* rt = S.rowtab() + cur.z;
#pragma unroll
        for (int h = 0; h < 2; ++h)
#pragma unroll
            for (int i = 0; i < 2; ++i) { int R, C; stage_rc(tid * 16 + i * 8192, R, C); const int tk = (R + h * HALF < cur.v) ? rt[R + h * HALF] : 0; voffG[h][i] = (unsigned)(tk * ldaB + C * 2); tokN[h][i] = 0; } }
    if constexpr (Epi::GROUP > 0) E.begin(st, cur, wr, wc, fr, fq);
    bf16x8 At[4][2], B0[2][2], B1[2][2];
    {   const char* cA0 = S.aptr(cur, 0); const char* cA1 = S.aptr(cur, 1); const char* cB0 = S.bptr(cur, 0); const char* cB1 = S.bptr(cur, 1);
        PG8_STAGE(PG8_SB(0, 0), cB0, voffB); PG8_STAGE_B1(PG8_SB(0, 1), cB0 + hsB); PG8_STAGE_A(PG8_SA(0, 0), 0, cA0, false); PG8_STAGE_A(PG8_SA(0, 1), 1, cA0, false);
        if (wr == 1) PG8_BAR;
        PG8_WAIT_V(2); PG8_BAR;
        PG8_STAGE(PG8_SB(1, 0), cB1, voffB); PG8_STAGE_A(PG8_SA(1, 0), 0, cA1, false); PG8_STAGE_B1(PG8_SB(1, 1), cB1 + hsB);
        if constexpr (NB == 2) PG8_WAIT_V(6); else PG8_WAIT_V(4);
        PG8_BAR;
    }
    for (;;) {
        const bool has_next = S.next(ui + 1, nxt);
        const Unit nu = has_next ? nxt : cur;
        if constexpr (GATHER) { const int* rt = S.rowtab() + nu.z;
#pragma unroll
            for (int h = 0; h < 2; ++h)
#pragma unroll
                for (int i = 0; i < 2; ++i) { int R, C; stage_rc(tid * 16 + i * 8192, R, C); const int* p = rt + R + h * HALF;
                    asm volatile("global_load_dword %0, %1, off" : "+v"(tokN[h][i]) : "v"(p) : "memory"); } }
        const char* nA0 = S.aptr(nu, 0); const char* nA1 = S.aptr(nu, 1); const char* nB0 = S.bptr(nu, 0); const char* nB1 = S.bptr(nu, 1);
#pragma nounroll
        for (int t = 0; t < nt; t += 2) {
            const bool last = (t == nt - 2);
            const char* a1 = S.aptr(cur, t + 1);
            const char* a2 = last ? nA0 : S.aptr(cur, t + 2); const char* a3 = last ? nA1 : S.aptr(cur, t + 3);
            const char* b2 = last ? nB0 : S.bptr(cur, t + 2); const char* b3 = last ? nB1 : S.bptr(cur, t + 3);
            PG8_LDB(B0, 0, 0); if constexpr (NB == 2) PG8_LDB(B1, 0, 1); PG8_SCHED; PG8_LDA(At, 0, 0); PG8_STAGE_A(PG8_SA(1, 1), 1, a1, false);
            if constexpr (GATHER) { if (last) { asm volatile("" : "+v"(tokN[0][0]), "+v"(tokN[0][1]), "+v"(tokN[1][0]), "+v"(tokN[1][1]));
#pragma unroll
                for (int h = 0; h < 2; ++h)
#pragma unroll
                    for (int i = 0; i < 2; ++i) { int R, C; stage_rc(tid * 16 + i * 8192, R, C); const int tk = (R + h * HALF < nu.v) ? tokN[h][i] : 0; voffG[h][i] = (unsigned)(tk * ldaB + C * 2); } } }
            PG8_WAIT_VS(); PG8_WAIT_L(0); PG8_BAR; PG8_MMA(0, 0, At, B0); if constexpr (NB == 2) PG8_MMA(0, NB - 1, At, B1); PG8_BAR; PG8_SCHED;
            PG8_LDA(At, 0, 1); PG8_STAGE(PG8_SB(0, 0), b2, voffB); PG8_STAGE_B1(PG8_SB(0, 1), b2 + hsB); PG8_STAGE_A(PG8_SA(0, 0), 0, a2, last);
            PG8_WAIT_VS(); PG8_WAIT_L(0); PG8_BAR; PG8_MMA(1, 0, At, B0); if constexpr (NB == 2) PG8_MMA(1, NB - 1, At, B1); PG8_BAR; PG8_SCHED;
            PG8_LDB(B0, 1, 0); if constexpr (NB == 2) PG8_LDB(B1, 1, 1); PG8_SCHED; PG8_LDA(At, 1, 0); PG8_STAGE_A(PG8_SA(0, 1), 1, a2, last);
            PG8_WAIT_VS(); PG8_WAIT_L(0); PG8_BAR; PG8_MMA(0, 0, At, B0); if constexpr (NB == 2) PG8_MMA(0, NB - 1, At, B1); PG8_BAR; PG8_SCHED;
            PG8_LDA(At, 1, 1); PG8_STAGE(PG8_SB(1, 0), b3, voffB); PG8_STAGE_B1(PG8_SB(1, 1), b3 + hsB); PG8_STAGE_A(PG8_SA(1, 0), 0, a3, last);
            PG8_WAIT_VS(); PG8_WAIT_L(0); PG8_BAR; PG8_MMA(1, 0, At, B0); if constexpr (NB == 2) PG8_MMA(1, NB - 1, At, B1); PG8_BAR; PG8_SCHED;
            if constexpr (Epi::GROUP > 0) { if (((t + 2) % Epi::GROUP) == 0) { const int ln_ = lane_id_now(); E.group(st, acc, cur, (t + 2) / Epi::GROUP - 1, nt / Epi::GROUP, wr, wc, ln_ & 15, ln_ >> 4); } }
        }
        if constexpr (ALIGN_EPI) { if (wr == 0) PG8_BAR; }
        { const int ln_ = lane_id_now(), fr_ = ln_ & 15, fq_ = ln_ >> 4;
          if constexpr (Epi::GROUP > 0) { E.store(st, cur, wr, wc, fr_, fq_); if (has_next) E.begin(st, nxt, wr, wc, fr_, fq_); }
          else E(acc, cur, wr, wc, fr_, fq_); }
        if (!has_next) break;
        if constexpr (Epi::GROUP == 0) {
#pragma unroll
        for (int a = 0; a < 2; ++a)
#pragma unroll
            for (int b = 0; b < NB; ++b)
#pragma unroll
                for (int m = 0; m < 4; ++m)
#pragma unroll
                    for (int n = 0; n < 2; ++n) acc[a][b][m][n] = (f32x4){0.f, 0.f, 0.f, 0.f};
        }
        cur = nxt; ++ui;
        if constexpr (ALIGN_EPI) { if (wr == 1) PG8_BAR; }
    }
    PG8_WAIT_V(0);
    if constexpr (!ALIGN_EPI) { if (wr == 0) PG8_BAR; }
    PG8_BAR;
#undef PG8_SA
#undef PG8_SB
#undef PG8_STAGE
#undef PG8_STAGE_B1
#undef PG8_STAGE_A
#undef PG8_LDA
#undef PG8_LDB
#undef PG8_CAT
#undef PG8_MMA
#undef PG8_WAIT_V
#undef PG8_WAIT_VS
#undef PG8_WAIT_L
#undef PG8_BAR
#undef PG8_SCHED
}
}

namespace attn_body {
using bf16=unsigned short;
using bf16x8=__attribute__((ext_vector_type(8)))short;
using s16x4=__attribute__((ext_vector_type(4)))short;
using f32x16=__attribute__((ext_vector_type(16)))float;
using u32x4=__attribute__((ext_vector_type(4)))unsigned;
using f32x4=__attribute__((ext_vector_type(4)))float;
constexpr int BATCH=8,NHEAD=8,SEQ=4096,D=64,DM=NHEAD*D;
constexpr int VP=NPB;
constexpr int NW=8,QBLK=32,QB=QBLK*NW,KVBLK=64,NQB=SEQ/QB;
__device__ __forceinline__ int crow(int r,int hi){return (r&3)+8*(r>>2)+4*hi;}
#define SBAR() __builtin_amdgcn_sched_barrier(0)
__device__ __forceinline__ void cmask(f32x16&p0,f32x16&p1,int jb,int qrel,int hi){
  const float NEG=-INFINITY; int kb=64*jb+4*hi;
  #pragma unroll
  for(int r=0;r<16;++r){int kv=kb+(r&3)+8*(r>>2); if(kv>qrel)p0[r]=NEG; if(kv+32>qrel)p1[r]=NEG;}
}

constexpr int NSLOT=3, SLOTB=8192;
constexpr int LDS_K=0, LDS_V=NSLOT*SLOTB, LDS_WS=2*NSLOT*SLOTB, LDS_OST=LDS_WS+NW*64*4, LDS_BYTES=LDS_OST+NW*4096;
constexpr float C2=0.17677669529663687f*1.4426950408889634f;
__device__ __forceinline__ void glds16(const void*gsrc,unsigned lds_dst){unsigned keep;
  asm volatile("s_mov_b32 %0, m0\n\ts_mov_b32 m0, %2\n\ts_nop 0\n\tglobal_load_lds_dwordx4 %1, off\n\ts_mov_b32 m0, %0":"=&s"(keep):"v"(gsrc),"s"(lds_dst):"memory");}
__device__ __forceinline__ float max3f(float a,float b,float c){float r;asm("v_max3_f32 %0, %1, %2, %3":"=v"(r):"v"(a),"v"(b),"v"(c));return r;}
__device__ __forceinline__ float max2f(float a,float b){float r;asm("v_max_f32_e32 %0, %1, %2":"=v"(r):"v"(a),"v"(b));return r;}
__device__ __forceinline__ float fadd_s(float a,float b){float r;asm("v_add_f32_e32 %0, %1, %2":"=v"(r):"v"(a),"v"(b));return r;}
__device__ __forceinline__ float fsub_s(float a,float b){float r;asm("v_sub_f32_e32 %0, %1, %2":"=v"(r):"v"(a),"v"(b));return r;}
typedef float f32x2_t __attribute__((ext_vector_type(2))); typedef __bf16 bf16x2_t __attribute__((ext_vector_type(2)));
__device__ __forceinline__ unsigned cvtpk_s(float lo,float hi){f32x2_t v={lo,hi};bf16x2_t b=__builtin_convertvector(v,bf16x2_t);return __builtin_bit_cast(unsigned,b);}
#define WAIT_BAR(N) asm volatile("s_waitcnt vmcnt(" #N ") lgkmcnt(0)\n\ts_barrier":::"memory")

__device__ __forceinline__ void qkt(f32x16&p0,f32x16&p1,const char*Kslot,const bf16x8*qr,const f32x16&negm,int r32,int hi){
  const char*kb=Kslot+hi*1024+r32*16;
  #pragma unroll
  for(int d0=0;d0<2;++d0){
    const bf16x8 b0=*reinterpret_cast<const bf16x8*>(kb+d0*2048);
    const bf16x8 b1=*reinterpret_cast<const bf16x8*>(kb+d0*2048+512);
    if(d0==0){p0=__builtin_amdgcn_mfma_f32_32x32x16_bf16(b0,qr[0],negm,0,0,0);p1=__builtin_amdgcn_mfma_f32_32x32x16_bf16(b1,qr[0],negm,0,0,0);}
    else{p0=__builtin_amdgcn_mfma_f32_32x32x16_bf16(b0,qr[d0],p0,0,0,0);p1=__builtin_amdgcn_mfma_f32_32x32x16_bf16(b1,qr[d0],p1,0,0,0);}}
}
typedef __attribute__((address_space(3))) const char* lds_cptr;
typedef short v4i16_t __attribute__((ext_vector_type(4)));
__device__ __forceinline__ void kload8(bf16x8*kf,lds_cptr kp){
  kf[0]=*(const __attribute__((address_space(3))) bf16x8*)(kp);      kf[1]=*(const __attribute__((address_space(3))) bf16x8*)(kp+512);
  kf[2]=*(const __attribute__((address_space(3))) bf16x8*)(kp+2048); kf[3]=*(const __attribute__((address_space(3))) bf16x8*)(kp+2560);
}
__device__ __forceinline__ void kload2(bf16x8*kf,lds_cptr kp,int j){ kf[2*j]=*(const __attribute__((address_space(3))) bf16x8*)(kp+j*2048); kf[2*j+1]=*(const __attribute__((address_space(3))) bf16x8*)(kp+j*2048+512); }
__device__ __forceinline__ s16x4 vtr(lds_cptr p){ return __builtin_bit_cast(s16x4,__builtin_amdgcn_ds_read_tr16_b64_v4i16((__attribute__((address_space(3))) v4i16_t*)p)); }
__device__ __forceinline__ float rowmax(const f32x16&p0,const f32x16&p1){
  float a=max3f(p0[0],p0[1],p1[0]),b=max3f(p0[2],p0[3],p1[1]);a=max3f(a,p1[2],p1[3]);
  #pragma unroll
  for(int r=4;r<16;r+=4){a=max3f(a,p0[r],p0[r+1]);b=max3f(b,p0[r+2],p0[r+3]);a=max3f(a,p1[r],p1[r+1]);b=max3f(b,p1[r+2],p1[r+3]);}
  const float m=max2f(a,b);
  auto rr=__builtin_amdgcn_permlane32_swap(__float_as_uint(m),__float_as_uint(m),false,false);
  return max2f(__uint_as_float(rr[0]),__uint_as_float(rr[1]));
}
__device__ __forceinline__ void pv(f32x16*o,int vb,bf16x8 pa0,bf16x8 pa1,bf16x8 pa2,bf16x8 pa3){
  #pragma unroll
  for(int d0=0;d0<2;++d0){s16x4 lo[4],hi[4];
    #pragma unroll
    for(int ks=0;ks<4;++ks){
      asm volatile("ds_read_b64_tr_b16 %0,%1 offset:%c2":"=&v"(lo[ks]):"v"(vb),"i"(d0*4096+ks*1024):"memory");
      asm volatile("ds_read_b64_tr_b16 %0,%1 offset:%c2":"=&v"(hi[ks]):"v"(vb),"i"(d0*4096+ks*1024+512):"memory");}
    asm volatile("s_waitcnt lgkmcnt(0)":::"memory");SBAR();
    #define PK(k) (bf16x8){lo[k][0],lo[k][1],lo[k][2],lo[k][3],hi[k][0],hi[k][1],hi[k][2],hi[k][3]}
    o[d0]=__builtin_amdgcn_mfma_f32_32x32x16_bf16(pa0,PK(0),o[d0],0,0,0);
    o[d0]=__builtin_amdgcn_mfma_f32_32x32x16_bf16(pa1,PK(1),o[d0],0,0,0);
    o[d0]=__builtin_amdgcn_mfma_f32_32x32x16_bf16(pa2,PK(2),o[d0],0,0,0);
    o[d0]=__builtin_amdgcn_mfma_f32_32x32x16_bf16(pa3,PK(3),o[d0],0,0,0);
    #undef PK
  }
}

template<int THRL> __device__ __forceinline__ void attn_unit(int b,int h,int mp,int qb,const bf16*Q,const bf16*__restrict__ K,const bf16*__restrict__ V,bf16*Y,float lam,float osc,const float*__restrict__ sg,char*shm,int tid){
  asm volatile("":"+v"(tid)); const int lane=tid&63,r32=lane&31,hi=lane>>5; const int wid=__builtin_amdgcn_readfirstlane(tid>>6);
  const long rowbase=(long)b*SEQ; const int q0=qb*QB; const int vh=2*h+mp;
  const bf16*Qw=Q+(rowbase+q0+wid*QBLK)*DM+vh*D;
  const bf16*Kh=K+rowbase*DM+vh*D,*Vh=V+rowbase*VP+h*D;
  const unsigned lds0=(unsigned)(uintptr_t)shm;
  float*wsf=(float*)(shm+LDS_WS)+wid*64;
  const bf16*ksrc=Kh+(long)lane*DM+wid*8;
  const bf16*vsrc=Vh+(long)(16*(wid&3)+(lane>>2))*VP+(wid>>2)*32+(lane&3)*8;
  const unsigned kdst=lds0+LDS_K+wid*1024, vdst=lds0+LDS_V+wid*1024;
  #define DMA_K(t,slot) glds16(ksrc+(long)(t)*KVBLK*DM,(unsigned)__builtin_amdgcn_readfirstlane(kdst+(slot)))
  #define DMA_V(t,slot) glds16(vsrc+(long)(t)*KVBLK*VP,(unsigned)__builtin_amdgcn_readfirstlane(vdst+(slot)))
  const int vb0=(int)(lds0+LDS_V)+((lane>>4)&1)*32+(lane&3)*8+(4*hi+((lane&15)>>2))*64;
  const char*Kbase=shm+LDS_K; bf16x8 kf[4];
  const lds_cptr shm3=(lds_cptr)shm; const lds_cptr kp0=shm3+LDS_K+hi*1024+r32*16; const lds_cptr vp0=shm3+LDS_V+((lane>>4)&1)*32+(lane&3)*8+(4*hi+((lane&15)>>2))*64;
  const int NT=(q0+QB)/KVBLK;
  DMA_K(0,0);DMA_V(0,0);DMA_K(1,SLOTB);
  bf16x8 qr[2];
  #pragma unroll
  for(int d0=0;d0<2;++d0)qr[d0]=*reinterpret_cast<const bf16x8*>(&Qw[(long)r32*DM+d0*16+hi*8]);
  float zz=0.f; asm volatile("":"+v"(zz));
  float mhat=0.f;f32x16 o[3],negm;
  const bf16x8 ones8={(short)0x3F80,(short)0x3F80,(short)0x3F80,(short)0x3F80,(short)0x3F80,(short)0x3F80,(short)0x3F80,(short)0x3F80};
  #pragma unroll
  for(int r=0;r<16;++r){o[0][r]=zz;o[1][r]=zz;o[2][r]=zz;negm[r]=zz;}
  asm volatile("":"+v"(negm));
  const int qrel=wid*QBLK+r32;
  #define CMASK(P0,P1,t) do{int jb_=(t)-(NT-4); if(jb_>=0)cmask(P0,P1,jb_,qrel,hi);}while(0)
  bool resc=false;
  #define START(P0,P1) do{ const float rm=rowmax(P0,P1); resc=false; \
    { const float dl=rm; mhat=fadd_s(mhat,dl); \
      _Pragma("unroll") for(int r=0;r<16;++r){P0[r]=fsub_s(P0[r],dl);P1[r]=fsub_s(P1[r],dl);} \
      _Pragma("unroll") for(int r=0;r<16;++r)negm[r]=-mhat; asm volatile("":"+v"(negm)); } \
    _Pragma("unroll") for(int r=0;r<16;++r)P0[r]=__builtin_amdgcn_exp2f(P0[r]); }while(0)
  #define RESC() do{ if(resc){ asm volatile("s_waitcnt lgkmcnt(0)":::"memory"); \
      _Pragma("unroll") for(int d_=0;d_<3;++d_) _Pragma("unroll") for(int r=0;r<16;++r)o[d_][r]*=wsf[crow(r,hi)]; } }while(0)
  f32x16 pA0,pA1,pB0,pB1;
  int sl_prev=0,sl_cur=0,sl_next=SLOTB;
  #define ROT() do{sl_prev=sl_cur;sl_cur=sl_next;sl_next=(sl_next==(NSLOT-1)*SLOTB)?0:sl_next+SLOTB;}while(0)
  DMA_K(2,2*SLOTB);
  WAIT_BAR(3);
  qkt(pA0,pA1,Kbase,qr,negm,r32,hi);asm volatile("s_nop 15\n\ts_nop 7":"+v"(pA0),"+v"(pA1));CMASK(pA0,pA1,0);
  START(pA0,pA1);
  _Pragma("unroll") for(int r=0;r<16;++r)pA1[r]=__builtin_amdgcn_exp2f(pA1[r]);
  WAIT_BAR(0);
  DMA_K(3,0);DMA_V(1,SLOTB);
  ROT();
  kload8(kf,kp0+sl_cur);
  WAIT_BAR(2);
  s16x4 vlo[8],vhi[8]; u32x4 pw0,pw1,pw2,pw3;
  #define PKW(P,B) cvtpk_s(P[B],P[B+1])
  #define PAF(k) __builtin_bit_cast(bf16x8,pw##k)
  #define VFR(i) (bf16x8){vlo[i][0],vlo[i][1],vlo[i][2],vlo[i][3],vhi[i][0],vhi[i][1],vhi[i][2],vhi[i][3]}
  #define PIN(x) asm volatile("":"+v"(x))
  #define MX3(a,b,c) __builtin_fmaxf(__builtin_fmaxf((a),(b)),(c))
  #define GAPA(MF,W0,W1,PW) do{ MF; W0; W1; PIN(PW); SBAR(); }while(0)
  #define GAPN(W0,W1,PW) do{ W0; W1; PIN(PW); SBAR(); }while(0)
  #define GAPO(k) do{ o[2]=__builtin_amdgcn_mfma_f32_32x32x16_bf16(PAF(k),ones8,o[2],0,0,0); SBAR(); }while(0)
  #define EX(v) __builtin_amdgcn_exp2f(v)
  #define GAPB(MF,X,B) do{ MF; X[B]=EX(X[B]); X[B+1]=EX(X[B+1]); X[B+2]=EX(X[B+2]); X[B+3]=EX(X[B+3]); PIN(X); SBAR(); }while(0)
  #define VRD(i) do{ vlo[i]=vtr(vp_+(((i)>>2)*4096+((i)&3)*1024)); vhi[i]=vtr(vp_+(((i)>>2)*4096+((i)&3)*1024+512)); }while(0)
  #define KRD(G,j) do{ if(G){ kload2(kf,kp0+sl_next,j); SBAR(); } }while(0)
  #define STEP(C0,C1,P0,P1,t,GK,GV,GL) do{ SBAR(); \
    const lds_cptr vp_=vp0+sl_prev; \
    VRD(0); SBAR(); \
    GAPA(C0=__builtin_amdgcn_mfma_f32_32x32x16_bf16(kf[0],qr[0],negm,0,0,0), pw0[0]=PKW(P0,0), pw0[1]=PKW(P0,2), pw0); \
    VRD(4); SBAR(); GAPA(C1=__builtin_amdgcn_mfma_f32_32x32x16_bf16(kf[1],qr[0],negm,0,0,0), pw0[2]=PKW(P0,4), pw0[3]=PKW(P0,6), pw0); \
    VRD(1); SBAR(); GAPA(C0=__builtin_amdgcn_mfma_f32_32x32x16_bf16(kf[2],qr[1],C0,0,0,0),   pw1[0]=PKW(P0,8), pw1[1]=PKW(P0,10), pw1); \
    VRD(5); SBAR(); GAPA(C1=__builtin_amdgcn_mfma_f32_32x32x16_bf16(kf[3],qr[1],C1,0,0,0),   pw1[2]=PKW(P0,12),pw1[3]=PKW(P0,14), pw1); \
    VRD(2); SBAR(); GAPN(pw2[0]=PKW(P1,0), pw2[1]=PKW(P1,2), pw2); \
    VRD(6); SBAR(); GAPN(pw2[2]=PKW(P1,4), pw2[3]=PKW(P1,6), pw2); \
    VRD(3); SBAR(); GAPN(pw3[0]=PKW(P1,8), pw3[1]=PKW(P1,10), pw3); \
    VRD(7); SBAR(); GAPN(pw3[2]=PKW(P1,12),pw3[3]=PKW(P1,14), pw3); \
    if(GK){DMA_K((t)+3,sl_cur);} if(GV){DMA_V((t)+1,sl_next);} \
    CMASK(C0,C1,t); \
    { float a=MX3(C0[0],C0[1],C1[0]),b=MX3(C0[2],C0[3],C1[1]); a=MX3(a,C1[2],C1[3]); \
      _Pragma("unroll") for(int r=4;r<16;r+=4){a=MX3(a,C0[r],C0[r+1]);b=MX3(b,C0[r+2],C0[r+3]);a=MX3(a,C1[r],C1[r+1]);b=MX3(b,C1[r+2],C1[r+3]);} \
      float rm=__builtin_fmaxf(a,b); { auto rr=__builtin_amdgcn_permlane32_swap(__float_as_uint(rm),__float_as_uint(rm),false,false); rm=__builtin_fmaxf(__uint_as_float(rr[0]),__uint_as_float(rr[1])); } \
      resc=false; \
      if(__builtin_expect(__any(rm>(float)THRL),0)){ const float dl=__builtin_fmaxf(rm,0.f); mhat+=dl; \
        _Pragma("unroll") for(int r=0;r<16;++r){C0[r]-=dl;C1[r]-=dl;} \
        _Pragma("unroll") for(int r=0;r<16;++r)negm[r]=-mhat; asm volatile("":"+v"(negm)); \
        const float f=__builtin_amdgcn_exp2f(-dl); if(hi==0)wsf[r32]=f; resc=true; } } \
    SBAR(); \
    GAPB(o[0]=__builtin_amdgcn_mfma_f32_32x32x16_bf16(PAF(0),VFR(0),o[0],0,0,0), C0,0); \
    GAPB(o[1]=__builtin_amdgcn_mfma_f32_32x32x16_bf16(PAF(0),VFR(4),o[1],0,0,0), C0,4); GAPO(0); \
    KRD(GL,0); GAPB(o[0]=__builtin_amdgcn_mfma_f32_32x32x16_bf16(PAF(1),VFR(1),o[0],0,0,0), C0,8); \
    KRD(GL,1); GAPB(o[1]=__builtin_amdgcn_mfma_f32_32x32x16_bf16(PAF(1),VFR(5),o[1],0,0,0), C0,12); GAPO(1); \
    GAPB(o[0]=__builtin_amdgcn_mfma_f32_32x32x16_bf16(PAF(2),VFR(2),o[0],0,0,0), C1,0); \
    GAPB(o[1]=__builtin_amdgcn_mfma_f32_32x32x16_bf16(PAF(2),VFR(6),o[1],0,0,0), C1,4); GAPO(2); \
    GAPB(o[0]=__builtin_amdgcn_mfma_f32_32x32x16_bf16(PAF(3),VFR(3),o[0],0,0,0), C1,8); \
    GAPB(o[1]=__builtin_amdgcn_mfma_f32_32x32x16_bf16(PAF(3),VFR(7),o[1],0,0,0), C1,12); GAPO(3); \
    }while(0)
  int t=1;
  #undef CMASK
  #define CMASK(P0,P1,t) do{}while(0)
  for(;t+5<NT;t+=2){
    STEP(pB0,pB1,pA0,pA1,t,true,true,true);     WAIT_BAR(2); RESC(); ROT();
    STEP(pA0,pA1,pB0,pB1,t+1,true,true,true);   WAIT_BAR(2); RESC(); ROT();
  }
  #undef CMASK
  #define CMASK(P0,P1,t) do{int jb_=(t)-(NT-4); if(jb_>=0)cmask(P0,P1,jb_,qrel,hi);}while(0)
  #define ENDW(tt) do{ if((tt)+3<NT){WAIT_BAR(2);} else if((tt)+2<NT){WAIT_BAR(1);} else {WAIT_BAR(0);} }while(0)
  for(;t+1<NT;t+=2){
    STEP(pB0,pB1,pA0,pA1,t,(t+3<NT),(t+1<NT),(t+1<NT));       ENDW(t);   RESC(); ROT();
    STEP(pA0,pA1,pB0,pB1,t+1,(t+4<NT),(t+2<NT),(t+2<NT));     ENDW(t+1); RESC(); ROT();
  }
  STEP(pB0,pB1,pA0,pA1,NT-1,false,false,false); RESC();
  {
    pw0=(u32x4){PKW(pB0,0),PKW(pB0,2),PKW(pB0,4),PKW(pB0,6)};pw1=(u32x4){PKW(pB0,8),PKW(pB0,10),PKW(pB0,12),PKW(pB0,14)};pw2=(u32x4){PKW(pB1,0),PKW(pB1,2),PKW(pB1,4),PKW(pB1,6)};pw3=(u32x4){PKW(pB1,8),PKW(pB1,10),PKW(pB1,12),PKW(pB1,14)};
    SBAR(); pv(o,vb0+sl_cur,PAF(0),PAF(1),PAF(2),PAF(3));
    o[2]=__builtin_amdgcn_mfma_f32_32x32x16_bf16(PAF(0),ones8,o[2],0,0,0); o[2]=__builtin_amdgcn_mfma_f32_32x32x16_bf16(PAF(1),ones8,o[2],0,0,0);
    o[2]=__builtin_amdgcn_mfma_f32_32x32x16_bf16(PAF(2),ones8,o[2],0,0,0); o[2]=__builtin_amdgcn_mfma_f32_32x32x16_bf16(PAF(3),ones8,o[2],0,0,0); }
  #undef PKW
  #undef PAF
  #undef VFR
  #undef PIN
  #undef MX3
  #undef GAPA
  #undef GAPN
  #undef GAPO
  #undef GAPB
  #undef EX
  #undef VRD
  #undef KRD
  #undef STEP
  #undef ENDW
  float rli[16];
  #pragma unroll
  for(int r=0;r<16;++r)rli[r]=__builtin_amdgcn_rcpf(o[2][r]);
  { bf16*stg=(bf16*)(shm+LDS_OST)+wid*2048;
    if(mp==0){
      #pragma unroll
      for(int r=0;r<16;++r){const int orow=crow(r,hi);
        #pragma unroll
        for(int d0=0;d0<2;++d0)stg[orow*64+d0*32+r32]=(bf16)(cvtpk_s(o[d0][r]*rli[r],0.f)&0xffffu);}
    } else {
      #pragma unroll
      for(int r=0;r<16;++r){const int orow=crow(r,hi);
        #pragma unroll
        for(int d0=0;d0<2;++d0){const float o1=__uint_as_float(((unsigned)stg[orow*64+d0*32+r32])<<16); stg[orow*64+d0*32+r32]=(bf16)(cvtpk_s(o1-lam*(o[d0][r]*rli[r]),0.f)&0xffffu);}}
      asm volatile("s_waitcnt lgkmcnt(0)":::"memory");
      bf16*Yw=Y+(rowbase+q0+wid*QBLK)*256+h*D;
      const int ch=lane&7; const f32x4 g0=*(const f32x4*)(sg+ch*8),g1=*(const f32x4*)(sg+ch*8+4);
      #pragma unroll
      for(int i=0;i<4;++i){const int row=i*8+(lane>>3); const u32x4 v=*(const u32x4*)(stg+row*64+ch*8);
        float f[8]; f[0]=__uint_as_float(v.x<<16);f[1]=__uint_as_float(v.x&0xffff0000u);f[2]=__uint_as_float(v.y<<16);f[3]=__uint_as_float(v.y&0xffff0000u);
        f[4]=__uint_as_float(v.z<<16);f[5]=__uint_as_float(v.z&0xffff0000u);f[6]=__uint_as_float(v.w<<16);f[7]=__uint_as_float(v.w&0xffff0000u);
        float ss=(f[0]*f[0]+f[1]*f[1])+(f[2]*f[2]+f[3]*f[3])+(f[4]*f[4]+f[5]*f[5])+(f[6]*f[6]+f[7]*f[7]);
        ss+=__shfl_xor(ss,1);ss+=__shfl_xor(ss,2);ss+=__shfl_xor(ss,4);
        const float rs=__builtin_amdgcn_rsqf(ss*(1.f/64.f)+1e-5f)*osc;
        u32x4 w; w.x=cvtpk_s(f[0]*rs*g0[0],f[1]*rs*g0[1]); w.y=cvtpk_s(f[2]*rs*g0[2],f[3]*rs*g0[3]); w.z=cvtpk_s(f[4]*rs*g1[0],f[5]*rs*g1[1]); w.w=cvtpk_s(f[6]*rs*g1[2],f[7]*rs*g1[3]);
        *(u32x4*)(Yw+(long)row*256+ch*8)=w;}
    } }
  asm volatile("s_waitcnt lgkmcnt(0)\n\ts_barrier":::"memory");
  #undef DMA_K
  #undef DMA_V
  #undef CMASK
  #undef START
  #undef RESC
  #undef ROT
}
constexpr int ATTN_LDS_BYTES=LDS_BYTES;
#undef SBAR
#undef WAIT_BAR
}
#define GAS __attribute__((address_space(1)))
#define LAS __attribute__((address_space(3)))
typedef unsigned short bf16;
typedef unsigned v4u __attribute__((ext_vector_type(4)));
typedef float f32x4 __attribute__((ext_vector_type(4)));
typedef short bf16x8 __attribute__((ext_vector_type(8)));
typedef GAS unsigned gu32;
typedef GAS unsigned long long gu64;
#define RLX_AGENT __ATOMIC_RELAXED, __HIP_MEMORY_SCOPE_AGENT
#define LDS_WAIT() asm volatile("s_waitcnt lgkmcnt(0)" ::: "memory")
#define VM_WAIT() asm volatile("s_waitcnt vmcnt(0)" ::: "memory")
__device__ __forceinline__ unsigned long long rt() { return __builtin_amdgcn_s_memrealtime(); }
__device__ __forceinline__ unsigned f2bf(float f) { unsigned u = __builtin_bit_cast(unsigned, f); return (u + 0x7fffu + ((u >> 16) & 1u)) >> 16; }
__device__ __forceinline__ unsigned pk2(float lo, float hi) { return f2bf(lo) | (f2bf(hi) << 16); }

#define XB_TMO      128
#define XB_XCNT(j)  (256  + 64 * (j))
#define XB_XSUB(j)  (1280 + 64 * (j))
#define XB_XGEN(j)  (2304 + 64 * (j))
#define XB_TOP      3328
#define XB_TOPGEN   3392
#define XCD_BAR_WORDS 3456
#define XB_SPIN_CAP (1u << 18)

__device__ __forceinline__ unsigned xb_ld(unsigned* p)              { return __hip_atomic_load(p, __ATOMIC_RELAXED, __HIP_MEMORY_SCOPE_AGENT); }
__device__ __forceinline__ unsigned xb_add(unsigned* p, unsigned v) { return __hip_atomic_fetch_add(p, v, __ATOMIC_RELAXED, __HIP_MEMORY_SCOPE_AGENT); }
__device__ __forceinline__ unsigned xb_xcc_id() { return (unsigned)__builtin_amdgcn_s_getreg((3 << 11) | 20) & 0xFu; }
#define XB_SPIN(cond, bar) do { unsigned _sp = 0; while (cond) { __builtin_amdgcn_s_sleep(1); \
    if ((++_sp & 255u) == 0u) { if (xb_ld(&(bar)[XB_TMO])) break; if (_sp > XB_SPIN_CAP) { atomicAdd(&(bar)[XB_TMO], 1u); break; } } } } while (0)

struct XcdBarrier {
    unsigned* bar; unsigned x;
    unsigned off;
    unsigned G;
    int wave;
    volatile LAS unsigned* st;
};

__device__ __forceinline__ int xb_lane_id() { int l; asm volatile("v_mbcnt_lo_u32_b32 %0, -1, 0\n\tv_mbcnt_hi_u32_b32 %0, -1, %0" : "=v"(l)); return l; }
__device__ __forceinline__ bool xb_thread0(int wave) { asm volatile("" : "+s"(wave)); return wave == 0 && xb_lane_id() == 0; }
__device__ __forceinline__ XcdBarrier xcd_barrier_post(unsigned* bar, unsigned off, volatile LAS unsigned* st, int wave) {
    XcdBarrier b; b.bar = bar; b.off = off; b.x = xb_xcc_id(); b.st = st; b.wave = wave; b.G = gridDim.x * gridDim.y * gridDim.z;
    if (xb_thread0(wave)) (void)xb_add(&bar[off + XB_XCNT(b.x)], 1u);
    return b;
}
__device__ __forceinline__ void xcd_barrier_complete(unsigned* bar, unsigned x, unsigned G, unsigned& nloc, unsigned& nx) {
    unsigned sum, cnt, mine, sp = 0u;
    for (;;) {
        sum = 0u; cnt = 0u; mine = 0u;
#pragma unroll
        for (unsigned j = 0; j < 16; ++j) { const unsigned c = xb_ld(&bar[XB_XCNT(j)]); sum += c; cnt += (c > 0u) ? 1u : 0u; }
        mine = xb_ld(&bar[XB_XCNT(x)]);
        if (sum == G) break;
        __builtin_amdgcn_s_sleep(1);
        if ((++sp & 255u) == 0u) { if (xb_ld(&bar[XB_TMO])) break; if (sp > XB_SPIN_CAP) { atomicAdd(&bar[XB_TMO], 1u); break; } }
    }
    nloc = mine > 0u ? mine : 1u; nx = cnt > 0u ? cnt : 1u;
}

__device__ __forceinline__ void xcd_barrier(const XcdBarrier& b) {
    asm volatile("s_waitcnt vmcnt(0)" ::: "memory");
    __syncthreads();
    if (xb_thread0(b.wave)) {
        GAS unsigned* barg = (GAS unsigned*)b.bar; asm volatile("" : "+s"(barg)); unsigned* bar = (unsigned*)barg + b.off; const unsigned bx_ = xb_xcc_id();
        __builtin_amdgcn_s_waitcnt(0);
        unsigned nloc = b.st[0], nx = b.st[1];
        if (nloc == 0u) { xcd_barrier_complete(bar, bx_, b.G, nloc, nx); b.st[0] = nloc; b.st[1] = nx; }
        const unsigned old = xb_add(&bar[XB_XSUB(bx_)], 1u);
        const unsigned gen = old / nloc;
        if (old + 1u == (gen + 1u) * nloc) {
            __builtin_amdgcn_fence(__ATOMIC_RELEASE, "agent");
            asm volatile("s_waitcnt vmcnt(0)" ::: "memory");
            const unsigned og = xb_add(&bar[XB_TOP], 1u);
            const unsigned tg = og / nx;
            if (og + 1u == (tg + 1u) * nx) xb_add(&bar[XB_TOPGEN], 1u);
            else XB_SPIN(xb_ld(&bar[XB_TOPGEN]) == tg, bar);
            __builtin_amdgcn_fence(__ATOMIC_ACQUIRE, "agent");
            xb_add(&bar[XB_XGEN(bx_)], 1u);
            asm volatile("s_waitcnt vmcnt(0)" ::: "memory");
        } else {
            XB_SPIN(xb_ld(&bar[XB_XGEN(bx_)]) == gen, bar);
            __builtin_amdgcn_fence(__ATOMIC_ACQUIRE, "agent");
            asm volatile("s_waitcnt vmcnt(0)" ::: "memory");
        }
    }
    __syncthreads();
}
constexpr size_t KiB = 1u << 10, MiB = 1u << 20;
constexpr size_t WS_CTL = 0, CTL_ZERO_BYTES = 64 * KiB;
constexpr size_t TB_ROPEC = 1 * MiB, TB_ROPES = TB_ROPEC + 256 * KiB;
constexpr size_t TB_PWT = TB_ROPES + 256 * KiB;
constexpr size_t TB_SGW = TB_PWT + 64 * KiB;
constexpr size_t TB_HIST = TB_SGW + 256 * KiB;
constexpr size_t TB_TOKC = TB_HIST + 32 * KiB;
constexpr size_t TB_TOKW = TB_TOKC + 128 * KiB;
constexpr size_t TB_ROWTOK = TB_TOKW + 256 * KiB;
constexpr size_t TB_ROWW = TB_ROWTOK + 160 * KiB;
static_assert(TB_ROWW + 320 * KiB <= 3 * MiB, "tables");
constexpr size_t W_IN = 3 * MiB;
constexpr size_t W_G8 = W_IN + (size_t)NPB * DMODEL * 2;
constexpr size_t W_B = W_G8 + 4 * MiB;
constexpr size_t W_O = W_B + 2 * MiB;
constexpr size_t W_GU = W_O + 2 * MiB;
constexpr size_t W_D = W_GU + 16 * MiB;
static_assert(W_D + 8 * MiB <= 44 * MiB, "weights");
constexpr size_t WS_XB = 44 * MiB;
constexpr size_t WS_X = 108 * MiB;
constexpr size_t WS_QKY = 236 * MiB;
constexpr size_t WS_QP = WS_QKY, WS_KP = WS_QKY + 32 * MiB, WS_YA = WS_QKY + 64 * MiB;
constexpr size_t WS_X8 = WS_X, WS_X18 = WS_X + 32 * MiB;
constexpr size_t WS_P = 364 * MiB;
constexpr size_t WS_MG = WS_P, WS_XS = WS_P, WS_HB = WS_P + 80 * MiB;
constexpr size_t WS_END = 508 * MiB;
static_assert(WS_P + (size_t)M * NPB * 2 <= WS_END && WS_HB + (size_t)MAXROWS * 512 * 2 <= WS_END && WS_XS + (size_t)MAXROWS * 1024 * 2 <= WS_HB, "d_ws map");
constexpr int CW_TMO = 0, CW_BAR = 4096, CW_CNT = 8192;
constexpr int CAP = 32768;
constexpr size_t TB2_ROWTOK = WS_X + 64 * MiB, TB2_ROWW = WS_X + 68 * MiB;
static_assert((CW_CNT + 2 * 2048) * 4 <= (int)CTL_ZERO_BYTES && TB2_ROWW + (size_t)NCLS * CAP * 8 <= WS_X + 128 * MiB, "class tables");
constexpr int RING_OFF = 0, RING_BYTES = 131072;
constexpr int LDSCTL_OFF = RING_BYTES, MISC_OFF = LDSCTL_OFF + 320, LDSX_OFF = LDSCTL_OFF + 1024;
constexpr int LDS_BYTES = 147456;
constexpr int NWAVES = 8;
constexpr int NPHASE = 1 + 10 * DEPTH;

struct Frame {
    LAS unsigned char* lds;
    gu32* ctl;
    int tid, lane, wave, vcu, G, bx;
    float* out; unsigned char* ws;
};
typedef const GAS float* cgfptr_t;
__device__ __forceinline__ const float* arg_in(int k) {
    const __attribute__((address_space(4))) char* ka = (const __attribute__((address_space(4))) char*)__builtin_amdgcn_kernarg_segment_ptr();
    asm volatile("" : "+s"(ka));
    const GAS float* p = *(const __attribute__((address_space(4))) cgfptr_t*)(ka + 8 * k);
    return (const float*)p;
}
__device__ __forceinline__ float dpp_add(float v, const int ctrl_sel) {
    const int x = __builtin_bit_cast(int, v); int y;
    if (ctrl_sel == 0) y = __builtin_amdgcn_update_dpp(0, x, 0xB1, 0xf, 0xf, true);
    else if (ctrl_sel == 1) y = __builtin_amdgcn_update_dpp(0, x, 0x4E, 0xf, 0xf, true);
    else if (ctrl_sel == 2) y = __builtin_amdgcn_update_dpp(0, x, 0x141, 0xf, 0xf, true);
    else y = __builtin_amdgcn_update_dpp(0, x, 0x140, 0xf, 0xf, true);
    return v + __builtin_bit_cast(float, y);
}
__device__ __forceinline__ float wave_sum(float v) {
    v = dpp_add(v, 0); v = dpp_add(v, 1); v = dpp_add(v, 2); v = dpp_add(v, 3);
    const int x = __builtin_bit_cast(int, v);
    const float a = __builtin_bit_cast(float, __builtin_amdgcn_readlane(x, 0)), b = __builtin_bit_cast(float, __builtin_amdgcn_readlane(x, 16));
    const float c = __builtin_bit_cast(float, __builtin_amdgcn_readlane(x, 32)), d = __builtin_bit_cast(float, __builtin_amdgcn_readlane(x, 48));
    return (a + b) + (c + d);
}
__device__ __forceinline__ unsigned cvtpk(float lo, float hi) { unsigned r; asm volatile("v_cvt_pk_bf16_f32 %0, %1, %2" : "=v"(r) : "v"(lo), "v"(hi)); return r; }
__device__ __forceinline__ float bflo(unsigned w) { return __uint_as_float(w << 16); }
__device__ __forceinline__ float bfhi(unsigned w) { return __uint_as_float(w & 0xffff0000u); }
typedef float f32x2g __attribute__((ext_vector_type(2)));
typedef unsigned u32x2g __attribute__((ext_vector_type(2)));

__device__ __forceinline__ void transpose_item(const float* W, int N, bf16* WT, int ldt, int dst_row0, int k0, int n0, LAS float* scr, int lane) {
#pragma unroll 8
    for (int i = 0; i < 32; ++i) { const int kk = 2 * i + (lane >> 5); scr[kk * 33 + (lane & 31)] = W[(size_t)(k0 + kk) * N + n0 + (lane & 31)]; }
    LDS_WAIT(); asm volatile("" ::: "memory");
    const int c = lane & 7;
#pragma unroll
    for (int j = 0; j < 4; ++j) { const int n = (lane >> 3) + 8 * j; const LAS float* s = scr + (8 * c) * 33 + n;
        v4u o; o.x = pk2(s[0 * 33], s[1 * 33]); o.y = pk2(s[2 * 33], s[3 * 33]); o.z = pk2(s[4 * 33], s[5 * 33]); o.w = pk2(s[6 * 33], s[7 * 33]);
        *(v4u*)(WT + (size_t)(dst_row0 + n) * ldt + k0 + 8 * c) = o; }
    LDS_WAIT(); asm volatile("" ::: "memory");
}
__device__ __forceinline__ void transpose_item8(const float* W, int N, unsigned char* WT, int ldt, int dst_row0, int k0, int n0, float scale, LAS float* scr, int lane) {
#pragma unroll 8
    for (int i = 0; i < 32; ++i) { const int kk = 2 * i + (lane >> 5); scr[kk * 33 + (lane & 31)] = W[(size_t)(k0 + kk) * N + n0 + (lane & 31)]; }
    LDS_WAIT(); asm volatile("" ::: "memory");
    const int c = lane & 7;
#pragma unroll
    for (int j = 0; j < 4; ++j) { const int n = (lane >> 3) + 8 * j; const LAS float* s = scr + (8 * c) * 33 + n;
        int lo = 0, hi = 0;
        lo = __builtin_amdgcn_cvt_pk_fp8_f32(s[0 * 33] * scale, s[1 * 33] * scale, lo, false); lo = __builtin_amdgcn_cvt_pk_fp8_f32(s[2 * 33] * scale, s[3 * 33] * scale, lo, true);
        hi = __builtin_amdgcn_cvt_pk_fp8_f32(s[4 * 33] * scale, s[5 * 33] * scale, hi, false); hi = __builtin_amdgcn_cvt_pk_fp8_f32(s[6 * 33] * scale, s[7 * 33] * scale, hi, true);
        *(u32x2g*)(WT + (size_t)(dst_row0 + n) * ldt + k0 + 8 * c) = (u32x2g){(unsigned)lo, (unsigned)hi}; }
    LDS_WAIT(); asm volatile("" ::: "memory");
}
__device__ __forceinline__ void convert_weights(Frame& F, int l, int w0 = 0, int nw = NWAVES) {
    if (F.wave < w0 || F.wave >= w0 + nw) return;
    LAS float* scr = (LAS float*)(F.lds + RING_OFF + F.wave * 16384);
    const int gw = F.vcu * nw + (F.wave - w0), NGW = F.G * nw;
    bf16* Win = (bf16*)(F.ws + W_IN); unsigned char* Wg8 = F.ws + W_G8; bf16* Wb = (bf16*)(F.ws + W_B); bf16* Wo = (bf16*)(F.ws + W_O); bf16* Wgu = (bf16*)(F.ws + W_GU); bf16* Wd = (bf16*)(F.ws + W_D);
    constexpr int I_IN = 16 * 200, I_B = 512, I_O = 512, I_G = 2048, I_D = 2048, NITEMS = I_IN + I_B + I_O + 2 * I_G + I_D;
    for (int it = gw; it < NITEMS; it += NGW) {
        int r = it;
        if (r < I_IN) { const int kb = r / 200, nb = r % 200; const float* w = arg_in(1) + (size_t)l * DMODEL * NIN;
            if (nb < NPB / 32) transpose_item(w, NIN, Win, DMODEL, 32 * nb, 64 * kb, 32 * nb, scr, F.lane);
            else transpose_item8(w, NIN, Wg8, DMODEL, 32 * nb - NPB, 64 * kb, 32 * nb, pg8::FP8_WS, scr, F.lane);
            continue; } r -= I_IN;
        if (r < I_B) { const int br = r >> 7, q = r & 127, kb = q >> 5, nb = q & 31; transpose_item(arg_in(14) + (size_t)(l * 4 + br) * 256 * DMODEL, DMODEL, Wb + (size_t)br * DMODEL * 256, 256, 32 * nb, 64 * kb, 32 * nb, scr, F.lane); continue; } r -= I_B;
        if (r < I_O) { const int kb = r >> 5, nb = r & 31; transpose_item(arg_in(15) + (size_t)l * DMODEL * DMODEL, DMODEL, Wo, DMODEL, 32 * nb, 64 * kb, 32 * nb, scr, F.lane); continue; } r -= I_O;
        if (r < 2 * I_G) { const int up = r >= I_G; if (up) r -= I_G; const int e = r >> 7, q = r & 127, kb = q >> 3, nb = q & 7, n0 = 32 * nb;
            transpose_item8((up ? arg_in(23) : arg_in(22)) + (size_t)(l * 16 + e) * DMODEL * 256, 256, (unsigned char*)Wgu + (size_t)e * 512 * DMODEL, DMODEL, 256 * (n0 >> 7) + (n0 & 127) + (up ? 128 : 0), 64 * kb, n0, pg8::FP8_WS, scr, F.lane); continue; } r -= 2 * I_G;
        { const int e = r >> 7, q = r & 127, kb = q >> 5, nb = q & 31; transpose_item8(arg_in(24) + (size_t)(l * 16 + e) * 256 * DMODEL, DMODEL, (unsigned char*)Wd + (size_t)e * DMODEL * 256, 256, 32 * nb, 64 * kb, 32 * nb, pg8::FP8_WS, scr, F.lane); }
    }
}
__device__ __forceinline__ void p0_prologue(Frame& F) {
    constexpr int XW = 8;
    convert_weights(F, 0);
    const int gt = F.vcu * 512 + F.tid, NT = F.G * 512;
    if (F.wave < XW) { const float* x = arg_in(0); bf16* xb = (bf16*)(F.ws + WS_XB); unsigned char* x8 = F.ws + WS_X8; const int gx = (F.vcu * XW + F.wave) * 64 + F.lane, NX = F.G * XW * 64, NI = M * DMODEL / 8;
      for (int i0 = gx; i0 < NI; i0 += 4 * NX) { f32x4 a[4], b[4];
#pragma unroll
          for (int u = 0; u < 4; ++u) { const int i = i0 + u * NX; if (i < NI) { a[u] = *(const f32x4*)(x + (size_t)i * 8); b[u] = *(const f32x4*)(x + (size_t)i * 8 + 4); } }
#pragma unroll
          for (int u = 0; u < 4; ++u) { const int i = i0 + u * NX; if (i < NI) {
              v4u o; o.x = cvtpk(a[u][0], a[u][1]); o.y = cvtpk(a[u][2], a[u][3]); o.z = cvtpk(b[u][0], b[u][1]); o.w = cvtpk(b[u][2], b[u][3]); *(v4u*)(xb + (size_t)i * 8) = o;
              const float s = pg8::FP8_XS;
              *(u32x2g*)(x8 + (size_t)i * 8) = (u32x2g){pg8::fp8_pk4(a[u][0] * s, a[u][1] * s, a[u][2] * s, a[u][3] * s), pg8::fp8_pk4(b[u][0] * s, b[u][1] * s, b[u][2] * s, b[u][3] * s)}; } } } }
    { float* rc = (float*)(F.ws + TB_ROPEC); float* rs = (float*)(F.ws + TB_ROPES);
      for (int i = gt; i < SEQ * 16; i += NT) { const int pos = i >> 4, j = i & 15;
          const float inv = (float)exp2(-(double)j * (13.287712379549449 / 16.0)); const float ang = (float)pos * inv;
          const double a = (double)ang; const double k = rint(a * 0.15915494309189535); const float r = (float)(a - k * 6.283185307179586);
          rc[i] = cosf(r); rs[i] = sinf(r); } }
    { bf16* pwt = (bf16*)(F.ws + TB_PWT); const float* pw = arg_in(2);
      for (int i = gt; i < 2 * 4 * 64 * 64; i += NT) { const int c = i & 63, d = (i >> 6) & 63, lg = i >> 12; pwt[i] = (bf16)f2bf(pw[(size_t)lg * 4096 + c * 64 + d]); }
      bf16* sgw = (bf16*)(F.ws + TB_SGW); const float* sw = arg_in(12);
      for (int i = gt; i < 2 * 4 * 128 * 128; i += NT) { const int s = i & 127, t = (i >> 7) & 127; sgw[i] = (s <= t) ? (bf16)f2bf(sw[i]) : (bf16)0; } }
}

constexpr int VTP = 136;
__device__ __forceinline__ void unpack8(const v4u v, float (&f)[8]) { f[0] = bflo(v.x); f[1] = bfhi(v.x); f[2] = bflo(v.y); f[3] = bfhi(v.y); f[4] = bflo(v.z); f[5] = bfhi(v.z); f[6] = bflo(v.w); f[7] = bfhi(v.w); }
__device__ __forceinline__ v4u pack8(const float (&f)[8]) { v4u w; w.x = cvtpk(f[0], f[1]); w.y = cvtpk(f[2], f[3]); w.z = cvtpk(f[4], f[5]); w.w = cvtpk(f[6], f[7]); return w; }
template <int WIN> __device__ __forceinline__ void pool_item(const bf16* P, const bf16* pwt_g, const float* psc, bf16* YA, int g, int row0, int pos0, int tb, int r32, int hi) {
    const int t = 32 * tb + r32, pos = pos0 + t; const size_t row = (size_t)(row0 + t);
    const int cnt = (pos + 1 < WIN) ? pos + 1 : WIN; const float rcnt = 1.0f / (float)cnt;
    attn_body::f32x16 acc0 = {}, acc1 = {};
#pragma unroll
    for (int ks = 0; ks < 4; ++ks) { const bf16* src = P + row * NPB + PC_POOL + 64 * g + 16 * ks + 8 * hi;
        v4u v[WIN];
#pragma unroll
        for (int j = 0; j < WIN; ++j) v[j] = *(const v4u*)(src - (size_t)(j < cnt ? j : 0) * NPB);
        float s[8], a0[8]; unpack8(v[0], a0);
#pragma unroll
        for (int e = 0; e < 8; ++e) s[e] = a0[e];
#pragma unroll
        for (int j = 1; j < WIN; ++j) { float x[8]; unpack8(v[j], x); const float m = j < cnt ? 1.f : 0.f;
#pragma unroll
            for (int e = 0; e < 8; ++e) s[e] += m * x[e]; }
        float d[8];
#pragma unroll
        for (int e = 0; e < 8; ++e) d[e] = s[e] * rcnt - a0[e];
        const bf16x8 dfr = __builtin_bit_cast(bf16x8, pack8(d));
        const bf16x8 w0 = *(const bf16x8*)(pwt_g + (size_t)r32 * 64 + 16 * ks + 8 * hi), w1 = *(const bf16x8*)(pwt_g + (size_t)(32 + r32) * 64 + 16 * ks + 8 * hi);
        acc0 = __builtin_amdgcn_mfma_f32_32x32x16_bf16(w0, dfr, acc0, 0, 0, 0); acc1 = __builtin_amdgcn_mfma_f32_32x32x16_bf16(w1, dfr, acc1, 0, 0, 0); }
#pragma unroll
    for (int q4 = 0; q4 < 4; ++q4) { const int c0 = 64 * g + 8 * q4 + 4 * hi; const f32x4 p0 = *(const f32x4*)(psc + c0), p1 = *(const f32x4*)(psc + c0 + 32);
        u32x2g w; w.x = cvtpk(acc0[4 * q4 + 0] * p0[0], acc0[4 * q4 + 1] * p0[1]); w.y = cvtpk(acc0[4 * q4 + 2] * p0[2], acc0[4 * q4 + 3] * p0[3]); *(u32x2g*)(YA + row * 256 + c0) = w;
        w.x = cvtpk(acc1[4 * q4 + 0] * p1[0], acc1[4 * q4 + 1] * p1[1]); w.y = cvtpk(acc1[4 * q4 + 2] * p1[2], acc1[4 * q4 + 3] * p1[3]); *(u32x2g*)(YA + row * 256 + c0 + 32) = w; }
}
__device__ __forceinline__ void prep_unit(Frame& F, int ch, int l) {
    const bf16* P = (const bf16*)(F.ws + WS_P);
    int tid = F.tid; asm volatile("" : "+v"(tid)); const int row0 = ch * 128, pos0 = (ch & 31) * 128, lane = tid & 63, wave = F.wave;
    { bf16* YB = (bf16*)(F.ws + WS_YA) + (size_t)1 * M * 256; const float* cw = arg_in(4) + (size_t)l * 3 * 256; const int c8 = (tid & 31) * 8;
      float w0[8], w1[8], w2[8];
      { const f32x4 a = *(const f32x4*)(cw + c8), b = *(const f32x4*)(cw + c8 + 4), c = *(const f32x4*)(cw + 256 + c8), d = *(const f32x4*)(cw + 256 + c8 + 4), e = *(const f32x4*)(cw + 512 + c8), g = *(const f32x4*)(cw + 512 + c8 + 4);
#pragma unroll
        for (int i = 0; i < 4; ++i) { w0[i] = a[i]; w0[4 + i] = b[i]; w1[i] = c[i]; w1[4 + i] = d[i]; w2[i] = e[i]; w2[4 + i] = g[i]; } }
      for (int bt = 0; bt < 2; ++bt) { v4u gb[4], gc[4][3], hh[4][3];
#pragma unroll
          for (int u = 0; u < 4; ++u) { const int r = (tid >> 5) + 16 * (bt * 4 + u); const int pos = pos0 + r; const bf16* pr = P + (size_t)(row0 + r) * NPB;
              gb[u] = *(const v4u*)(pr + PC_GB + c8);
#pragma unroll
              for (int j = 0; j < 3; ++j) { const bf16* pj = pr - (size_t)(pos - j >= 0 ? j : 0) * NPB; gc[u][j] = *(const v4u*)(pj + PC_GC + c8); hh[u][j] = *(const v4u*)(pj + PC_H + c8); } }
#pragma unroll
          for (int u = 0; u < 4; ++u) { const int r = (tid >> 5) + 16 * (bt * 4 + u); const int pos = pos0 + r;
              float g[8], z0[8], z1[8], z2[8], a[8], b[8]; unpack8(gb[u], g);
              unpack8(gc[u][0], a); unpack8(hh[u][0], b);
#pragma unroll
              for (int e = 0; e < 8; ++e) z0[e] = a[e] * b[e];
              unpack8(gc[u][1], a); unpack8(hh[u][1], b); const float m1 = pos >= 1 ? 1.f : 0.f;
#pragma unroll
              for (int e = 0; e < 8; ++e) z1[e] = a[e] * b[e] * m1;
              unpack8(gc[u][2], a); unpack8(hh[u][2], b); const float m2 = pos >= 2 ? 1.f : 0.f;
#pragma unroll
              for (int e = 0; e < 8; ++e) z2[e] = a[e] * b[e] * m2;
              float o[8];
#pragma unroll
              for (int e = 0; e < 8; ++e) o[e] = g[e] * (w0[e] * z2[e] + w1[e] * z1[e] + w2[e] * z0[e]);
              *(v4u*)(YB + (size_t)(row0 + r) * 256 + c8) = pack8(o); } } }
    LAS bf16* VT = (LAS bf16*)(F.lds + RING_OFF);
    { const float* lg = arg_in(10) + l * 256; const float* lb = arg_in(11) + l * 256; const f32x4 g4 = *(const f32x4*)(lg + 4 * lane), b4 = *(const f32x4*)(lb + 4 * lane);
      for (int bt = 0; bt < 4; ++bt) { u32x2g v[4];
#pragma unroll
          for (int u = 0; u < 4; ++u) v[u] = *(const u32x2g*)(P + (size_t)(row0 + wave * 16 + bt * 4 + u) * NPB + PC_VV + 4 * lane);
#pragma unroll
          for (int u = 0; u < 4; ++u) { const int r = wave * 16 + bt * 4 + u; float f[4] = {bflo(v[u].x), bfhi(v[u].x), bflo(v[u].y), bfhi(v[u].y)};
              const float mean = wave_sum((f[0] + f[1]) + (f[2] + f[3])) * (1.f / 256.f);
#pragma unroll
              for (int e = 0; e < 4; ++e) f[e] -= mean;
              const float rstd = __builtin_amdgcn_rsqf(wave_sum((f[0] * f[0] + f[1] * f[1]) + (f[2] * f[2] + f[3] * f[3])) * (1.f / 256.f) + LN_EPS);
#pragma unroll
              for (int e = 0; e < 4; ++e) VT[(4 * lane + e) * VTP + r] = (bf16)f2bf(f[e] * rstd * g4[e] + b4[e]); } } }
    LDS_WAIT(); __syncthreads();
    const int r32 = lane & 31, hi = lane >> 5;
    { const int g = wave >> 1, cb = wave & 1; const bf16* sgw = (const bf16*)(F.ws + TB_SGW) + (size_t)(l * 4 + g) * 128 * 128; const float* sb = arg_in(13) + (size_t)(l * 4 + g) * 128;
      bf16* YD = (bf16*)(F.ws + WS_YA) + (size_t)3 * M * 256;
#pragma unroll
      for (int tb = 0; tb < 4; ++tb) { attn_body::f32x16 acc = {}; bf16x8 bfr[8]; u32x2g uu[4]; const int t = 32 * tb + r32; const size_t row = (size_t)(row0 + t);
#pragma unroll
          for (int ks = 0; ks < 2 * (tb + 1); ++ks) bfr[ks] = *(const bf16x8*)(sgw + (size_t)t * 128 + 16 * ks + 8 * hi);
#pragma unroll
          for (int q4 = 0; q4 < 4; ++q4) uu[q4] = *(const u32x2g*)(P + row * NPB + PC_U + 64 * g + 32 * cb + 8 * q4 + 4 * hi);
          const float bias = sb[t];
#pragma unroll
          for (int ks = 0; ks < 2 * (tb + 1); ++ks) { const bf16x8 a = *(const LAS bf16x8*)(VT + (64 * g + 32 * cb + r32) * VTP + 16 * ks + 8 * hi);
              acc = __builtin_amdgcn_mfma_f32_32x32x16_bf16(a, bfr[ks], acc, 0, 0, 0); }
#pragma unroll
          for (int q4 = 0; q4 < 4; ++q4) { const int c0 = 64 * g + 32 * cb + 8 * q4 + 4 * hi; const u32x2g u = uu[q4];
              u32x2g w; w.x = cvtpk(bflo(u.x) * (acc[4 * q4 + 0] + bias), bfhi(u.x) * (acc[4 * q4 + 1] + bias)); w.y = cvtpk(bflo(u.y) * (acc[4 * q4 + 2] + bias), bfhi(u.y) * (acc[4 * q4 + 3] + bias));
              *(u32x2g*)(YD + row * 256 + c0) = w; } } }
    { const int g = wave & 3; const bf16* pwt_g = (const bf16*)(F.ws + TB_PWT) + (size_t)(l * 4 + g) * 4096; const float* psc = arg_in(3) + l * 256; bf16* YA = (bf16*)(F.ws + WS_YA);
      for (int tb = wave >> 2; tb < 4; tb += 2) {
          if (g == 0) pool_item<2>(P, pwt_g, psc, YA, g, row0, pos0, tb, r32, hi); else if (g == 1) pool_item<4>(P, pwt_g, psc, YA, g, row0, pos0, tb, r32, hi);
          else if (g == 2) pool_item<8>(P, pwt_g, psc, YA, g, row0, pos0, tb, r32, hi); else pool_item<16>(P, pwt_g, psc, YA, g, row0, pos0, tb, r32, hi); } }
    __syncthreads();
}

__device__ __forceinline__ void route_phase(Frame& F, int l) {
    int tid = F.tid; asm volatile("" : "+v"(tid)); const bf16* H1 = (const bf16*)F.out; bf16* XB = (bf16*)(F.ws + WS_XB); unsigned char* X18 = F.ws + WS_X18; const int lane = tid & 63, wave = F.wave;
    LAS float* Wrg = (LAS float*)(F.lds + RING_OFF); LAS float* Wre = Wrg + 4096;
    LAS int* cc = (LAS int*)(F.lds + LDSCTL_OFF + 224);
    { const float* wrg = arg_in(18) + (size_t)l * 4096; const float* wre = arg_in(20) + (size_t)l * 16384;
      for (int k = tid; k < 1024; k += 512) { const int dst = (((k >> 8) * 4 + (k & 3)) * 64 + ((k & 255) >> 2)) * 4; *(LAS f32x4*)(Wrg + dst) = *(const f32x4*)(wrg + 4 * k);
#pragma unroll
          for (int g = 0; g < 4; ++g) *(LAS f32x4*)(Wre + g * 4096 + dst) = *(const f32x4*)(wre + (size_t)g * 4096 + 4 * k); } }
    const float* g1 = arg_in(16) + l * DMODEL; const float* b1 = arg_in(17) + l * DMODEL; const float* brg = arg_in(19) + l * 4; const float* bre = arg_in(21) + l * 16;
    int* rowtok = (int*)(F.ws + TB2_ROWTOK); f32x2g* roww = (f32x2g*)(F.ws + TB2_ROWW); gu32* gcnt = F.ctl + CW_CNT + 2048 * l;
    LAS int* ent = (LAS int*)(F.lds + LDSX_OFF); LAS int* cbase = (LAS int*)(F.lds + LDSX_OFF + 2048);
    f32x4 gg[4], bb[4];
#pragma unroll
    for (int j = 0; j < 4; ++j) { gg[j] = *(const f32x4*)(g1 + 4 * lane + 256 * j); bb[j] = *(const f32x4*)(b1 + 4 * lane + 256 * j); }
    const f32x4 brg4 = *(const f32x4*)brg;
    for (int rg = F.vcu; rg < M / 128; rg += F.G) {
        if (tid < NCLS) cc[tid] = 0;
        LDS_WAIT(); __syncthreads();
        constexpr int NR = 2;
        u32x2g qn[NR][4];
#pragma unroll
        for (int r = 0; r < NR; ++r)
#pragma unroll
            for (int j = 0; j < 4; ++j) qn[r][j] = *(const u32x2g*)(H1 + ((size_t)rg * 128 + wave * 16 + r) * DMODEL + 4 * lane + 256 * j);
        for (int i = 0; i < 16; i += NR) {
            f32x4 v[NR][4]; float mean[NR], rstd[NR];
#pragma unroll
            for (int r = 0; r < NR; ++r)
#pragma unroll
                for (int j = 0; j < 4; ++j) v[r][j] = (f32x4){bflo(qn[r][j].x), bfhi(qn[r][j].x), bflo(qn[r][j].y), bfhi(qn[r][j].y)};
            if (i + NR < 16) {
#pragma unroll
                for (int r = 0; r < NR; ++r)
#pragma unroll
                    for (int j = 0; j < 4; ++j) qn[r][j] = *(const u32x2g*)(H1 + ((size_t)rg * 128 + wave * 16 + i + NR + r) * DMODEL + 4 * lane + 256 * j); }
#pragma unroll
            for (int r = 0; r < NR; ++r) { float s = 0.f;
#pragma unroll
                for (int j = 0; j < 4; ++j) s += (v[r][j][0] + v[r][j][1]) + (v[r][j][2] + v[r][j][3]);
                mean[r] = wave_sum(s) * (1.f / DMODEL); }
#pragma unroll
            for (int r = 0; r < NR; ++r) { float s2 = 0.f;
#pragma unroll
                for (int j = 0; j < 4; ++j) { v[r][j] = v[r][j] - mean[r]; s2 += (v[r][j][0] * v[r][j][0] + v[r][j][1] * v[r][j][1]) + (v[r][j][2] * v[r][j][2] + v[r][j][3] * v[r][j][3]); }
                rstd[r] = 1.f / sqrtf(wave_sum(s2) * (1.f / DMODEL) + LN_EPS); }
            f32x4 gl[NR];
#pragma unroll
            for (int r = 0; r < NR; ++r) gl[r] = (f32x4){0.f, 0.f, 0.f, 0.f};
#pragma unroll
            for (int r = 0; r < NR; ++r) { const size_t row = (size_t)rg * 128 + wave * 16 + i + r;
#pragma unroll
                for (int j = 0; j < 4; ++j) { v[r][j] = v[r][j] * rstd[r] * gg[j] + bb[j];
                    u32x2g w; w.x = cvtpk(v[r][j][0], v[r][j][1]); w.y = cvtpk(v[r][j][2], v[r][j][3]); *(u32x2g*)(XB + row * DMODEL + 4 * lane + 256 * j) = w;
                    *(unsigned*)(X18 + row * DMODEL + 4 * lane + 256 * j) = pg8::fp8_pk4(v[r][j][0] * pg8::FP8_XS, v[r][j][1] * pg8::FP8_XS, v[r][j][2] * pg8::FP8_XS, v[r][j][3] * pg8::FP8_XS); } }
#pragma unroll
            for (int j = 0; j < 4; ++j)
#pragma unroll
                for (int e = 0; e < 4; ++e) { const f32x4 w = *(const LAS f32x4*)(Wrg + ((j * 4 + e) * 64 + lane) * 4);
#pragma unroll
                    for (int r = 0; r < NR; ++r) gl[r] += w * v[r][j][e]; }
            int gs[NR]; float psel[NR];
#pragma unroll
            for (int r = 0; r < NR; ++r) {
#pragma unroll
                for (int e = 0; e < 4; ++e) gl[r][e] = wave_sum(gl[r][e]) + brg4[e];
                int g_ = 0; float gm = gl[r][0];
#pragma unroll
                for (int e = 1; e < 4; ++e) if (gl[r][e] > gm) { gm = gl[r][e]; g_ = e; }
                psel[r] = 1.0f / ((expf(gl[r][0] - gm) + expf(gl[r][1] - gm)) + (expf(gl[r][2] - gm) + expf(gl[r][3] - gm)));
                gs[r] = __builtin_amdgcn_readfirstlane(g_); }
            f32x4 el[NR];
#pragma unroll
            for (int r = 0; r < NR; ++r) el[r] = (f32x4){0.f, 0.f, 0.f, 0.f};
#pragma unroll
            for (int r = 0; r < NR; ++r) { const LAS float* wre = Wre + gs[r] * 4096;
#pragma unroll
                for (int j = 0; j < 4; ++j)
#pragma unroll
                    for (int e = 0; e < 4; ++e) el[r] += *(const LAS f32x4*)(wre + ((j * 4 + e) * 64 + lane) * 4) * v[r][j][e]; }
#pragma unroll
            for (int r = 0; r < NR; ++r) { const size_t row = (size_t)rg * 128 + wave * 16 + i + r; const f32x4 bre4 = *(const f32x4*)(bre + gs[r] * 4);
#pragma unroll
                for (int e = 0; e < 4; ++e) el[r][e] = wave_sum(el[r][e]) + bre4[e];
                int i1 = 0; float v1 = el[r][0];
#pragma unroll
                for (int e = 1; e < 4; ++e) if (el[r][e] > v1) { v1 = el[r][e]; i1 = e; }
                int i2 = -1; float v2 = 0.f;
#pragma unroll
                for (int e = 0; e < 4; ++e) if (e != i1 && (i2 < 0 || el[r][e] > v2)) { v2 = el[r][e]; i2 = e; }
                const float w1 = psel[r] / (1.0f + expf(v2 - v1)), w2 = psel[r] - w1;
                const int ea = i1 < i2 ? i1 : i2, eb = i1 < i2 ? i2 : i1; const float wa = i1 < i2 ? w1 : w2, wb = i1 < i2 ? w2 : w1;
                const int pair = (ea == 0) ? (eb - 1) : (ea == 1) ? (eb + 1) : 5; const int cls = gs[r] * 6 + pair;
                if (lane == 0) { const int lr = atomicAdd((int*)(cc + cls), 1); LAS int* e_ = ent + 4 * (wave * 16 + i + r); e_[0] = cls; e_[1] = lr; e_[2] = __float_as_int(wa); e_[3] = __float_as_int(wb); } }
        }
        LDS_WAIT(); __syncthreads();
        if (tid < NCLS) { const int n = cc[tid]; cbase[tid] = n ? (int)__hip_atomic_fetch_add(gcnt + 64 * tid, (unsigned)n, RLX_AGENT) : 0; }
        LDS_WAIT(); __syncthreads();
        if (tid < 128) { const LAS int* e_ = ent + 4 * tid; const int idx = e_[0] * CAP + cbase[e_[0]] + e_[1]; rowtok[idx] = rg * 128 + tid; roww[idx] = (f32x2g){__int_as_float(e_[2]), __int_as_float(e_[3])}; }
        __syncthreads();
    }
}
__device__ __forceinline__ void moe_tables(Frame& F, int l) {
    LAS int* cb = (LAS int*)(F.lds + LDSCTL_OFF); LAS int* tot = (LAS int*)(F.lds + LDSCTL_OFF + 128);
    if (F.tid < NCLS) tot[F.tid] = (int)__hip_atomic_load(F.ctl + CW_CNT + 2048 * l + 64 * F.tid, RLX_AGENT);
    LDS_WAIT(); __syncthreads();
    if (F.tid == 0) { int b = 0; for (int c = 0; c < NCLS; ++c) { cb[c] = b; b += (tot[c] + 255) & ~255; } cb[NCLS] = b; }
    LDS_WAIT(); __syncthreads();
}
__device__ __forceinline__ int cls_of_rowtile_(const LAS int* cb, int rt) { int c = 0; for (int q = 1; q < NCLS; ++q) c += (__builtin_amdgcn_readfirstlane(cb[q]) <= rt * 256) ? 1 : 0; return c; }
__device__ __forceinline__ int rowtile_info(const LAS int* cb, int rt, int& z, int& v) {
    const int c = cls_of_rowtile_(cb, rt); const int s0 = rt * 256 - __builtin_amdgcn_readfirstlane(cb[c]); const int n = __builtin_amdgcn_readfirstlane(cb[32 + c]) - s0;
    z = c * CAP + s0; v = n < 256 ? n : 256; return c; }
__device__ __forceinline__ void cls_experts(int cls, int& e1, int& e2) { const int g = cls / 6, p = cls % 6; const int a = p < 3 ? 0 : (p < 5 ? 1 : 2), b = p < 3 ? p + 1 : (p < 5 ? p - 1 : 3); e1 = g * 4 + a; e2 = g * 4 + b; }
struct MoeUpOrder {
    const char* A; const char* B; const int* rt; const LAS int* cb; int G, c;
    __device__ __forceinline__ bool next(int i, pg8::Unit& u) const {
        const int L = i * G + c, nrt = __builtin_amdgcn_readfirstlane(cb[NCLS]) >> 8; if (L >= nrt * 4) return false;
        const int rt_ = L >> 2, j = L & 3, half = j >> 1, jj = j & 1; int e1, e2; cls_experts(rowtile_info(cb, rt_, u.z, u.v), e1, e2);
        u.pm = rt_; u.pn = (half ? e2 : e1) * 2 + jj; u.x = half * 256 + jj * 128; u.y = half; return true; }
    __device__ __forceinline__ const int* rowtab() const { return rt; }
    __device__ __forceinline__ const char* aptr(const pg8::Unit& u, int t) const { return A + (size_t)t * 128; }
    __device__ __forceinline__ const char* bptr(const pg8::Unit& u, int t) const { return B + (size_t)u.pn * (256 * 1024) + (size_t)t * 128; }
};
struct MoeDownOrder {
    const char* A; const char* B; const LAS int* cb; int G, c;
    __device__ __forceinline__ bool next(int i, pg8::Unit& u) const {
        const int L = i * G + c, nrt = __builtin_amdgcn_readfirstlane(cb[NCLS]) >> 8; if (L >= nrt * 4) return false;
        const int rt = L >> 2; int e1, e2; cls_experts(rowtile_info(cb, rt, u.z, u.v), e1, e2);
        u.pm = rt; u.pn = L & 3; u.x = e1; u.y = e2; return true; }
    __device__ __forceinline__ const char* aptr(const pg8::Unit& u, int t) const { return A + (size_t)u.pm * (256 * 512) + (size_t)t * 128; }
    __device__ __forceinline__ const char* bptr(const pg8::Unit& u, int t) const { return B + ((size_t)((t < 2 ? u.x : u.y) * 1024 + u.pn * 256) * 256) + (size_t)(t & 1) * 128; }
};
struct MergeOrder {
    const char* A; const char* B; int G, c;
    __device__ __forceinline__ bool next(int i, pg8::Unit& u) const {
        const int L = i * G + c; if (L >= (M / 256) * 8) return false;
        u.pm = L >> 3; u.pn = L & 7; u.x = 0; u.y = 0; u.z = 0; u.v = 0; return true; }
    __device__ __forceinline__ const char* aptr(const pg8::Unit& u, int t) const { return A + (size_t)(t >> 2) * ((size_t)M * 512) + (size_t)u.pm * (256 * 512) + (size_t)(t & 3) * 128; }
    __device__ __forceinline__ const char* bptr(const pg8::Unit& u, int t) const { return B + (size_t)(t >> 2) * (1024 * 512) + (size_t)u.pn * (128 * 512) + (size_t)(t & 3) * 128; }
};
template <int NR> __device__ __forceinline__ void ln_rows(const bf16* hr, const float* g, const float* b, float* of, bf16* ob, unsigned char* o8, size_t rstride, int lane) {
    f32x4 v[NR][4]; float mean[NR], rstd[NR];
#pragma unroll
    for (int r = 0; r < NR; ++r)
#pragma unroll
        for (int j = 0; j < 4; ++j) { const u32x2g q = *(const u32x2g*)(hr + r * rstride + 4 * lane + 256 * j); v[r][j] = (f32x4){bflo(q.x), bfhi(q.x), bflo(q.y), bfhi(q.y)}; }
    f32x4 gg[4], bb[4];
#pragma unroll
    for (int j = 0; j < 4; ++j) { gg[j] = *(const f32x4*)(g + 4 * lane + 256 * j); bb[j] = *(const f32x4*)(b + 4 * lane + 256 * j); }
#pragma unroll
    for (int r = 0; r < NR; ++r) { float s = 0.f;
#pragma unroll
        for (int j = 0; j < 4; ++j) s += (v[r][j][0] + v[r][j][1]) + (v[r][j][2] + v[r][j][3]);
        mean[r] = wave_sum(s) * (1.f / DMODEL); }
#pragma unroll
    for (int r = 0; r < NR; ++r) { float s2 = 0.f;
#pragma unroll
        for (int j = 0; j < 4; ++j) { v[r][j] = v[r][j] - mean[r]; s2 += (v[r][j][0] * v[r][j][0] + v[r][j][1] * v[r][j][1]) + (v[r][j][2] * v[r][j][2] + v[r][j][3] * v[r][j][3]); }
        rstd[r] = 1.f / sqrtf(wave_sum(s2) * (1.f / DMODEL) + LN_EPS); }
#pragma unroll
    for (int r = 0; r < NR; ++r)
#pragma unroll
        for (int j = 0; j < 4; ++j) { const f32x4 o = v[r][j] * rstd[r] * gg[j] + bb[j];
            if (of) *(f32x4*)(of + r * rstride + 4 * lane + 256 * j) = o;
            else { u32x2g w; w.x = cvtpk(o[0], o[1]); w.y = cvtpk(o[2], o[3]); *(u32x2g*)(ob + r * rstride + 4 * lane + 256 * j) = w;
                const float sc = pg8::FP8_XS; *(unsigned*)(o8 + r * rstride + 4 * lane + 256 * j) = pg8::fp8_pk4(o[0] * sc, o[1] * sc, o[2] * sc, o[3] * sc); } }
}

struct Args { const float* in[27]; float* out; unsigned char* ws; int ph_lo, ph_hi; };
__device__ __forceinline__ void mkframe(Frame& F, int wave, LAS unsigned char* lds) {
    unsigned la = (unsigned)(uintptr_t)lds; asm volatile("" : "+s"(la), "+s"(wave));
    LAS unsigned char* l = (LAS unsigned char*)(uintptr_t)la; volatile LAS unsigned* mi = (volatile LAS unsigned*)(l + MISC_OFF);
    const unsigned w0 = __builtin_amdgcn_readfirstlane(mi[10]), w1 = __builtin_amdgcn_readfirstlane(mi[11]), o0 = __builtin_amdgcn_readfirstlane(mi[12]), o1 = __builtin_amdgcn_readfirstlane(mi[13]);
    GAS unsigned char* wsg = (GAS unsigned char*)(uintptr_t)(((unsigned long long)w1 << 32) | w0); GAS float* og = (GAS float*)(uintptr_t)(((unsigned long long)o1 << 32) | o0);
    const int tid = wave * 64 + xb_lane_id();
    F.ws = (unsigned char*)wsg; F.out = (float*)og;
    F.G = (int)__builtin_amdgcn_readfirstlane(mi[14]); F.vcu = (int)__builtin_amdgcn_readfirstlane(mi[15]); F.bx = (int)__builtin_amdgcn_readfirstlane(mi[16]);
    F.tid = tid; F.lane = tid & 63; F.wave = wave; F.lds = l; F.ctl = (gu32*)(F.ws + WS_CTL);
}
#if MK_PER_PHASE
#define GRID_BAR() do { } while (0)
#else
#define GRID_BAR() do { XcdBarrier b_; b_.bar = (unsigned*)F.ws; b_.off = (unsigned)(WS_CTL / 4 + CW_BAR); b_.x = 0; b_.st = (volatile LAS unsigned*)(F.lds + MISC_OFF) + 8; b_.wave = F.wave; b_.G = (unsigned)F.G; xcd_barrier(b_); } while (0)
#endif
#ifndef PHMASK
#define PHMASK 0x7ff
#endif
#define IN(k) (lo <= (k) && (k) < hi)
#define ON(j) ((PHMASK >> (j)) & 1)
#ifndef REPMASK
#define REPMASK 0
#endif
#define REP(j) for (int rep_ = 0; rep_ < 1 + ((REPMASK >> (j)) & 1); ++rep_)
#ifndef BARX
#define BARX 1
#endif
#define SEAM(k) do { if (IN(k) && IN((k) + 1)) { for (int bx_ = 0; bx_ < BARX; ++bx_) GRID_BAR(); } } while (0)
#define FRAME() Frame F; mkframe(F, wave0, ldsb); unsigned char* const ws = F.ws; LAS unsigned char* const ring = F.lds + RING_OFF; (void)ws; (void)ring
template <int l> __device__ __forceinline__ void layer_phases(const int lo, const int hi, const int wave0, LAS unsigned char* const ldsb) {
        const int pb = 1 + 10 * l;
        const float lam_init = l == 0 ? 0.2f : 0.35550906759096764f;
        if (ON(1) && IN(pb + 0)) { FRAME();
            { pg8::StdOrder S; S.init(ws + WS_XB, ws + W_IN, M, NPB, DMODEL * 2, F.G, F.bx); S.skew = 2;
              pg8::EpiProjA E{(bf16*)(ws + WS_P), (bf16*)(ws + WS_QP), (bf16*)(ws + WS_KP), (const float*)(ws + TB_ROPEC), (const float*)(ws + TB_ROPES), attn_body::C2};
              REP(1) pg8::gemm_phase<pg8::EpiProjA, pg8::StdOrder, false, 0, 2>(ring, F.tid, DMODEL / 64, DMODEL * 2, DMODEL * 2, S, E); }
            { pg8::StdOrder S; S.init(ws + WS_X8, ws + W_G8, M, NGATE, DMODEL, F.G, F.bx); S.skew = 1;
              pg8::EpiGate E{(unsigned char*)F.out};
              REP(1) pg8::gemm_phase<pg8::EpiGate, pg8::StdOrder, false, 1, 2>(ring, F.tid, DMODEL / 128, DMODEL, DMODEL, S, E); }
            SEAM(pb + 0);
        }
        if (ON(2) && IN(pb + 1)) { FRAME();
            REP(2) for (int ch = F.vcu; ch < M / 128; ch += F.G) prep_unit(F, ch, l);
            if (MK_PER_PHASE) SEAM(pb + 1);
        }
        if (ON(3) && IN(pb + 2)) { FRAME();
            float lam;
            { const float* q1 = arg_in(5); const float* k1 = arg_in(6); const float* q2 = arg_in(7); const float* k2 = arg_in(8); const int li = l * 32 + (F.lane & 31);
              const float p1 = F.lane < 32 ? q1[li] * k1[li] : 0.f, p2 = F.lane < 32 ? q2[li] * k2[li] : 0.f;
              lam = expf(wave_sum(p1)) - expf(wave_sum(p2)) + lam_init; }
            const attn_body::bf16* Qp = (const attn_body::bf16*)(ws + WS_QP); const attn_body::bf16* Kp = (const attn_body::bf16*)(ws + WS_KP);
            const attn_body::bf16* Vb = (const attn_body::bf16*)(ws + WS_P) + PC_V; attn_body::bf16* YC = (attn_body::bf16*)(ws + WS_YA) + (size_t)2 * M * 256;
            const float* sg = arg_in(9) + l * 64;
            REP(3) for (int i = 0;; ++i) { const int p = (i >> 1) * F.G + F.vcu; if (p >= 256) break;
                const int bh = p >> 3, s = p & 7, qb = (i & 1) ? 15 - s : s;
                for (int mp = 0; mp < 2; ++mp) attn_body::attn_unit<8>(bh >> 2, bh & 3, mp, qb, Qp, Kp, Vb, YC, lam, 1.0f - lam_init, sg, (char*)(unsigned char*)ring, F.tid); }
            SEAM(pb + 2);
        }
        if (ON(4) && IN(pb + 3)) { FRAME();
            MergeOrder S{(const char*)(ws + WS_YA), (const char*)(ws + W_B), F.G, F.vcu};
            pg8::EpiMerge2 E{(const unsigned char*)F.out, (bf16*)(ws + WS_MG)};
            REP(4) pg8::gemm_phase<pg8::EpiMerge2, MergeOrder, true, 0, 1>(ring, F.tid, 16, 512, 512, S, E);
            SEAM(pb + 3);
        }
        if (ON(5) && IN(pb + 4)) { FRAME();
            pg8::StdOrder S; S.init(ws + WS_MG, ws + W_O, M, DMODEL, DMODEL * 2, F.G, F.bx);
            { pg8::EpiRes<true> E{(const void*)(ws + WS_XB), (bf16*)F.out};
                REP(5) pg8::gemm_phase<pg8::EpiRes<true>, pg8::StdOrder, true, 0, 2>(ring, F.tid, DMODEL / 64, DMODEL * 2, DMODEL * 2, S, E); }
            SEAM(pb + 4);
        }
        if (ON(6) && IN(pb + 5)) { FRAME(); route_phase(F, l); if (IN(pb + 5) && IN(pb + 7)) GRID_BAR(); }
        if (ON(8) && IN(pb + 7)) { FRAME();
            moe_tables(F, l);
            MoeUpOrder S{(const char*)(ws + WS_X18), (const char*)(ws + W_GU), (const int*)(ws + TB2_ROWTOK), (const LAS int*)(F.lds + LDSCTL_OFF), F.G, F.vcu};
            pg8::EpiAct E{(unsigned char*)(ws + WS_HB), (const pg8::f32x2*)(ws + TB2_ROWW)};
            REP(8) pg8::gemm_phase<pg8::EpiAct, MoeUpOrder, true, 1, 2, true>(ring, F.tid, DMODEL / 128, DMODEL, DMODEL, S, E);
            SEAM(pb + 7);
        }
        if (ON(9) && IN(pb + 8)) { FRAME();
            moe_tables(F, l);
            MoeDownOrder S{(const char*)(ws + WS_HB), (const char*)(ws + W_D), (const LAS int*)(F.lds + LDSCTL_OFF), F.G, F.vcu};
            pg8::EpiDown E{(const int*)(ws + TB2_ROWTOK), (bf16*)(ws + WS_XB)};
            pg8::gemm_phase<pg8::EpiDown, MoeDownOrder, true, 1, 2>(ring, F.tid, 4, 512, 256, S, E);
            if ((REPMASK >> 9) & 1) { pg8::EpiDown E2{(const int*)(ws + TB2_ROWTOK), (bf16*)(ws + WS_X + 96 * MiB)}; pg8::gemm_phase<pg8::EpiDown, MoeDownOrder, true, 1, 2>(ring, F.tid, 4, 512, 256, S, E2); }
            SEAM(pb + 8);
        }
        if (ON(10) && IN(pb + 9)) { FRAME();
            bf16* XB = (bf16*)(ws + WS_XB);
            const float* g2 = arg_in(25) + l * DMODEL; const float* b2 = arg_in(26) + l * DMODEL;
            for (int m = 4 * (F.vcu * NWAVES + F.wave); m < M; m += 4 * F.G * NWAVES)
                ln_rows<4>(XB + (size_t)m * DMODEL, g2, b2, (l == DEPTH - 1) ? F.out + (size_t)m * DMODEL : nullptr, XB + (size_t)m * DMODEL, ws + WS_X8 + (size_t)m * DMODEL, (size_t)DMODEL, F.lane);
            if (l + 1 < DEPTH) { REP(11) convert_weights(F, l + 1); SEAM(pb + 9); }
        }
}
__global__ void __launch_bounds__(NWAVES * 64, 2) fwd(Args args) {
    extern __shared__ __attribute__((aligned(16))) unsigned char lds[];
    LAS unsigned char* const ldsb = (LAS unsigned char*)lds;
    const int G0 = gridDim.x; int vcu0; { const int bx = blockIdx.x; vcu0 = (G0 % 8 == 0) ? (bx % 8) * (G0 / 8) + bx / 8 : bx; }
    unsigned char* const ws0 = args.ws; float* const out0 = args.out; const int wave0 = __builtin_amdgcn_readfirstlane((int)threadIdx.x >> 6);
    for (int u = threadIdx.x; u < (LDS_BYTES - LDSCTL_OFF) / 4; u += NWAVES * 64) ((LAS unsigned*)(ldsb + LDSCTL_OFF))[u] = 0u;
    __syncthreads();
    volatile LAS unsigned* MISC = (volatile LAS unsigned*)(ldsb + MISC_OFF);
    if (threadIdx.x == 0) { const unsigned long long w = (unsigned long long)(uintptr_t)ws0, o = (unsigned long long)(uintptr_t)out0;
        MISC[10] = (unsigned)w; MISC[11] = (unsigned)(w >> 32); MISC[12] = (unsigned)o; MISC[13] = (unsigned)(o >> 32); MISC[14] = (unsigned)G0; MISC[15] = (unsigned)vcu0; MISC[16] = blockIdx.x; }
    __syncthreads();
#if !MK_PER_PHASE
    (void)xcd_barrier_post((unsigned*)ws0, (unsigned)(WS_CTL / 4 + CW_BAR), MISC + 8, wave0);
#endif
    const int lo = args.ph_lo, hi = args.ph_hi;
    if (ON(0) && IN(0)) { FRAME(); REP(0) p0_prologue(F); SEAM(0); }
    layer_phases<0>(lo, hi, wave0, ldsb);
    layer_phases<1>(lo, hi, wave0, ldsb);
    static_assert(DEPTH == 2, "two layer instances");
}
#undef IN
#undef SEAM
#undef GRID_BAR
#undef FRAME


extern "C" void kernel_launch(void* const* d_in, const int* in_sizes, int n_in, void* d_out, int out_size, void* d_ws, size_t ws_size, hipStream_t stream) {
    static int grid = 0;
    if (grid == 0) {
        if (n_in != 27 || in_sizes[0] != M * DMODEL || out_size != M * DMODEL || ws_size < WS_END) { fprintf(stderr, "kernel_launch: built for 27 inputs, x/out of %d floats, >= %zu bytes of workspace; got n_in %d, in0 %d, out %d, ws %zu; nothing launched\n", M * DMODEL, (size_t)WS_END, n_in, n_in > 0 ? in_sizes[0] : -1, out_size, ws_size); grid = -1; return; }
        int dev = 0, cus = 0, per_cu = 0;
        if (hipGetDevice(&dev) != hipSuccess || hipDeviceGetAttribute(&cus, hipDeviceAttributeMultiprocessorCount, dev) != hipSuccess) { fprintf(stderr, "kernel_launch: device query failed\n"); grid = -1; return; }
        if (hipFuncSetAttribute((const void*)fwd, hipFuncAttributeMaxDynamicSharedMemorySize, LDS_BYTES) != hipSuccess) { fprintf(stderr, "kernel_launch: hipFuncSetAttribute failed\n"); grid = -1; return; }
        if (hipOccupancyMaxActiveBlocksPerMultiprocessor(&per_cu, (const void*)fwd, NWAVES * 64, LDS_BYTES) != hipSuccess || per_cu < 1) { fprintf(stderr, "kernel_launch: occupancy query reports %d workgroups per CU\n", per_cu); }
        (void)hipGetLastError();
        grid = cus;
    }
    if (grid < 0) return;
    if (hipMemsetAsync((char*)d_ws + WS_CTL, 0, CTL_ZERO_BYTES, stream) != hipSuccess) { fprintf(stderr, "kernel_launch: memset failed\n"); return; }
    Args a{};
    for (int i = 0; i < 27; ++i) a.in[i] = (const float*)d_in[i];
    a.out = (float*)d_out; a.ws = (unsigned char*)d_ws;
#if MK_PER_PHASE
    for (int p = 0; p < NPHASE; ++p) { a.ph_lo = p; a.ph_hi = p + 1; hipLaunchKernelGGL(fwd, dim3(grid), dim3(NWAVES * 64), LDS_BYTES, stream, a); }
#else
    a.ph_lo = 0; a.ph_hi = NPHASE; hipLaunchKernelGGL(fwd, dim3(grid), dim3(NWAVES * 64), LDS_BYTES, stream, a);
#endif
    const hipError_t le = hipPeekAtLastError();
    if (le != hipSuccess) fprintf(stderr, "kernel_launch: launch failed: %s\n", hipGetErrorName(le));
}
```

```cpp
#include <hip/hip_runtime.h>
#include <hip/hip_bf16.h>
#include <cstdio>
#include <cstdint>
#include <cmath>

#ifndef MK_PER_PHASE
#define MK_PER_PHASE 0
#endif

constexpr int BATCH = 8, SEQ = 4096, DMODEL = 1024, M = BATCH * SEQ, DEPTH = 2;
constexpr int NPB = 2304;
constexpr int NGATE = 4096, NIN = NPB + NGATE;
constexpr int PC_POOL = 0, PC_GB = 256, PC_GC = 512, PC_H = 768, PC_Q = 1024, PC_K = 1280, PC_V = 1536, PC_U = 1792, PC_VV = 2048;
constexpr float LN_EPS = 1e-5f;
constexpr float ALPHA = 1.41421356237309515f;
constexpr int NCLS = 24;
constexpr int MAXROWS = 40960;

namespace pg8 {
#define PG8_LAS __attribute__((address_space(3)))
typedef unsigned short bf16_t;
typedef short bf16x8 __attribute__((ext_vector_type(8)));
typedef float f32x4 __attribute__((ext_vector_type(4)));
typedef unsigned u32x4 __attribute__((ext_vector_type(4)));
constexpr int BM = 256, BK = 64, HALF = 128, HTB = HALF * BK * 2  , STAGE_BYTES = 8 * HTB, NXCD = 8, WGM = 8;

__host__ __device__ __forceinline__ int lds_byte(int r, int c) { const int st = (r >> 4) * 2 + (c >> 5), rr = r & 15, cc = c & 31, ob = rr * 64 + cc * 2; return st * 1024 + (ob ^ (((ob >> 9) & 1) << 5)); }
__host__ __device__ __forceinline__ void stage_rc(int b, int& R, int& C) { const int st = b / 1024, sb = b % 1024, swz = sb ^ (((sb >> 9) & 1) << 5); R = (st >> 1) * 16 + swz / 64; C = (st & 1) * 32 + (swz % 64) / 2; }
__host__ __device__ __forceinline__ int perm32(int rho) { const int n = rho >> 4, i = rho & 15; return 8 * (i >> 2) + 4 * n + (i & 3); }

struct Unit { int pm, pn, x, y, z, v; };

struct StdOrder {
    const char* A; const char* B; size_t tsA, tsB;
    int nM, nN, nwg, G, c, skew;
    __device__ __forceinline__ void init(const void* A_, const void* B_, int M_, int N_, int rowbytes, int G_, int c_) {
        A = (const char*)A_; B = (const char*)B_; tsA = (size_t)BM * rowbytes; tsB = tsA; nM = M_ / BM; nN = N_ / BM; nwg = nM * nN; G = G_; c = c_; skew = 0; }
    __device__ __forceinline__ bool next(int i, Unit& u) const {
        long L = (long)i * G + c;
        if (skew && G == 256 && nwg == 2048) { if (i >= 7) { if (c < 128 || i > 8) return false; L = 1792 + (i - 7) * 128 + (c - 128); } }
        if (L >= nwg) return false;
        int wgid = (int)L; { const int q = nwg / NXCD, r = nwg % NXCD, xcd = wgid % NXCD, off = wgid / NXCD; wgid = (xcd < r ? xcd * (q + 1) : r * (q + 1) + (xcd - r) * q) + off; }
        if (skew == 2 && nM % NXCD == 0 && nwg % NXCD == 0) { const int xcd = (int)(L % NXCD), off = (int)(L / NXCD); u.pm = xcd * (nM / NXCD) + off / nN; u.pn = off % nN; u.x = 0; u.y = 0; u.z = 0; u.v = 0; return true; }
        const int nig = WGM * nN, gid = wgid / nig, fm = gid * WGM, gsz = (nM - fm) < WGM ? (nM - fm) : WGM;
        u.pm = fm + ((wgid % nig) % gsz); u.pn = (wgid % nig) / gsz; u.x = 0; u.y = 0; u.z = 0; u.v = 0; return true;
    }
    __device__ __forceinline__ const char* aptr(const Unit& u, int t) const { return A + (size_t)u.pm * tsA + (size_t)t * (BK * 2); }
    __device__ __forceinline__ const char* bptr(const Unit& u, int t) const { return B + (size_t)u.pn * tsB + (size_t)t * (BK * 2); }
};

__device__ __forceinline__ unsigned cvt_pk_bf16(float lo, float hi) { unsigned r; asm volatile("v_cvt_pk_bf16_f32 %0, %1, %2" : "=v"(r) : "v"(lo), "v"(hi)); return r; }
typedef float f32x2 __attribute__((ext_vector_type(2)));
typedef unsigned u32x2 __attribute__((ext_vector_type(2)));
__device__ __forceinline__ float bf_lo(unsigned w) { return __uint_as_float(w << 16); }
__device__ __forceinline__ float bf_hi(unsigned w) { return __uint_as_float(w & 0xffff0000u); }
__device__ __forceinline__ float sigmoidf_(float x) { return __builtin_amdgcn_rcpf(1.0f + __builtin_amdgcn_exp2f(x * -1.4426950408889634f)); }
__device__ __forceinline__ float gelu_tanh(float x) { const float u = x * (1.0f + 0.044715f * x * x); return x * __builtin_amdgcn_rcpf(1.0f + __builtin_amdgcn_exp2f(u * -2.3022082f)); }
__device__ __forceinline__ float ubf(unsigned w, int n) { return (float)((w >> (8 * n)) & 0xffu); }
__device__ __forceinline__ unsigned sig_u8(float x) { return (unsigned)(sigmoidf_(x) * 255.0f + 0.5f); }

struct NoState {};
#ifndef EPI_WT
#define EPI_WT 0
#endif
__device__ __forceinline__ void st16(void* p, u32x4 v) {
#if EPI_WT
    asm volatile("global_store_dwordx4 %0, %1, off sc1" :: "v"((__attribute__((address_space(1))) void*)p), "v"(v) : "memory");
#else
    *(u32x4*)p = v;
#endif
}
__device__ __forceinline__ void st8(void* p, u32x2 v) {
#if EPI_WT
    asm volatile("global_store_dwordx2 %0, %1, off sc1" :: "v"((__attribute__((address_space(1))) void*)p), "v"(v) : "memory");
#else
    *(u32x2*)p = v;
#endif
}
struct EpiProjA {
    static constexpr bool PERM = true, AFTER_DRAIN = false; static constexpr int GROUP = 0; typedef NoState State;
    bf16_t* P; bf16_t* Qp; bf16_t* Kp; const float* rc; const float* rs; float qscale;
    __device__ __forceinline__ void operator()(const f32x4 (&acc)[2][2][4][2], const Unit& u, int wr, int wc, int fr, int fq) const {
        asm volatile("" : "+v"(fr), "+v"(fq));
        const int row0 = u.pm * BM + wr * 64 + fr, col0 = wc * 32 + 8 * fq;
        if (u.pn == 4 || u.pn == 5) {
            bf16_t* dstb = (u.pn == 4 ? Qp : Kp) + wc * 64 + 8 * fq; const float sc = u.pn == 4 ? qscale : 1.0f; const bool up = fq >= 2; const int j0 = 8 * (fq & 1);
#pragma unroll
            for (int ai = 0; ai < 2; ++ai)
#pragma unroll
                for (int m = 0; m < 4; ++m) { const int row = row0 + ai * HALF + m * 16, pos = row & 4095;
                    const f32x4 c0 = *(const f32x4*)(rc + pos * 16 + j0), c1 = *(const f32x4*)(rc + pos * 16 + j0 + 4), s0 = *(const f32x4*)(rs + pos * 16 + j0), s1 = *(const f32x4*)(rs + pos * 16 + j0 + 4);
#pragma unroll
                    for (int bj = 0; bj < 2; ++bj) { const f32x4 v0 = acc[ai][bj][m][0], v1 = acc[ai][bj][m][1]; f32x4 p0, p1;
#pragma unroll
                        for (int e = 0; e < 4; ++e) { p0[e] = __shfl_xor(v0[e], 32); p1[e] = __shfl_xor(v1[e], 32); }
                        const f32x4 o0 = (v0 * c0 + (up ? p0 : -p0) * s0) * sc, o1 = (v1 * c1 + (up ? p1 : -p1) * s1) * sc;
                        u32x4 w; w.x = cvt_pk_bf16(o0[0], o0[1]); w.y = cvt_pk_bf16(o0[2], o0[3]); w.z = cvt_pk_bf16(o1[0], o1[1]); w.w = cvt_pk_bf16(o1[2], o1[3]);
                        bf16_t* d = dstb + (size_t)row * 512 + bj * 256;
                        st16(d, w); st16(d + 32, (u32x4){0u, 0u, 0u, 0u}); } }
            return;
        }
        const bool act = u.pn >= 7; bf16_t* base = P + u.pn * BM + col0;
#pragma unroll
        for (int ai = 0; ai < 2; ++ai)
#pragma unroll
            for (int m = 0; m < 4; ++m) { bf16_t* rowp = base + (size_t)(row0 + ai * HALF + m * 16) * NPB;
#pragma unroll
                for (int bj = 0; bj < 2; ++bj) { f32x4 v0 = acc[ai][bj][m][0], v1 = acc[ai][bj][m][1];
                    if (act) { v0 = (f32x4){gelu_tanh(v0[0]), gelu_tanh(v0[1]), gelu_tanh(v0[2]), gelu_tanh(v0[3])}; v1 = (f32x4){gelu_tanh(v1[0]), gelu_tanh(v1[1]), gelu_tanh(v1[2]), gelu_tanh(v1[3])}; }
                    u32x4 w; w.x = cvt_pk_bf16(v0[0], v0[1]); w.y = cvt_pk_bf16(v0[2], v0[3]); w.z = cvt_pk_bf16(v1[0], v1[1]); w.w = cvt_pk_bf16(v1[2], v1[3]);
                    st16(rowp + bj * HALF, w); } }
    }
};
constexpr float FP8_XS = 16.0f, FP8_WS = 512.0f, FP8_SCALE = FP8_XS * FP8_WS;
__device__ __forceinline__ float fp8_clamp(float x) { return __builtin_fminf(__builtin_fmaxf(x, -448.0f), 448.0f); }
__device__ __forceinline__ unsigned fp8_pk4(float a, float b, float c, float d) { int q = 0; q = __builtin_amdgcn_cvt_pk_fp8_f32(fp8_clamp(a), fp8_clamp(b), q, false); q = __builtin_amdgcn_cvt_pk_fp8_f32(fp8_clamp(c), fp8_clamp(d), q, true); return (unsigned)q; }
__device__ __forceinline__ unsigned sig_u8s(float x) { return (unsigned)(__builtin_amdgcn_rcpf(1.0f + __builtin_amdgcn_exp2f(x * (-1.4426950408889634f / FP8_SCALE))) * 255.0f + 0.5f); }
struct EpiGate {
    static constexpr bool PERM = true, AFTER_DRAIN = false; static constexpr int GROUP = 0; typedef NoState State;
    unsigned char* G8;
    __device__ __forceinline__ void operator()(const f32x4 (&acc)[2][2][4][2], const Unit& u, int wr, int wc, int fr, int fq) const {
        asm volatile("" : "+v"(fr), "+v"(fq));
        const int row0 = u.pm * BM + wr * 64 + fr, col0 = wc * 32 + 8 * fq;
#pragma unroll
        for (int ai = 0; ai < 2; ++ai)
#pragma unroll
            for (int m = 0; m < 4; ++m) { unsigned char* rowp = G8 + (unsigned)((row0 + ai * HALF + m * 16) * NGATE + u.pn * BM + col0);
#pragma unroll
                for (int bj = 0; bj < 2; ++bj) { const f32x4 v0 = acc[ai][bj][m][0], v1 = acc[ai][bj][m][1];
                    u32x2 w; w.x = sig_u8s(v0[0]) | (sig_u8s(v0[1]) << 8) | (sig_u8s(v0[2]) << 16) | (sig_u8s(v0[3]) << 24);
                    w.y = sig_u8s(v1[0]) | (sig_u8s(v1[1]) << 8) | (sig_u8s(v1[2]) << 16) | (sig_u8s(v1[3]) << 24);
                    *(u32x2*)(rowp + bj * HALF) = w; } }
    }
};
struct EpiMerge2 {
    static constexpr bool PERM = true, AFTER_DRAIN = false; static constexpr int GROUP = 4;
    struct State { f32x4 mg[2][4][2]; u32x2 gq[2][4]; };
    const unsigned char* G8; bf16_t* MG;
    __device__ __forceinline__ void load_gates(State& st, const Unit& u, int g, int wr, int wc, int fr, int fq) const {
        asm volatile("" : "+v"(fr), "+v"(fq));
        const unsigned char* base = G8 + (size_t)(u.pm * BM + wr * 64 + fr) * NGATE + g * DMODEL + u.pn * HALF + wc * 32 + 8 * fq;
#pragma unroll
        for (int ai = 0; ai < 2; ++ai)
#pragma unroll
            for (int m = 0; m < 4; ++m) { const unsigned char* p = base + (size_t)(ai * HALF + m * 16) * NGATE;
                asm volatile("global_load_dwordx2 %0, %1, off" : "+v"(st.gq[ai][m]) : "v"(p) : "memory"); }
    }
    __device__ __forceinline__ void begin(State& st, const Unit& u, int wr, int wc, int fr, int fq) const {
#pragma unroll
        for (int ai = 0; ai < 2; ++ai)
#pragma unroll
            for (int m = 0; m < 4; ++m) { st.mg[ai][m][0] = (f32x4){0.f, 0.f, 0.f, 0.f}; st.mg[ai][m][1] = (f32x4){0.f, 0.f, 0.f, 0.f}; }
        load_gates(st, u, 0, wr, wc, fr, fq);
    }
    __device__ __forceinline__ void group(State& st, f32x4 (&acc)[2][1][4][2], const Unit& u, int g, int ng, int wr, int wc, int fr, int fq) const {
        asm volatile("s_waitcnt vmcnt(6)" ::: "memory");
#pragma unroll
        for (int ai = 0; ai < 2; ++ai)
#pragma unroll
            for (int m = 0; m < 4; ++m) { const u32x2 q = st.gq[ai][m];
                st.mg[ai][m][0] += (f32x4){ubf(q.x, 0), ubf(q.x, 1), ubf(q.x, 2), ubf(q.x, 3)} * acc[ai][0][m][0];
                st.mg[ai][m][1] += (f32x4){ubf(q.y, 0), ubf(q.y, 1), ubf(q.y, 2), ubf(q.y, 3)} * acc[ai][0][m][1];
                acc[ai][0][m][0] = (f32x4){0.f, 0.f, 0.f, 0.f}; acc[ai][0][m][1] = (f32x4){0.f, 0.f, 0.f, 0.f}; }
        asm volatile("" : "+v"(st.mg[0][0][0]), "+v"(st.mg[0][0][1]), "+v"(st.mg[0][1][0]), "+v"(st.mg[0][1][1]), "+v"(st.mg[0][2][0]), "+v"(st.mg[0][2][1]), "+v"(st.mg[0][3][0]), "+v"(st.mg[0][3][1]),
                          "+v"(st.mg[1][0][0]), "+v"(st.mg[1][0][1]), "+v"(st.mg[1][1][0]), "+v"(st.mg[1][1][1]), "+v"(st.mg[1][2][0]), "+v"(st.mg[1][2][1]), "+v"(st.mg[1][3][0]), "+v"(st.mg[1][3][1]));
        if (g + 1 < ng) load_gates(st, u, g + 1, wr, wc, fr, fq);
    }
    __device__ __forceinline__ void store(State& st, const Unit& u, int wr, int wc, int fr, int fq) const {
        asm volatile("" : "+v"(fr), "+v"(fq));
        bf16_t* base = MG + (size_t)(u.pm * BM + wr * 64 + fr) * DMODEL + u.pn * HALF + wc * 32 + 8 * fq; const float s = 1.0f / 255.0f;
#pragma unroll
        for (int ai = 0; ai < 2; ++ai)
#pragma unroll
            for (int m = 0; m < 4; ++m) { const f32x4 a = st.mg[ai][m][0] * s, b = st.mg[ai][m][1] * s;
                u32x4 w; w.x = cvt_pk_bf16(a[0], a[1]); w.y = cvt_pk_bf16(a[2], a[3]); w.z = cvt_pk_bf16(b[0], b[1]); w.w = cvt_pk_bf16(b[2], b[3]);
                st16(base + (size_t)(ai * HALF + m * 16) * DMODEL, w); }
    }
};
template <bool RES_BF16> struct EpiRes {
    static constexpr bool PERM = true, AFTER_DRAIN = false; static constexpr int GROUP = 0; typedef NoState State;
    const void* res; bf16_t* out;
    __device__ __forceinline__ void operator()(const f32x4 (&acc)[2][2][4][2], const Unit& u, int wr, int wc, int fr, int fq) const {
        asm volatile("" : "+v"(fr), "+v"(fq));
        const int row0 = u.pm * BM + wr * 64 + fr, col0 = u.pn * BM + wc * 32 + 8 * fq;
#pragma unroll
        for (int ai = 0; ai < 2; ++ai)
#pragma unroll
            for (int m = 0; m < 4; ++m) { const size_t off = (size_t)(row0 + ai * HALF + m * 16) * DMODEL + col0;
#pragma unroll
                for (int bj = 0; bj < 2; ++bj) { f32x4 r0, r1;
                    if constexpr (RES_BF16) { const u32x4 p = *(const u32x4*)((const bf16_t*)res + off + bj * HALF); r0 = (f32x4){bf_lo(p.x), bf_hi(p.x), bf_lo(p.y), bf_hi(p.y)}; r1 = (f32x4){bf_lo(p.z), bf_hi(p.z), bf_lo(p.w), bf_hi(p.w)}; }
                    else { r0 = *(const f32x4*)((const float*)res + off + bj * HALF); r1 = *(const f32x4*)((const float*)res + off + bj * HALF + 4); }
                    const f32x4 a = r0 * ALPHA + acc[ai][bj][m][0], b = r1 * ALPHA + acc[ai][bj][m][1];
                    u32x4 w; w.x = cvt_pk_bf16(a[0], a[1]); w.y = cvt_pk_bf16(a[2], a[3]); w.z = cvt_pk_bf16(b[0], b[1]); w.w = cvt_pk_bf16(b[2], b[3]);
                    st16(out + off + bj * HALF, w); } }
    }
};
struct EpiAct {
    static constexpr bool PERM = true, AFTER_DRAIN = false; static constexpr int GROUP = 0; typedef NoState State;
    unsigned char* H; const f32x2* roww;
    __device__ __forceinline__ void operator()(const f32x4 (&acc)[2][2][4][2], const Unit& u, int wr, int wc, int fr, int fq) const {
        asm volatile("" : "+v"(fr), "+v"(fq));
        const int row0 = u.pm * BM + wr * 64 + fr, col0 = u.x + wc * 32 + 8 * fq; const float ds = 1.0f / FP8_SCALE;
#pragma unroll
        for (int ai = 0; ai < 2; ++ai)
#pragma unroll
            for (int m = 0; m < 4; ++m) { const size_t row = (size_t)(row0 + ai * HALF + m * 16); const int r_ = wr * 64 + fr + ai * HALF + m * 16; const f32x2 rw = roww[u.z + (r_ < u.v ? r_ : 0)]; const float w = (u.y ? rw.y : rw.x) * FP8_XS;
                float o[8];
#pragma unroll
                for (int n = 0; n < 2; ++n)
#pragma unroll
                    for (int e = 0; e < 4; ++e) { const float g = acc[ai][0][m][n][e] * ds, up = acc[ai][1][m][n][e] * ds; o[n * 4 + e] = g * sigmoidf_(g) * up * w; }
                u32x2 q; q.x = fp8_pk4(o[0], o[1], o[2], o[3]); q.y = fp8_pk4(o[4], o[5], o[6], o[7]);
                st8(H + row * 512 + col0, q); }
    }
};
struct EpiDown {
    static constexpr bool PERM = true, AFTER_DRAIN = false; static constexpr int GROUP = 0; typedef NoState State;
    const int* rowtok; bf16_t* hx;
    __device__ __forceinline__ void operator()(const f32x4 (&acc)[2][2][4][2], const Unit& u, int wr, int wc, int fr, int fq) const {
        asm volatile("" : "+v"(fr), "+v"(fq));
        const int row0 = u.pm * BM + wr * 64 + fr, col0 = u.pn * BM + wc * 32 + 8 * fq;
#pragma unroll
        for (int ai = 0; ai < 2; ++ai)
#pragma unroll
            for (int m = 0; m < 4; ++m) { const int r_ = wr * 64 + fr + ai * HALF + m * 16;
                if (r_ < u.v) { const int tok = rowtok[u.z + r_]; bf16_t* p = (bf16_t*)((char*)hx + (unsigned)(tok * (DMODEL * 2) + col0 * 2));
#pragma unroll
                    for (int bj = 0; bj < 2; ++bj) { const u32x4 q = *(const u32x4*)(p + bj * HALF);
                        const f32x4 a = (f32x4){bf_lo(q.x), bf_hi(q.x), bf_lo(q.y), bf_hi(q.y)} * ALPHA + acc[ai][bj][m][0] * (1.0f / FP8_SCALE), b = (f32x4){bf_lo(q.z), bf_hi(q.z), bf_lo(q.w), bf_hi(q.w)} * ALPHA + acc[ai][bj][m][1] * (1.0f / FP8_SCALE);
                        u32x4 w; w.x = cvt_pk_bf16(a[0], a[1]); w.y = cvt_pk_bf16(a[2], a[3]); w.z = cvt_pk_bf16(b[0], b[1]); w.w = cvt_pk_bf16(b[2], b[3]);
                        *(u32x4*)(p + bj * HALF) = w; } }
                asm volatile("" ::: "memory"); }
    }
};

typedef int i32x8 __attribute__((ext_vector_type(8)));
__device__ __forceinline__ int lane_id_now() { int l; asm volatile("v_mbcnt_lo_u32_b32 %0, -1, 0\n\tv_mbcnt_hi_u32_b32 %0, -1, %0" : "=v"(l)); return l; }
template <class Epi, class Sched, bool ALIGN_EPI = false, int MODE = 0, int NB = 2, bool GATHER = false>
__device__ __forceinline__ void gemm_phase(PG8_LAS unsigned char* lds, int tid, const int nt, const int ldaB, const int ldbB, const Sched& S, const Epi& E) {
    asm volatile("" : "+v"(tid));
    const int wid = __builtin_amdgcn_readfirstlane(tid >> 6), lane = tid & 63, wr = wid >> 2, wc = wid & 3, fr = lane & 15, fq = lane >> 4;
    unsigned voffA[2], voffB[2];
#pragma unroll
    for (int i = 0; i < 2; ++i) { int R, C; stage_rc(tid * 16 + i * 8192, R, C); const int Rb = Epi::PERM ? ((R & ~31) + perm32(R & 31)) : R;
        voffA[i] = (unsigned)(R * ldaB + C * 2); voffB[i] = (unsigned)(Rb * ldbB + C * 2); }
    const size_t hsA = (size_t)HALF * ldaB, hsB = (size_t)HALF * ldbB;
    const unsigned ldsw = (unsigned)wid * 1024u;
    const int aoff = lds_byte(wr * 64 + fr, fq * 8), boff = lds_byte(wc * 32 + fr, fq * 8);
#define PG8_SA(b, h) (((b) * 2 + (h)) * HTB)
#define PG8_SB(b, h) ((4 + (b) * 2 + (h)) * HTB)
#define PG8_STAGE(bufoff, gbase, voff) do { const __attribute__((address_space(1))) char* gb_ = (const __attribute__((address_space(1))) char*)(gbase); asm volatile("" : "+s"(gb_));   \
        _Pragma("unroll") for (int _i = 0; _i < 2; ++_i) \
        __builtin_amdgcn_global_load_lds((const __attribute__((address_space(1))) unsigned*)(gb_ + (voff)[_i]), (PG8_LAS unsigned*)(lds + (bufoff) + ldsw + _i * 8192), 16, 0, 0); } while (0)
#define PG8_STAGE_B1(bufoff, gbase) do { if constexpr (NB == 2) PG8_STAGE(bufoff, gbase, voffB); } while (0)
#define PG8_STAGE_A(bufoff, h, gbase, nx) do { if constexpr (GATHER) PG8_STAGE(bufoff, gbase, voffG[h]); else PG8_STAGE(bufoff, (gbase) + (h) * hsA, voffA); } while (0)
#define PG8_LDA(dst, b, h) do { _Pragma("unroll") for (int m = 0; m < 4; ++m) _Pragma("unroll") for (int k = 0; k < 2; ++k) dst[m][k] = *(const PG8_LAS bf16x8*)(lds + PG8_SA(b, h) + aoff + m * 2048 + k * 1024); } while (0)
#define PG8_LDB(dst, b, h) do { _Pragma("unroll") for (int n = 0; n < 2; ++n) _Pragma("unroll") for (int k = 0; k < 2; ++k) dst[n][k] = *(const PG8_LAS bf16x8*)(lds + PG8_SB(b, h) + boff + n * 2048 + k * 1024); } while (0)
#define PG8_CAT(x) __builtin_bit_cast(i32x8, __builtin_shufflevector((x)[0], (x)[1], 0, 1, 2, 3, 4, 5, 6, 7, 8, 9, 10, 11, 12, 13, 14, 15))
#define PG8_MMA(ai, bj, At, Bt) do { __builtin_amdgcn_s_setprio(1); _Pragma("unroll") for (int m = 0; m < 4; ++m) _Pragma("unroll") for (int n = 0; n < 2; ++n) { \
        if constexpr (MODE == 0) { _Pragma("unroll") for (int k = 0; k < 2; ++k) acc[ai][bj][m][n] = __builtin_amdgcn_mfma_f32_16x16x32_bf16(Bt[n][k], At[m][k], acc[ai][bj][m][n], 0, 0, 0); } \
        else acc[ai][bj][m][n] = __builtin_amdgcn_mfma_scale_f32_16x16x128_f8f6f4(PG8_CAT(Bt[n]), PG8_CAT(At[m]), acc[ai][bj][m][n], 0, 0, 0, 0, 0, 0); } \
        __builtin_amdgcn_s_setprio(0); } while (0)
#define PG8_WAIT_V(n) asm volatile("s_waitcnt vmcnt(" #n ")" ::: "memory")
#define PG8_WAIT_VS() do { if constexpr (NB == 2) PG8_WAIT_V(8); else PG8_WAIT_V(6); } while (0)
#define PG8_WAIT_L(n) asm volatile("s_waitcnt lgkmcnt(" #n ")" ::: "memory")
#define PG8_BAR __builtin_amdgcn_s_barrier()
#define PG8_SCHED __builtin_amdgcn_sched_barrier(0)
    Unit cur, nxt; int ui = 0;
    if (!S.next(0, cur)) return;
    f32x4 acc[2][NB][4][2];
#pragma unroll
    for (int a = 0; a < 2; ++a)
#pragma unroll
        for (int b = 0; b < NB; ++b)
#pragma unroll
            for (int m = 0; m < 4; ++m)
#pragma unroll
                for (int n = 0; n < 2; ++n) acc[a][b][m][n] = (f32x4){0.f, 0.f, 0.f, 0.f};
    typename Epi::State st = {};
    unsigned voffG[2][2]; int tokN[2][2];
    if constexpr (GATHER) { const int* rt = S.rowtab() + cur.z;
#pragma unroll
        for (int h = 0; h < 2; ++h)
#pragma unroll
            for (int i = 0; i < 2; ++i) { int R, C; stage_rc(tid * 16 + i * 8192, R, C); const int tk = (R + h * HALF < cur.v) ? rt[R + h * HALF] : 0; voffG[h][i] = (unsigned)(tk * ldaB + C * 2); tokN[h][i] = 0; } }
    if constexpr (Epi::GROUP > 0) E.begin(st, cur, wr, wc, fr, fq);
    bf16x8 At[4][2], B0[2][2], B1[2][2];
    {   const char* cA0 = S.aptr(cur, 0); const char* cA1 = S.aptr(cur, 1); const char* cB0 = S.bptr(cur, 0); const char* cB1 = S.bptr(cur, 1);
        PG8_STAGE(PG8_SB(0, 0), cB0, voffB); PG8_STAGE_B1(PG8_SB(0, 1), cB0 + hsB); PG8_STAGE_A(PG8_SA(0, 0), 0, cA0, false); PG8_STAGE_A(PG8_SA(0, 1), 1, cA0, false);
        if (wr == 1) PG8_BAR;
        PG8_WAIT_V(2); PG8_BAR;
        PG8_STAGE(PG8_SB(1, 0), cB1, voffB); PG8_STAGE_A(PG8_SA(1, 0), 0, cA1, false); PG8_STAGE_B1(PG8_SB(1, 1), cB1 + hsB);
        if constexpr (NB == 2) PG8_WAIT_V(6); else PG8_WAIT_V(4);
        PG8_BAR;
    }
    for (;;) {
        const bool has_next = S.next(ui + 1, nxt);
        const Unit nu = has_next ? nxt : cur;
        if constexpr (GATHER) { const int* rt = S.rowtab() + nu.z;
#pragma unroll
            for (int h = 0; h < 2; ++h)
#pragma unroll
                for (int i = 0; i < 2; ++i) { int R, C; stage_rc(tid * 16 + i * 8192, R, C); const int* p = rt + R + h * HALF;
                    asm volatile("global_load_dword %0, %1, off" : "+v"(tokN[h][i]) : "v"(p) : "memory"); } }
        const char* nA0 = S.aptr(nu, 0); const char* nA1 = S.aptr(nu, 1); const char* nB0 = S.bptr(nu, 0); const char* nB1 = S.bptr(nu, 1);
#pragma nounroll
        for (int t = 0; t < nt; t += 2) {
            const bool last = (t == nt - 2);
            const char* a1 = S.aptr(cur, t + 1);
            const char* a2 = last ? nA0 : S.aptr(cur, t + 2); const char* a3 = last ? nA1 : S.aptr(cur, t + 3);
            const char* b2 = last ? nB0 : S.bptr(cur, t + 2); const char* b3 = last ? nB1 : S.bptr(cur, t + 3);
            PG8_LDB(B0, 0, 0); if constexpr (NB == 2) PG8_LDB(B1, 0, 1); PG8_SCHED; PG8_LDA(At, 0, 0); PG8_STAGE_A(PG8_SA(1, 1), 1, a1, false);
            if constexpr (GATHER) { if (last) { asm volatile("" : "+v"(tokN[0][0]), "+v"(tokN[0][1]), "+v"(tokN[1][0]), "+v"(tokN[1][1]));
#pragma unroll
                for (int h = 0; h < 2; ++h)
#pragma unroll
                    for (int i = 0; i < 2; ++i) { int R, C; stage_rc(tid * 16 + i * 8192, R, C); const int tk = (R + h * HALF < nu.v) ? tokN[h][i] : 0; voffG[h][i] = (unsigned)(tk * ldaB + C * 2); } } }
            PG8_WAIT_VS(); PG8_WAIT_L(0); PG8_BAR; PG8_MMA(0, 0, At, B0); if constexpr (NB == 2) PG8_MMA(0, NB - 1, At, B1); PG8_BAR; PG8_SCHED;
            PG8_LDA(At, 0, 1); PG8_STAGE(PG8_SB(0, 0), b2, voffB); PG8_STAGE_B1(PG8_SB(0, 1), b2 + hsB); PG8_STAGE_A(PG8_SA(0, 0), 0, a2, last);
            PG8_WAIT_VS(); PG8_WAIT_L(0); PG8_BAR; PG8_MMA(1, 0, At, B0); if constexpr (NB == 2) PG8_MMA(1, NB - 1, At, B1); PG8_BAR; PG8_SCHED;
            PG8_LDB(B0, 1, 0); if constexpr (NB == 2) PG8_LDB(B1, 1, 1); PG8_SCHED; PG8_LDA(At, 1, 0); PG8_STAGE_A(PG8_SA(0, 1), 1, a2, last);
            PG8_WAIT_VS(); PG8_WAIT_L(0); PG8_BAR; PG8_MMA(0, 0, At, B0); if constexpr (NB == 2) PG8_MMA(0, NB - 1, At, B1); PG8_BAR; PG8_SCHED;
            PG8_LDA(At, 1, 1); PG8_STAGE(PG8_SB(1, 0), b3, voffB); PG8_STAGE_B1(PG8_SB(1, 1), b3 + hsB); PG8_STAGE_A(PG8_SA(1, 0), 0, a3, last);
            PG8_WAIT_VS(); PG8_WAIT_L(0); PG8_BAR; PG8_MMA(1, 0, At, B0); if constexpr (NB == 2) PG8_MMA(1, NB - 1, At, B1); PG8_BAR; PG8_SCHED;
            if constexpr (Epi::GROUP > 0) { if (((t + 2) % Epi::GROUP) == 0) { const int ln_ = lane_id_now(); E.group(st, acc, cur, (t + 2) / Epi::GROUP - 1, nt / Epi::GROUP, wr, wc, ln_ & 15, ln_ >> 4); } }
        }
        if constexpr (ALIGN_EPI) { if (wr == 0) PG8_BAR; }
        { const int ln_ = lane_id_now(), fr_ = ln_ & 15, fq_ = ln_ >> 4;
          if constexpr (Epi::GROUP > 0) { E.store(st, cur, wr, wc, fr_, fq_); if (has_next) E.begin(st, nxt, wr, wc, fr_, fq_); }
          else E(acc, cur, wr, wc, fr_, fq_); }
        if (!has_next) break;
        if constexpr (Epi::GROUP == 0) {
#pragma unroll
        for (int a = 0; a < 2; ++a)
#pragma unroll
            for (int b = 0; b < NB; ++b)
#pragma unroll
                for (int m = 0; m < 4; ++m)
#pragma unroll
                    for (int n = 0; n < 2; ++n) acc[a][b][m][n] = (f32x4){0.f, 0.f, 0.f, 0.f};
        }
        cur = nxt; ++ui;
        if constexpr (ALIGN_EPI) { if (wr == 1) PG8_BAR; }
    }
    PG8_WAIT_V(0);
    if constexpr (!ALIGN_EPI) { if (wr == 0) PG8_BAR; }
    PG8_BAR;
#undef PG8_SA
#undef PG8_SB
#undef PG8_STAGE
#undef PG8_STAGE_B1
#undef PG8_STAGE_A
#undef PG8_LDA
#undef PG8_LDB
#undef PG8_CAT
#undef PG8_MMA
#undef PG8_WAIT_V
#undef PG8_WAIT_VS
#undef PG8_WAIT_L
#undef PG8_BAR
#undef PG8_SCHED
}
}

namespace attn_body {
using bf16=unsigned short;
using bf16x8=__attribute__((ext_vector_type(8)))short;
using s16x4=__attribute__((ext_vector_type(4)))short;
using f32x16=__attribute__((ext_vector_type(16)))float;
using u32x4=__attribute__((ext_vector_type(4)))unsigned;
using f32x4=__attribute__((ext_vector_type(4)))float;
constexpr int BATCH=8,NHEAD=8,SEQ=4096,D=64,DM=NHEAD*D;
constexpr int VP=NPB;
constexpr int NW=8,QBLK=32,QB=QBLK*NW,KVBLK=64,NQB=SEQ/QB;
__device__ __forceinline__ int crow(int r,int hi){return (r&3)+8*(r>>2)+4*hi;}
#define SBAR() __builtin_amdgcn_sched_barrier(0)
__device__ __forceinline__ void cmask(f32x16&p0,f32x16&p1,int jb,int qrel,int hi){
  const float NEG=-INFINITY; int kb=64*jb+4*hi;
  #pragma unroll
  for(int r=0;r<16;++r){int kv=kb+(r&3)+8*(r>>2); if(kv>qrel)p0[r]=NEG; if(kv+32>qrel)p1[r]=NEG;}
}

constexpr int NSLOT=3, SLOTB=8192;
constexpr int LDS_K=0, LDS_V=NSLOT*SLOTB, LDS_WS=2*NSLOT*SLOTB, LDS_OST=LDS_WS+NW*64*4, LDS_BYTES=LDS_OST+NW*4096;
constexpr float C2=0.17677669529663687f*1.4426950408889634f;
__device__ __forceinline__ void glds16(const void*gsrc,unsigned lds_dst){unsigned keep;
  asm volatile("s_mov_b32 %0, m0\n\ts_mov_b32 m0, %2\n\ts_nop 0\n\tglobal_load_lds_dwordx4 %1, off\n\ts_mov_b32 m0, %0":"=&s"(keep):"v"(gsrc),"s"(lds_dst):"memory");}
__device__ __forceinline__ float max3f(float a,float b,float c){float r;asm("v_max3_f32 %0, %1, %2, %3":"=v"(r):"v"(a),"v"(b),"v"(c));return r;}
__device__ __forceinline__ float max2f(float a,float b){float r;asm("v_max_f32_e32 %0, %1, %2":"=v"(r):"v"(a),"v"(b));return r;}
__device__ __forceinline__ float fadd_s(float a,float b){float r;asm("v_add_f32_e32 %0, %1, %2":"=v"(r):"v"(a),"v"(b));return r;}
__device__ __forceinline__ float fsub_s(float a,float b){float r;asm("v_sub_f32_e32 %0, %1, %2":"=v"(r):"v"(a),"v"(b));return r;}
typedef float f32x2_t __attribute__((ext_vector_type(2))); typedef __bf16 bf16x2_t __attribute__((ext_vector_type(2)));
__device__ __forceinline__ unsigned cvtpk_s(float lo,float hi){f32x2_t v={lo,hi};bf16x2_t b=__builtin_convertvector(v,bf16x2_t);return __builtin_bit_cast(unsigned,b);}
#define WAIT_BAR(N) asm volatile("s_waitcnt vmcnt(" #N ") lgkmcnt(0)\n\ts_barrier":::"memory")

__device__ __forceinline__ void qkt(f32x16&p0,f32x16&p1,const char*Kslot,const bf16x8*qr,const f32x16&negm,int r32,int hi){
  const char*kb=Kslot+hi*1024+r32*16;
  #pragma unroll
  for(int d0=0;d0<2;++d0){
    const bf16x8 b0=*reinterpret_cast<const bf16x8*>(kb+d0*2048);
    const bf16x8 b1=*reinterpret_cast<const bf16x8*>(kb+d0*2048+512);
    if(d0==0){p0=__builtin_amdgcn_mfma_f32_32x32x16_bf16(b0,qr[0],negm,0,0,0);p1=__builtin_amdgcn_mfma_f32_32x32x16_bf16(b1,qr[0],negm,0,0,0);}
    else{p0=__builtin_amdgcn_mfma_f32_32x32x16_bf16(b0,qr[d0],p0,0,0,0);p1=__builtin_amdgcn_mfma_f32_32x32x16_bf16(b1,qr[d0],p1,0,0,0);}}
}
typedef __attribute__((address_space(3))) const char* lds_cptr;
typedef short v4i16_t __attribute__((ext_vector_type(4)));
__device__ __forceinline__ void kload8(bf16x8*kf,lds_cptr kp){
  kf[0]=*(const __attribute__((address_space(3))) bf16x8*)(kp);      kf[1]=*(const __attribute__((address_space(3))) bf16x8*)(kp+512);
  kf[2]=*(const __attribute__((address_space(3))) bf16x8*)(kp+2048); kf[3]=*(const __attribute__((address_space(3))) bf16x8*)(kp+2560);
}
__device__ __forceinline__ void kload2(bf16x8*kf,lds_cptr kp,int j){ kf[2*j]=*(const __attribute__((address_space(3))) bf16x8*)(kp+j*2048); kf[2*j+1]=*(const __attribute__((address_space(3))) bf16x8*)(kp+j*2048+512); }
__device__ __forceinline__ s16x4 vtr(lds_cptr p){ return __builtin_bit_cast(s16x4,__builtin_amdgcn_ds_read_tr16_b64_v4i16((__attribute__((address_space(3))) v4i16_t*)p)); }
__device__ __forceinline__ float rowmax(const f32x16&p0,const f32x16&p1){
  float a=max3f(p0[0],p0[1],p1[0]),b=max3f(p0[2],p0[3],p1[1]);a=max3f(a,p1[2],p1[3]);
  #pragma unroll
  for(int r=4;r<16;r+=4){a=max3f(a,p0[r],p0[r+1]);b=max3f(b,p0[r+2],p0[r+3]);a=max3f(a,p1[r],p1[r+1]);b=max3f(b,p1[r+2],p1[r+3]);}
  const float m=max2f(a,b);
  auto rr=__builtin_amdgcn_permlane32_swap(__float_as_uint(m),__float_as_uint(m),false,false);
  return max2f(__uint_as_float(rr[0]),__uint_as_float(rr[1]));
}
__device__ __forceinline__ void pv(f32x16*o,int vb,bf16x8 pa0,bf16x8 pa1,bf16x8 pa2,bf16x8 pa3){
  #pragma unroll
  for(int d0=0;d0<2;++d0){s16x4 lo[4],hi[4];
    #pragma unroll
    for(int ks=0;ks<4;++ks){
      asm volatile("ds_read_b64_tr_b16 %0,%1 offset:%c2":"=&v"(lo[ks]):"v"(vb),"i"(d0*4096+ks*1024):"memory");
      asm volatile("ds_read_b64_tr_b16 %0,%1 offset:%c2":"=&v"(hi[ks]):"v"(vb),"i"(d0*4096+ks*1024+512):"memory");}
    asm volatile("s_waitcnt lgkmcnt(0)":::"memory");SBAR();
    #define PK(k) (bf16x8){lo[k][0],lo[k][1],lo[k][2],lo[k][3],hi[k][0],hi[k][1],hi[k][2],hi[k][3]}
    o[d0]=__builtin_amdgcn_mfma_f32_32x32x16_bf16(pa0,PK(0),o[d0],0,0,0);
    o[d0]=__builtin_amdgcn_mfma_f32_32x32x16_bf16(pa1,PK(1),o[d0],0,0,0);
    o[d0]=__builtin_amdgcn_mfma_f32_32x32x16_bf16(pa2,PK(2),o[d0],0,0,0);
    o[d0]=__builtin_amdgcn_mfma_f32_32x32x16_bf16(pa3,PK(3),o[d0],0,0,0);
    #undef PK
  }
}

template<int THRL> __device__ __forceinline__ void attn_unit(int b,int h,int mp,int qb,const bf16*Q,const bf16*__restrict__ K,const bf16*__restrict__ V,bf16*Y,float lam,float osc,const float*__restrict__ sg,char*shm,int tid){
  asm volatile("":"+v"(tid)); const int lane=tid&63,r32=lane&31,hi=lane>>5; const int wid=__builtin_amdgcn_readfirstlane(tid>>6);
  const long rowbase=(long)b*SEQ; const int q0=qb*QB; const int vh=2*h+mp;
  const bf16*Qw=Q+(rowbase+q0+wid*QBLK)*DM+vh*D;
  const bf16*Kh=K+rowbase*DM+vh*D,*Vh=V+rowbase*VP+h*D;
  const unsigned lds0=(unsigned)(uintptr_t)shm;
  float*wsf=(float*)(shm+LDS_WS)+wid*64;
  const bf16*ksrc=Kh+(long)lane*DM+wid*8;
  const bf16*vsrc=Vh+(long)(16*(wid&3)+(lane>>2))*VP+(wid>>2)*32+(lane&3)*8;
  const unsigned kdst=lds0+LDS_K+wid*1024, vdst=lds0+LDS_V+wid*1024;
  #define DMA_K(t,slot) glds16(ksrc+(long)(t)*KVBLK*DM,(unsigned)__builtin_amdgcn_readfirstlane(kdst+(slot)))
  #define DMA_V(t,slot) glds16(vsrc+(long)(t)*KVBLK*VP,(unsigned)__builtin_amdgcn_readfirstlane(vdst+(slot)))
  const int vb0=(int)(lds0+LDS_V)+((lane>>4)&1)*32+(lane&3)*8+(4*hi+((lane&15)>>2))*64;
  const char*Kbase=shm+LDS_K; bf16x8 kf[4];
  const lds_cptr shm3=(lds_cptr)shm; const lds_cptr kp0=shm3+LDS_K+hi*1024+r32*16; const lds_cptr vp0=shm3+LDS_V+((lane>>4)&1)*32+(lane&3)*8+(4*hi+((lane&15)>>2))*64;
  const int NT=(q0+QB)/KVBLK;
  DMA_K(0,0);DMA_V(0,0);DMA_K(1,SLOTB);
  bf16x8 qr[2];
  #pragma unroll
  for(int d0=0;d0<2;++d0)qr[d0]=*reinterpret_cast<const bf16x8*>(&Qw[(long)r32*DM+d0*16+hi*8]);
  float zz=0.f; asm volatile("":"+v"(zz));
  float mhat=0.f;f32x16 o[3],negm;
  const bf16x8 ones8={(short)0x3F80,(short)0x3F80,(short)0x3F80,(short)0x3F80,(short)0x3F80,(short)0x3F80,(short)0x3F80,(short)0x3F80};
  #pragma unroll
  for(int r=0;r<16;++r){o[0][r]=zz;o[1][r]=zz;o[2][r]=zz;negm[r]=zz;}
  asm volatile("":"+v"(negm));
  const int qrel=wid*QBLK+r32;
  #define CMASK(P0,P1,t) do{int jb_=(t)-(NT-4); if(jb_>=0)cmask(P0,P1,jb_,qrel,hi);}while(0)
  bool resc=false;
  #define START(P0,P1) do{ const float rm=rowmax(P0,P1); resc=false; \
    { const float dl=rm; mhat=fadd_s(mhat,dl); \
      _Pragma("unroll") for(int r=0;r<16;++r){P0[r]=fsub_s(P0[r],dl);P1[r]=fsub_s(P1[r],dl);} \
      _Pragma("unroll") for(int r=0;r<16;++r)negm[r]=-mhat; asm volatile("":"+v"(negm)); } \
    _Pragma("unroll") for(int r=0;r<16;++r)P0[r]=__builtin_amdgcn_exp2f(P0[r]); }while(0)
  #define RESC() do{ if(resc){ asm volatile("s_waitcnt lgkmcnt(0)":::"memory"); \
      _Pragma("unroll") for(int d_=0;d_<3;++d_) _Pragma("unroll") for(int r=0;r<16;++r)o[d_][r]*=wsf[crow(r,hi)]; } }while(0)
  f32x16 pA0,pA1,pB0,pB1;
  int sl_prev=0,sl_cur=0,sl_next=SLOTB;
  #define ROT() do{sl_prev=sl_cur;sl_cur=sl_next;sl_next=(sl_next==(NSLOT-1)*SLOTB)?0:sl_next+SLOTB;}while(0)
  DMA_K(2,2*SLOTB);
  WAIT_BAR(3);
  qkt(pA0,pA1,Kbase,qr,negm,r32,hi);asm volatile("s_nop 15\n\ts_nop 7":"+v"(pA0),"+v"(pA1));CMASK(pA0,pA1,0);
  START(pA0,pA1);
  _Pragma("unroll") for(int r=0;r<16;++r)pA1[r]=__builtin_amdgcn_exp2f(pA1[r]);
  WAIT_BAR(0);
  DMA_K(3,0);DMA_V(1,SLOTB);
  ROT();
  kload8(kf,kp0+sl_cur);
  WAIT_BAR(2);
  s16x4 vlo[8],vhi[8]; u32x4 pw0,pw1,pw2,pw3;
  #define PKW(P,B) cvtpk_s(P[B],P[B+1])
  #define PAF(k) __builtin_bit_cast(bf16x8,pw##k)
  #define VFR(i) (bf16x8){vlo[i][0],vlo[i][1],vlo[i][2],vlo[i][3],vhi[i][0],vhi[i][1],vhi[i][2],vhi[i][3]}
  #define PIN(x) asm volatile("":"+v"(x))
  #define MX3(a,b,c) __builtin_fmaxf(__builtin_fmaxf((a),(b)),(c))
  #define GAPA(MF,W0,W1,PW) do{ MF; W0; W1; PIN(PW); SBAR(); }while(0)
  #define GAPN(W0,W1,PW) do{ W0; W1; PIN(PW); SBAR(); }while(0)
  #define GAPO(k) do{ o[2]=__builtin_amdgcn_mfma_f32_32x32x16_bf16(PAF(k),ones8,o[2],0,0,0); SBAR(); }while(0)
  #define EX(v) __builtin_amdgcn_exp2f(v)
  #define GAPB(MF,X,B) do{ MF; X[B]=EX(X[B]); X[B+1]=EX(X[B+1]); X[B+2]=EX(X[B+2]); X[B+3]=EX(X[B+3]); PIN(X); SBAR(); }while(0)
  #define VRD(i) do{ vlo[i]=vtr(vp_+(((i)>>2)*4096+((i)&3)*1024)); vhi[i]=vtr(vp_+(((i)>>2)*4096+((i)&3)*1024+512)); }while(0)
  #define KRD(G,j) do{ if(G){ kload2(kf,kp0+sl_next,j); SBAR(); } }while(0)
  #define STEP(C0,C1,P0,P1,t,GK,GV,GL) do{ SBAR(); \
    const lds_cptr vp_=vp0+sl_prev; \
    VRD(0); SBAR(); \
    GAPA(C0=__builtin_amdgcn_mfma_f32_32x32x16_bf16(kf[0],qr[0],negm,0,0,0), pw0[0]=PKW(P0,0), pw0[1]=PKW(P0,2), pw0); \
    VRD(4); SBAR(); GAPA(C1=__builtin_amdgcn_mfma_f32_32x32x16_bf16(kf[1],qr[0],negm,0,0,0), pw0[2]=PKW(P0,4), pw0[3]=PKW(P0,6), pw0); \
    VRD(1); SBAR(); GAPA(C0=__builtin_amdgcn_mfma_f32_32x32x16_bf16(kf[2],qr[1],C0,0,0,0),   pw1[0]=PKW(P0,8), pw1[1]=PKW(P0,10), pw1); \
    VRD(5); SBAR(); GAPA(C1=__builtin_amdgcn_mfma_f32_32x32x16_bf16(kf[3],qr[1],C1,0,0,0),   pw1[2]=PKW(P0,12),pw1[3]=PKW(P0,14), pw1); \
    VRD(2); SBAR(); GAPN(pw2[0]=PKW(P1,0), pw2[1]=PKW(P1,2), pw2); \
    VRD(6); SBAR(); GAPN(pw2[2]=PKW(P1,4), pw2[3]=PKW(P1,6), pw2); \
    VRD(3); SBAR(); GAPN(pw3[0]=PKW(P1,8), pw3[1]=PKW(P1,10), pw3); \
    VRD(7); SBAR(); GAPN(pw3[2]=PKW(P1,12),pw3[3]=PKW(P1,14), pw3); \
    if(GK){DMA_K((t)+3,sl_cur);} if(GV){DMA_V((t)+1,sl_next);} \
    CMASK(C0,C1,t); \
    { float a=MX3(C0[0],C0[1],C1[0]),b=MX3(C0[2],C0[3],C1[1]); a=MX3(a,C1[2],C1[3]); \
      _Pragma("unroll") for(int r=4;r<16;r+=4){a=MX3(a,C0[r],C0[r+1]);b=MX3(b,C0[r+2],C0[r+3]);a=MX3(a,C1[r],C1[r+1]);b=MX3(b,C1[r+2],C1[r+3]);} \
      float rm=__builtin_fmaxf(a,b); { auto rr=__builtin_amdgcn_permlane32_swap(__float_as_uint(rm),__float_as_uint(rm),false,false); rm=__builtin_fmaxf(__uint_as_float(rr[0]),__uint_as_float(rr[1])); } \
      resc=false; \
      if(__builtin_expect(__any(rm>(float)THRL),0)){ const float dl=__builtin_fmaxf(rm,0.f); mhat+=dl; \
        _Pragma("unroll") for(int r=0;r<16;++r){C0[r]-=dl;C1[r]-=dl;} \
        _Pragma("unroll") for(int r=0;r<16;++r)negm[r]=-mhat; asm volatile("":"+v"(negm)); \
        const float f=__builtin_amdgcn_exp2f(-dl); if(hi==0)wsf[r32]=f; resc=true; } } \
    SBAR(); \
    GAPB(o[0]=__builtin_amdgcn_mfma_f32_32x32x16_bf16(PAF(0),VFR(0),o[0],0,0,0), C0,0); \
    GAPB(o[1]=__builtin_amdgcn_mfma_f32_32x32x16_bf16(PAF(0),VFR(4),o[1],0,0,0), C0,4); GAPO(0); \
    KRD(GL,0); GAPB(o[0]=__builtin_amdgcn_mfma_f32_32x32x16_bf16(PAF(1),VFR(1),o[0],0,0,0), C0,8); \
    KRD(GL,1); GAPB(o[1]=__builtin_amdgcn_mfma_f32_32x32x16_bf16(PAF(1),VFR(5),o[1],0,0,0), C0,12); GAPO(1); \
    GAPB(o[0]=__builtin_amdgcn_mfma_f32_32x32x16_bf16(PAF(2),VFR(2),o[0],0,0,0), C1,0); \
    GAPB(o[1]=__builtin_amdgcn_mfma_f32_32x32x16_bf16(PAF(2),VFR(6),o[1],0,0,0), C1,4); GAPO(2); \
    GAPB(o[0]=__builtin_amdgcn_mfma_f32_32x32x16_bf16(PAF(3),VFR(3),o[0],0,0,0), C1,8); \
    GAPB(o[1]=__builtin_amdgcn_mfma_f32_32x32x16_bf16(PAF(3),VFR(7),o[1],0,0,0), C1,12); GAPO(3); \
    }while(0)
  int t=1;
  #undef CMASK
  #define CMASK(P0,P1,t) do{}while(0)
  for(;t+5<NT;t+=2){
    STEP(pB0,pB1,pA0,pA1,t,true,true,true);     WAIT_BAR(2); RESC(); ROT();
    STEP(pA0,pA1,pB0,pB1,t+1,true,true,true);   WAIT_BAR(2); RESC(); ROT();
  }
  #undef CMASK
  #define CMASK(P0,P1,t) do{int jb_=(t)-(NT-4); if(jb_>=0)cmask(P0,P1,jb_,qrel,hi);}while(0)
  #define ENDW(tt) do{ if((tt)+3<NT){WAIT_BAR(2);} else if((tt)+2<NT){WAIT_BAR(1);} else {WAIT_BAR(0);} }while(0)
  for(;t+1<NT;t+=2){
    STEP(pB0,pB1,pA0,pA1,t,(t+3<NT),(t+1<NT),(t+1<NT));       ENDW(t);   RESC(); ROT();
    STEP(pA0,pA1,pB0,pB1,t+1,(t+4<NT),(t+2<NT),(t+2<NT));     ENDW(t+1); RESC(); ROT();
  }
  STEP(pB0,pB1,pA0,pA1,NT-1,false,false,false); RESC();
  {
    pw0=(u32x4){PKW(pB0,0),PKW(pB0,2),PKW(pB0,4),PKW(pB0,6)};pw1=(u32x4){PKW(pB0,8),PKW(pB0,10),PKW(pB0,12),PKW(pB0,14)};pw2=(u32x4){PKW(pB1,0),PKW(pB1,2),PKW(pB1,4),PKW(pB1,6)};pw3=(u32x4){PKW(pB1,8),PKW(pB1,10),PKW(pB1,12),PKW(pB1,14)};
    SBAR(); pv(o,vb0+sl_cur,PAF(0),PAF(1),PAF(2),PAF(3));
    o[2]=__builtin_amdgcn_mfma_f32_32x32x16_bf16(PAF(0),ones8,o[2],0,0,0); o[2]=__builtin_amdgcn_mfma_f32_32x32x16_bf16(PAF(1),ones8,o[2],0,0,0);
    o[2]=__builtin_amdgcn_mfma_f32_32x32x16_bf16(PAF(2),ones8,o[2],0,0,0); o[2]=__builtin_amdgcn_mfma_f32_32x32x16_bf16(PAF(3),ones8,o[2],0,0,0); }
  #undef PKW
  #undef PAF
  #undef VFR
  #undef PIN
  #undef MX3
  #undef GAPA
  #undef GAPN
  #undef GAPO
  #undef GAPB
  #undef EX
  #undef VRD
  #undef KRD
  #undef STEP
  #undef ENDW
  float rli[16];
  #pragma unroll
  for(int r=0;r<16;++r)rli[r]=__builtin_amdgcn_rcpf(o[2][r]);
  { bf16*stg=(bf16*)(shm+LDS_OST)+wid*2048;
    if(mp==0){
      #pragma unroll
      for(int r=0;r<16;++r){const int orow=crow(r,hi);
        #pragma unroll
        for(int d0=0;d0<2;++d0)stg[orow*64+d0*32+r32]=(bf16)(cvtpk_s(o[d0][r]*rli[r],0.f)&0xffffu);}
    } else {
      #pragma unroll
      for(int r=0;r<16;++r){const int orow=crow(r,hi);
        #pragma unroll
        for(int d0=0;d0<2;++d0){const float o1=__uint_as_float(((unsigned)stg[orow*64+d0*32+r32])<<16); stg[orow*64+d0*32+r32]=(bf16)(cvtpk_s(o1-lam*(o[d0][r]*rli[r]),0.f)&0xffffu);}}
      asm volatile("s_waitcnt lgkmcnt(0)":::"memory");
      bf16*Yw=Y+(rowbase+q0+wid*QBLK)*256+h*D;
      const int ch=lane&7; const f32x4 g0=*(const f32x4*)(sg+ch*8),g1=*(const f32x4*)(sg+ch*8+4);
      #pragma unroll
      for(int i=0;i<4;++i){const int row=i*8+(lane>>3); const u32x4 v=*(const u32x4*)(stg+row*64+ch*8);
        float f[8]; f[0]=__uint_as_float(v.x<<16);f[1]=__uint_as_float(v.x&0xffff0000u);f[2]=__uint_as_float(v.y<<16);f[3]=__uint_as_float(v.y&0xffff0000u);
        f[4]=__uint_as_float(v.z<<16);f[5]=__uint_as_float(v.z&0xffff0000u);f[6]=__uint_as_float(v.w<<16);f[7]=__uint_as_float(v.w&0xffff0000u);
        float ss=(f[0]*f[0]+f[1]*f[1])+(f[2]*f[2]+f[3]*f[3])+(f[4]*f[4]+f[5]*f[5])+(f[6]*f[6]+f[7]*f[7]);
        ss+=__shfl_xor(ss,1);ss+=__shfl_xor(ss,2);ss+=__shfl_xor(ss,4);
        const float rs=__builtin_amdgcn_rsqf(ss*(1.f/64.f)+1e-5f)*osc;
        u32x4 w; w.x=cvtpk_s(f[0]*rs*g0[0],f[1]*rs*g0[1]); w.y=cvtpk_s(f[2]*rs*g0[2],f[3]*rs*g0[3]); w.z=cvtpk_s(f[4]*rs*g1[0],f[5]*rs*g1[1]); w.w=cvtpk_s(f[6]*rs*g1[2],f[7]*rs*g1[3]);
        *(u32x4*)(Yw+(long)row*256+ch*8)=w;}
    } }
  asm volatile("s_waitcnt lgkmcnt(0)\n\ts_barrier":::"memory");
  #undef DMA_K
  #undef DMA_V
  #undef CMASK
  #undef START
  #undef RESC
  #undef ROT
}
constexpr int ATTN_LDS_BYTES=LDS_BYTES;
#undef SBAR
#undef WAIT_BAR
}
#define GAS __attribute__((address_space(1)))
#define LAS __attribute__((address_space(3)))
typedef unsigned short bf16;
typedef unsigned v4u __attribute__((ext_vector_type(4)));
typedef float f32x4 __attribute__((ext_vector_type(4)));
typedef short bf16x8 __attribute__((ext_vector_type(8)));
typedef GAS unsigned gu32;
typedef GAS unsigned long long gu64;
#define RLX_AGENT __ATOMIC_RELAXED, __HIP_MEMORY_SCOPE_AGENT
#define LDS_WAIT() asm volatile("s_waitcnt lgkmcnt(0)" ::: "memory")
#define VM_WAIT() asm volatile("s_waitcnt vmcnt(0)" ::: "memory")
__device__ __forceinline__ unsigned long long rt() { return __builtin_amdgcn_s_memrealtime(); }
__device__ __forceinline__ unsigned f2bf(float f) { unsigned u = __builtin_bit_cast(unsigned, f); return (u + 0x7fffu + ((u >> 16) & 1u)) >> 16; }
__device__ __forceinline__ unsigned pk2(float lo, float hi) { return f2bf(lo) | (f2bf(hi) << 16); }

#define XB_TMO      128
#define XB_XCNT(j)  (256  + 64 * (j))
#define XB_XSUB(j)  (1280 + 64 * (j))
#define XB_XGEN(j)  (2304 + 64 * (j))
#define XB_TOP      3328
#define XB_TOPGEN   3392
#define XCD_BAR_WORDS 3456
#define XB_SPIN_CAP (1u << 18)

__device__ __forceinline__ unsigned xb_ld(unsigned* p)              { return __hip_atomic_load(p, __ATOMIC_RELAXED, __HIP_MEMORY_SCOPE_AGENT); }
__device__ __forceinline__ unsigned xb_add(unsigned* p, unsigned v) { return __hip_atomic_fetch_add(p, v, __ATOMIC_RELAXED, __HIP_MEMORY_SCOPE_AGENT); }
__device__ __forceinline__ unsigned xb_xcc_id() { return (unsigned)__builtin_amdgcn_s_getreg((3 << 11) | 20) & 0xFu; }
#define XB_SPIN(cond, bar) do { unsigned _sp = 0; while (cond) { __builtin_amdgcn_s_sleep(1); \
    if ((++_sp & 255u) == 0u) { if (xb_ld(&(bar)[XB_TMO])) break; if (_sp > XB_SPIN_CAP) { atomicAdd(&(bar)[XB_TMO], 1u); break; } } } } while (0)

struct XcdBarrier {
    unsigned* bar; unsigned x;
    unsigned off;
    unsigned G;
    int wave;
    volatile LAS unsigned* st;
};

__device__ __forceinline__ int xb_lane_id() { int l; asm volatile("v_mbcnt_lo_u32_b32 %0, -1, 0\n\tv_mbcnt_hi_u32_b32 %0, -1, %0" : "=v"(l)); return l; }
__device__ __forceinline__ bool xb_thread0(int wave) { asm volatile("" : "+s"(wave)); return wave == 0 && xb_lane_id() == 0; }
__device__ __forceinline__ XcdBarrier xcd_barrier_post(unsigned* bar, unsigned off, volatile LAS unsigned* st, int wave) {
    XcdBarrier b; b.bar = bar; b.off = off; b.x = xb_xcc_id(); b.st = st; b.wave = wave; b.G = gridDim.x * gridDim.y * gridDim.z;
    if (xb_thread0(wave)) (void)xb_add(&bar[off + XB_XCNT(b.x)], 1u);
    return b;
}
__device__ __forceinline__ void xcd_barrier_complete(unsigned* bar, unsigned x, unsigned G, unsigned& nloc, unsigned& nx) {
    unsigned sum, cnt, mine, sp = 0u;
    for (;;) {
        sum = 0u; cnt = 0u; mine = 0u;
#pragma unroll
        for (unsigned j = 0; j < 16; ++j) { const unsigned c = xb_ld(&bar[XB_XCNT(j)]); sum += c; cnt += (c > 0u) ? 1u : 0u; }
        mine = xb_ld(&bar[XB_XCNT(x)]);
        if (sum == G) break;
        __builtin_amdgcn_s_sleep(1);
        if ((++sp & 255u) == 0u) { if (xb_ld(&bar[XB_TMO])) break; if (sp > XB_SPIN_CAP) { atomicAdd(&bar[XB_TMO], 1u); break; } }
    }
    nloc = mine > 0u ? mine : 1u; nx = cnt > 0u ? cnt : 1u;
}

__device__ __forceinline__ void xcd_barrier(const XcdBarrier& b) {
    asm volatile("s_waitcnt vmcnt(0)" ::: "memory");
    __syncthreads();
    if (xb_thread0(b.wave)) {
        GAS unsigned* barg = (GAS unsigned*)b.bar; asm volatile("" : "+s"(barg)); unsigned* bar = (unsigned*)barg + b.off; const unsigned bx_ = xb_xcc_id();
        __builtin_amdgcn_s_waitcnt(0);
        unsigned nloc = b.st[0], nx = b.st[1];
        if (nloc == 0u) { xcd_barrier_complete(bar, bx_, b.G, nloc, nx); b.st[0] = nloc; b.st[1] = nx; }
        const unsigned old = xb_add(&bar[XB_XSUB(bx_)], 1u);
        const unsigned gen = old / nloc;
        if (old + 1u == (gen + 1u) * nloc) {
            __builtin_amdgcn_fence(__ATOMIC_RELEASE, "agent");
            asm volatile("s_waitcnt vmcnt(0)" ::: "memory");
            const unsigned og = xb_add(&bar[XB_TOP], 1u);
            const unsigned tg = og / nx;
            if (og + 1u == (tg + 1u) * nx) xb_add(&bar[XB_TOPGEN], 1u);
            else XB_SPIN(xb_ld(&bar[XB_TOPGEN]) == tg, bar);
            __builtin_amdgcn_fence(__ATOMIC_ACQUIRE, "agent");
            xb_add(&bar[XB_XGEN(bx_)], 1u);
            asm volatile("s_waitcnt vmcnt(0)" ::: "memory");
        } else {
            XB_SPIN(xb_ld(&bar[XB_XGEN(bx_)]) == gen, bar);
            __builtin_amdgcn_fence(__ATOMIC_ACQUIRE, "agent");
            asm volatile("s_waitcnt vmcnt(0)" ::: "memory");
        }
    }
    __syncthreads();
}
constexpr size_t KiB = 1u << 10, MiB = 1u << 20;
constexpr size_t WS_CTL = 0, CTL_ZERO_BYTES = 64 * KiB;
constexpr size_t TB_ROPEC = 1 * MiB, TB_ROPES = TB_ROPEC + 256 * KiB;
constexpr size_t TB_PWT = TB_ROPES + 256 * KiB;
constexpr size_t TB_SGW = TB_PWT + 64 * KiB;
constexpr size_t TB_HIST = TB_SGW + 256 * KiB;
constexpr size_t TB_TOKC = TB_HIST + 32 * KiB;
constexpr size_t TB_TOKW = TB_TOKC + 128 * KiB;
constexpr size_t TB_ROWTOK = TB_TOKW + 256 * KiB;
constexpr size_t TB_ROWW = TB_ROWTOK + 160 * KiB;
static_assert(TB_ROWW + 320 * KiB <= 3 * MiB, "tables");
constexpr size_t W_IN = 3 * MiB;
constexpr size_t W_G8 = W_IN + (size_t)NPB * DMODEL * 2;
constexpr size_t W_B = W_G8 + 4 * MiB;
constexpr size_t W_O = W_B + 2 * MiB;
constexpr size_t W_GU = W_O + 2 * MiB;
constexpr size_t W_D = W_GU + 16 * MiB;
static_assert(W_D + 8 * MiB <= 44 * MiB, "weights");
constexpr size_t WS_XB = 44 * MiB;
constexpr size_t WS_X = 108 * MiB;
constexpr size_t WS_QKY = 236 * MiB;
constexpr size_t WS_QP = WS_QKY, WS_KP = WS_QKY + 32 * MiB, WS_YA = WS_QKY + 64 * MiB;
constexpr size_t WS_X8 = WS_X, WS_X18 = WS_X + 32 * MiB;
constexpr size_t WS_P = 364 * MiB;
constexpr size_t WS_MG = WS_P, WS_XS = WS_P, WS_HB = WS_P + 80 * MiB;
constexpr size_t WS_END = 508 * MiB;
static_assert(WS_P + (size_t)M * NPB * 2 <= WS_END && WS_HB + (size_t)MAXROWS * 512 * 2 <= WS_END && WS_XS + (size_t)MAXROWS * 1024 * 2 <= WS_HB, "d_ws map");
constexpr int CW_TMO = 0, CW_BAR = 4096, CW_CNT = 8192, CW_Q = 12288;
constexpr int CW_CNT_ = CW_CNT;
constexpr int CAP = 32768;
constexpr size_t TB2_ROWTOK = WS_X + 64 * MiB, TB2_ROWW = WS_X + 68 * MiB;
static_assert((CW_CNT + 2 * 2048) <= CW_Q && (CW_Q + 4 * 64) * 4 <= (int)CTL_ZERO_BYTES && TB2_ROWW + (size_t)NCLS * CAP * 8 <= WS_X + 128 * MiB, "class tables");
constexpr int RING_OFF = 0, RING_BYTES = 131072;
constexpr int LDSCTL_OFF = RING_BYTES, MISC_OFF = LDSCTL_OFF + 320, LDSX_OFF = LDSCTL_OFF + 1024;
constexpr int LDS_BYTES = 147456;
constexpr int NWAVES = 8;
constexpr int NPHASE = 1 + 10 * DEPTH;

struct Frame {
    LAS unsigned char* lds;
    gu32* ctl;
    int tid, lane, wave, vcu, G, bx;
    float* out; unsigned char* ws;
};
typedef const GAS float* cgfptr_t;
__device__ __forceinline__ const float* arg_in(int k) {
    const __attribute__((address_space(4))) char* ka = (const __attribute__((address_space(4))) char*)__builtin_amdgcn_kernarg_segment_ptr();
    asm volatile("" : "+s"(ka));
    const GAS float* p = *(const __attribute__((address_space(4))) cgfptr_t*)(ka + 8 * k);
    return (const float*)p;
}
__device__ __forceinline__ float dpp_add(float v, const int ctrl_sel) {
    const int x = __builtin_bit_cast(int, v); int y;
    if (ctrl_sel == 0) y = __builtin_amdgcn_update_dpp(0, x, 0xB1, 0xf, 0xf, true);
    else if (ctrl_sel == 1) y = __builtin_amdgcn_update_dpp(0, x, 0x4E, 0xf, 0xf, true);
    else if (ctrl_sel == 2) y = __builtin_amdgcn_update_dpp(0, x, 0x141, 0xf, 0xf, true);
    else y = __builtin_amdgcn_update_dpp(0, x, 0x140, 0xf, 0xf, true);
    return v + __builtin_bit_cast(float, y);
}
__device__ __forceinline__ float wave_sum(float v) {
    v = dpp_add(v, 0); v = dpp_add(v, 1); v = dpp_add(v, 2); v = dpp_add(v, 3);
    const int x = __builtin_bit_cast(int, v);
    const float a = __builtin_bit_cast(float, __builtin_amdgcn_readlane(x, 0)), b = __builtin_bit_cast(float, __builtin_amdgcn_readlane(x, 16));
    const float c = __builtin_bit_cast(float, __builtin_amdgcn_readlane(x, 32)), d = __builtin_bit_cast(float, __builtin_amdgcn_readlane(x, 48));
    return (a + b) + (c + d);
}
__device__ __forceinline__ unsigned cvtpk(float lo, float hi) { unsigned r; asm volatile("v_cvt_pk_bf16_f32 %0, %1, %2" : "=v"(r) : "v"(lo), "v"(hi)); return r; }
__device__ __forceinline__ float bflo(unsigned w) { return __uint_as_float(w << 16); }
__device__ __forceinline__ float bfhi(unsigned w) { return __uint_as_float(w & 0xffff0000u); }
typedef float f32x2g __attribute__((ext_vector_type(2)));
typedef unsigned u32x2g __attribute__((ext_vector_type(2)));

__device__ __forceinline__ void transpose_item(const float* W, int N, bf16* WT, int ldt, int dst_row0, int k0, int n0, LAS float* scr, int lane) {
#pragma unroll 8
    for (int i = 0; i < 32; ++i) { const int kk = 2 * i + (lane >> 5); scr[kk * 33 + (lane & 31)] = W[(size_t)(k0 + kk) * N + n0 + (lane & 31)]; }
    LDS_WAIT(); asm volatile("" ::: "memory");
    const int c = lane & 7;
#pragma unroll
    for (int j = 0; j < 4; ++j) { const int n = (lane >> 3) + 8 * j; const LAS float* s = scr + (8 * c) * 33 + n;
        v4u o; o.x = pk2(s[0 * 33], s[1 * 33]); o.y = pk2(s[2 * 33], s[3 * 33]); o.z = pk2(s[4 * 33], s[5 * 33]); o.w = pk2(s[6 * 33], s[7 * 33]);
        *(v4u*)(WT + (size_t)(dst_row0 + n) * ldt + k0 + 8 * c) = o; }
    LDS_WAIT(); asm volatile("" ::: "memory");
}
__device__ __forceinline__ void transpose_item8(const float* W, int N, unsigned char* WT, int ldt, int dst_row0, int k0, int n0, float scale, LAS float* scr, int lane) {
#pragma unroll 8
    for (int i = 0; i < 32; ++i) { const int kk = 2 * i + (lane >> 5); scr[kk * 33 + (lane & 31)] = W[(size_t)(k0 + kk) * N + n0 + (lane & 31)]; }
    LDS_WAIT(); asm volatile("" ::: "memory");
    const int c = lane & 7;
#pragma unroll
    for (int j = 0; j < 4; ++j) { const int n = (lane >> 3) + 8 * j; const LAS float* s = scr + (8 * c) * 33 + n;
        int lo = 0, hi = 0;
        lo = __builtin_amdgcn_cvt_pk_fp8_f32(s[0 * 33] * scale, s[1 * 33] * scale, lo, false); lo = __builtin_amdgcn_cvt_pk_fp8_f32(s[2 * 33] * scale, s[3 * 33] * scale, lo, true);
        hi = __builtin_amdgcn_cvt_pk_fp8_f32(s[4 * 33] * scale, s[5 * 33] * scale, hi, false); hi = __builtin_amdgcn_cvt_pk_fp8_f32(s[6 * 33] * scale, s[7 * 33] * scale, hi, true);
        *(u32x2g*)(WT + (size_t)(dst_row0 + n) * ldt + k0 + 8 * c) = (u32x2g){(unsigned)lo, (unsigned)hi}; }
    LDS_WAIT(); asm volatile("" ::: "memory");
}
constexpr int WI_IN = 16 * 200, WI_B = 512, WI_O = 512, WI_G = 2048, WI_D = 2048, WI_NX = WI_IN + WI_B + WI_O, WI_GU = 2 * WI_G, WI_ALL = WI_NX + WI_GU + WI_D;
__device__ __forceinline__ void convert_item(Frame& F, int l, int it, LAS float* scr) {
    bf16* Win = (bf16*)(F.ws + W_IN); unsigned char* Wg8 = F.ws + W_G8; bf16* Wb = (bf16*)(F.ws + W_B); bf16* Wo = (bf16*)(F.ws + W_O); unsigned char* Wgu = F.ws + W_GU; unsigned char* Wd = F.ws + W_D;
    int r = it;
    if (r < WI_IN) { const int kb = r / 200, nb = r % 200; const float* w = arg_in(1) + (size_t)l * DMODEL * NIN;
        if (nb < NPB / 32) transpose_item(w, NIN, Win, DMODEL, 32 * nb, 64 * kb, 32 * nb, scr, F.lane);
        else transpose_item8(w, NIN, Wg8, DMODEL, 32 * nb - NPB, 64 * kb, 32 * nb, pg8::FP8_WS, scr, F.lane);
        return; } r -= WI_IN;
    if (r < WI_B) { const int br = r >> 7, q = r & 127, kb = q >> 5, nb = q & 31; transpose_item(arg_in(14) + (size_t)(l * 4 + br) * 256 * DMODEL, DMODEL, Wb + (size_t)br * DMODEL * 256, 256, 32 * nb, 64 * kb, 32 * nb, scr, F.lane); return; } r -= WI_B;
    if (r < WI_O) { const int kb = r >> 5, nb = r & 31; transpose_item(arg_in(15) + (size_t)l * DMODEL * DMODEL, DMODEL, Wo, DMODEL, 32 * nb, 64 * kb, 32 * nb, scr, F.lane); return; } r -= WI_O;
    if (r < WI_GU) { const int up = r >= WI_G; if (up) r -= WI_G; const int e = r >> 7, q = r & 127, kb = q >> 3, nb = q & 7, n0 = 32 * nb;
        transpose_item8((up ? arg_in(23) : arg_in(22)) + (size_t)(l * 16 + e) * DMODEL * 256, 256, Wgu + (size_t)e * 512 * DMODEL, DMODEL, 256 * (n0 >> 7) + (n0 & 127) + (up ? 128 : 0), 64 * kb, n0, pg8::FP8_WS, scr, F.lane); return; } r -= WI_GU;
    { const int e = r >> 7, q = r & 127, kb = q >> 5, nb = q & 31; transpose_item8(arg_in(24) + (size_t)(l * 16 + e) * 256 * DMODEL, DMODEL, Wd + (size_t)e * DMODEL * 256, 256, 32 * nb, 64 * kb, 32 * nb, pg8::FP8_WS, scr, F.lane); }
}
__device__ __forceinline__ void convert_weights(Frame& F, int l, int lo = 0, int hi = WI_ALL) {
    LAS float* scr = (LAS float*)(F.lds + RING_OFF + F.wave * 16384);
    for (int it = lo + F.vcu * NWAVES + F.wave; it < hi; it += F.G * NWAVES) convert_item(F, l, it, scr);
}
__device__ __forceinline__ void convert_tail(Frame& F, int l, int lo, int hi) {
    LAS float* scr = (LAS float*)(F.lds + RING_OFF + F.wave * 16384);
    const int nunits = (__builtin_amdgcn_readfirstlane(((const LAS int*)(F.lds + LDSCTL_OFF))[NCLS]) >> 8) * 4, rem = nunits % F.G;
    int first = rem, ncu = F.G - rem; if (rem == 0 || ncu < F.G / 4) { first = 0; ncu = F.G; }
    if (F.vcu < first) return;
    for (int it = lo + (F.vcu - first) * NWAVES + F.wave; it < hi; it += ncu * NWAVES) convert_item(F, l, it, scr);
}
__device__ __forceinline__ void p0_prologue(Frame& F) {
    constexpr int XW = 8;
    convert_weights(F, 0);
    const int gt = F.vcu * 512 + F.tid, NT = F.G * 512;
    if (F.wave < XW) { const float* x = arg_in(0); bf16* xb = (bf16*)(F.ws + WS_XB); unsigned char* x8 = F.ws + WS_X8; const int gx = (F.vcu * XW + F.wave) * 64 + F.lane, NX = F.G * XW * 64, NI = M * DMODEL / 8;
      for (int i0 = gx; i0 < NI; i0 += 4 * NX) { f32x4 a[4], b[4];
#pragma unroll
          for (int u = 0; u < 4; ++u) { const int i = i0 + u * NX; if (i < NI) { a[u] = *(const f32x4*)(x + (size_t)i * 8); b[u] = *(const f32x4*)(x + (size_t)i * 8 + 4); } }
#pragma unroll
          for (int u = 0; u < 4; ++u) { const int i = i0 + u * NX; if (i < NI) {
              v4u o; o.x = cvtpk(a[u][0], a[u][1]); o.y = cvtpk(a[u][2], a[u][3]); o.z = cvtpk(b[u][0], b[u][1]); o.w = cvtpk(b[u][2], b[u][3]); *(v4u*)(xb + (size_t)i * 8) = o;
              const float s = pg8::FP8_XS;
              *(u32x2g*)(x8 + (size_t)i * 8) = (u32x2g){pg8::fp8_pk4(a[u][0] * s, a[u][1] * s, a[u][2] * s, a[u][3] * s), pg8::fp8_pk4(b[u][0] * s, b[u][1] * s, b[u][2] * s, b[u][3] * s)}; } } } }
    { float* rc = (float*)(F.ws + TB_ROPEC); float* rs = (float*)(F.ws + TB_ROPES);
      for (int i = gt; i < SEQ * 16; i += NT) { const int pos = i >> 4, j = i & 15;
          const float inv = (float)exp2(-(double)j * (13.287712379549449 / 16.0)); const float ang = (float)pos * inv;
          const double a = (double)ang; const double k = rint(a * 0.15915494309189535); const float r = (float)(a - k * 6.283185307179586);
          rc[i] = cosf(r); rs[i] = sinf(r); } }
    { bf16* pwt = (bf16*)(F.ws + TB_PWT); const float* pw = arg_in(2);
      for (int i = gt; i < 2 * 4 * 64 * 64; i += NT) { const int c = i & 63, d = (i >> 6) & 63, lg = i >> 12; pwt[i] = (bf16)f2bf(pw[(size_t)lg * 4096 + c * 64 + d]); }
      bf16* sgw = (bf16*)(F.ws + TB_SGW); const float* sw = arg_in(12);
      for (int i = gt; i < 2 * 4 * 128 * 128; i += NT) { const int s = i & 127, t = (i >> 7) & 127; sgw[i] = (s <= t) ? (bf16)f2bf(sw[i]) : (bf16)0; } }
}

constexpr int VTP = 136;
__device__ __forceinline__ void unpack8(const v4u v, float (&f)[8]) { f[0] = bflo(v.x); f[1] = bfhi(v.x); f[2] = bflo(v.y); f[3] = bfhi(v.y); f[4] = bflo(v.z); f[5] = bfhi(v.z); f[6] = bflo(v.w); f[7] = bfhi(v.w); }
__device__ __forceinline__ v4u pack8(const float (&f)[8]) { v4u w; w.x = cvtpk(f[0], f[1]); w.y = cvtpk(f[2], f[3]); w.z = cvtpk(f[4], f[5]); w.w = cvtpk(f[6], f[7]); return w; }
template <int WIN> __device__ __forceinline__ void pool_item(const bf16* P, const bf16* pwt_g, const float* psc, bf16* YA, int g, int row0, int pos0, int tb, int r32, int hi) {
    const int t = 32 * tb + r32, pos = pos0 + t; const size_t row = (size_t)(row0 + t);
    const int cnt = (pos + 1 < WIN) ? pos + 1 : WIN; const float rcnt = 1.0f / (float)cnt;
    attn_body::f32x16 acc0 = {}, acc1 = {};
#pragma unroll
    for (int ks = 0; ks < 4; ++ks) { const bf16* src = P + row * NPB + PC_POOL + 64 * g + 16 * ks + 8 * hi;
        v4u v[WIN];
#pragma unroll
        for (int j = 0; j < WIN; ++j) v[j] = *(const v4u*)(src - (size_t)(j < cnt ? j : 0) * NPB);
        float s[8], a0[8]; unpack8(v[0], a0);
#pragma unroll
        for (int e = 0; e < 8; ++e) s[e] = a0[e];
#pragma unroll
        for (int j = 1; j < WIN; ++j) { float x[8]; unpack8(v[j], x); const float m = j < cnt ? 1.f : 0.f;
#pragma unroll
            for (int e = 0; e < 8; ++e) s[e] += m * x[e]; }
        float d[8];
#pragma unroll
        for (int e = 0; e < 8; ++e) d[e] = s[e] * rcnt - a0[e];
        const bf16x8 dfr = __builtin_bit_cast(bf16x8, pack8(d));
        const bf16x8 w0 = *(const bf16x8*)(pwt_g + (size_t)r32 * 64 + 16 * ks + 8 * hi), w1 = *(const bf16x8*)(pwt_g + (size_t)(32 + r32) * 64 + 16 * ks + 8 * hi);
        acc0 = __builtin_amdgcn_mfma_f32_32x32x16_bf16(w0, dfr, acc0, 0, 0, 0); acc1 = __builtin_amdgcn_mfma_f32_32x32x16_bf16(w1, dfr, acc1, 0, 0, 0); }
#pragma unroll
    for (int q4 = 0; q4 < 4; ++q4) { const int c0 = 64 * g + 8 * q4 + 4 * hi; const f32x4 p0 = *(const f32x4*)(psc + c0), p1 = *(const f32x4*)(psc + c0 + 32);
        u32x2g w; w.x = cvtpk(acc0[4 * q4 + 0] * p0[0], acc0[4 * q4 + 1] * p0[1]); w.y = cvtpk(acc0[4 * q4 + 2] * p0[2], acc0[4 * q4 + 3] * p0[3]); *(u32x2g*)(YA + row * 256 + c0) = w;
        w.x = cvtpk(acc1[4 * q4 + 0] * p1[0], acc1[4 * q4 + 1] * p1[1]); w.y = cvtpk(acc1[4 * q4 + 2] * p1[2], acc1[4 * q4 + 3] * p1[3]); *(u32x2g*)(YA + row * 256 + c0 + 32) = w; }
}
__device__ __forceinline__ void prep_unit(Frame& F, int ch, int l) {
    const bf16* P = (const bf16*)(F.ws + WS_P);
    int tid = F.tid; asm volatile("" : "+v"(tid)); const int row0 = ch * 128, pos0 = (ch & 31) * 128, lane = tid & 63, wave = F.wave;
    { bf16* YB = (bf16*)(F.ws + WS_YA) + (size_t)1 * M * 256; const float* cw = arg_in(4) + (size_t)l * 3 * 256; const int c8 = (tid & 31) * 8;
      float w0[8], w1[8], w2[8];
      { const f32x4 a = *(const f32x4*)(cw + c8), b = *(const f32x4*)(cw + c8 + 4), c = *(const f32x4*)(cw + 256 + c8), d = *(const f32x4*)(cw + 256 + c8 + 4), e = *(const f32x4*)(cw + 512 + c8), g = *(const f32x4*)(cw + 512 + c8 + 4);
#pragma unroll
        for (int i = 0; i < 4; ++i) { w0[i] = a[i]; w0[4 + i] = b[i]; w1[i] = c[i]; w1[4 + i] = d[i]; w2[i] = e[i]; w2[4 + i] = g[i]; } }
      for (int bt = 0; bt < 2; ++bt) { v4u gb[4], gc[4][3], hh[4][3];
#pragma unroll
          for (int u = 0; u < 4; ++u) { const int r = (tid >> 5) + 16 * (bt * 4 + u); const int pos = pos0 + r; const bf16* pr = P + (size_t)(row0 + r) * NPB;
              gb[u] = *(const v4u*)(pr + PC_GB + c8);
#pragma unroll
              for (int j = 0; j < 3; ++j) { const bf16* pj = pr - (size_t)(pos - j >= 0 ? j : 0) * NPB; gc[u][j] = *(const v4u*)(pj + PC_GC + c8); hh[u][j] = *(const v4u*)(pj + PC_H + c8); } }
#pragma unroll
          for (int u = 0; u < 4; ++u) { const int r = (tid >> 5) + 16 * (bt * 4 + u); const int pos = pos0 + r;
              float g[8], z0[8], z1[8], z2[8], a[8], b[8]; unpack8(gb[u], g);
              unpack8(gc[u][0], a); unpack8(hh[u][0], b);
#pragma unroll
              for (int e = 0; e < 8; ++e) z0[e] = a[e] * b[e];
              unpack8(gc[u][1], a); unpack8(hh[u][1], b); const float m1 = pos >= 1 ? 1.f : 0.f;
#pragma unroll
              for (int e = 0; e < 8; ++e) z1[e] = a[e] * b[e] * m1;
              unpack8(gc[u][2], a); unpack8(hh[u][2], b); const float m2 = pos >= 2 ? 1.f : 0.f;
#pragma unroll
              for (int e = 0; e < 8; ++e) z2[e] = a[e] * b[e] * m2;
              float o[8];
#pragma unroll
              for (int e = 0; e < 8; ++e) o[e] = g[e] * (w0[e] * z2[e] + w1[e] * z1[e] + w2[e] * z0[e]);
              *(v4u*)(YB + (size_t)(row0 + r) * 256 + c8) = pack8(o); } } }
    LAS bf16* VT = (LAS bf16*)(F.lds + RING_OFF);
    { const float* lg = arg_in(10) + l * 256; const float* lb = arg_in(11) + l * 256; const f32x4 g4 = *(const f32x4*)(lg + 4 * lane), b4 = *(const f32x4*)(lb + 4 * lane);
      for (int bt = 0; bt < 4; ++bt) { u32x2g v[4];
#pragma unroll
          for (int u = 0; u < 4; ++u) v[u] = *(const u32x2g*)(P + (size_t)(row0 + wave * 16 + bt * 4 + u) * NPB + PC_VV + 4 * lane);
#pragma unroll
          for (int u = 0; u < 4; ++u) { const int r = wave * 16 + bt * 4 + u; float f[4] = {bflo(v[u].x), bfhi(v[u].x), bflo(v[u].y), bfhi(v[u].y)};
              const float mean = wave_sum((f[0] + f[1]) + (f[2] + f[3])) * (1.f / 256.f);
#pragma unroll
              for (int e = 0; e < 4; ++e) f[e] -= mean;
              const float rstd = __builtin_amdgcn_rsqf(wave_sum((f[0] * f[0] + f[1] * f[1]) + (f[2] * f[2] + f[3] * f[3])) * (1.f / 256.f) + LN_EPS);
#pragma unroll
              for (int e = 0; e < 4; ++e) VT[(4 * lane + e) * VTP + r] = (bf16)f2bf(f[e] * rstd * g4[e] + b4[e]); } } }
    LDS_WAIT(); __syncthreads();
    const int r32 = lane & 31, hi = lane >> 5;
    { const int g = wave >> 1, cb = wave & 1; const bf16* sgw = (const bf16*)(F.ws + TB_SGW) + (size_t)(l * 4 + g) * 128 * 128; const float* sb = arg_in(13) + (size_t)(l * 4 + g) * 128;
      bf16* YD = (bf16*)(F.ws + WS_YA) + (size_t)3 * M * 256;
#pragma unroll
      for (int tb = 0; tb < 4; ++tb) { attn_body::f32x16 acc = {}; bf16x8 bfr[8]; u32x2g uu[4]; const int t = 32 * tb + r32; const size_t row = (size_t)(row0 + t);
#pragma unroll
          for (int ks = 0; ks < 2 * (tb + 1); ++ks) bfr[ks] = *(const bf16x8*)(sgw + (size_t)t * 128 + 16 * ks + 8 * hi);
#pragma unroll
          for (int q4 = 0; q4 < 4; ++q4) uu[q4] = *(const u32x2g*)(P + row * NPB + PC_U + 64 * g + 32 * cb + 8 * q4 + 4 * hi);
          const float bias = sb[t];
#pragma unroll
          for (int ks = 0; ks < 2 * (tb + 1); ++ks) { const bf16x8 a = *(const LAS bf16x8*)(VT + (64 * g + 32 * cb + r32) * VTP + 16 * ks + 8 * hi);
              acc = __builtin_amdgcn_mfma_f32_32x32x16_bf16(a, bfr[ks], acc, 0, 0, 0); }
#pragma unroll
          for (int q4 = 0; q4 < 4; ++q4) { const int c0 = 64 * g + 32 * cb + 8 * q4 + 4 * hi; const u32x2g u = uu[q4];
              u32x2g w; w.x = cvtpk(bflo(u.x) * (acc[4 * q4 + 0] + bias), bfhi(u.x) * (acc[4 * q4 + 1] + bias)); w.y = cvtpk(bflo(u.y) * (acc[4 * q4 + 2] + bias), bfhi(u.y) * (acc[4 * q4 + 3] + bias));
              *(u32x2g*)(YD + row * 256 + c0) = w; } } }
    { const int g = wave & 3; const bf16* pwt_g = (const bf16*)(F.ws + TB_PWT) + (size_t)(l * 4 + g) * 4096; const float* psc = arg_in(3) + l * 256; bf16* YA = (bf16*)(F.ws + WS_YA);
      for (int tb = wave >> 2; tb < 4; tb += 2) {
          if (g == 0) pool_item<2>(P, pwt_g, psc, YA, g, row0, pos0, tb, r32, hi); else if (g == 1) pool_item<4>(P, pwt_g, psc, YA, g, row0, pos0, tb, r32, hi);
          else if (g == 2) pool_item<8>(P, pwt_g, psc, YA, g, row0, pos0, tb, r32, hi); else pool_item<16>(P, pwt_g, psc, YA, g, row0, pos0, tb, r32, hi); } }
    __syncthreads();
}

__device__ __forceinline__ void route_phase(Frame& F, int l) {
    int tid = F.tid; asm volatile("" : "+v"(tid)); const bf16* H1 = (const bf16*)F.out; bf16* XB = (bf16*)(F.ws + WS_XB); unsigned char* X18 = F.ws + WS_X18; const int lane = tid & 63, wave = F.wave;
    LAS float* Wrg = (LAS float*)(F.lds + RING_OFF); LAS float* Wre = Wrg + 4096;
    LAS int* cc = (LAS int*)(F.lds + LDSCTL_OFF + 224);
    { const float* wrg = arg_in(18) + (size_t)l * 4096; const float* wre = arg_in(20) + (size_t)l * 16384;
      for (int k = tid; k < 1024; k += 512) { const int dst = (((k >> 8) * 4 + (k & 3)) * 64 + ((k & 255) >> 2)) * 4; *(LAS f32x4*)(Wrg + dst) = *(const f32x4*)(wrg + 4 * k);
#pragma unroll
          for (int g = 0; g < 4; ++g) *(LAS f32x4*)(Wre + g * 4096 + dst) = *(const f32x4*)(wre + (size_t)g * 4096 + 4 * k); } }
    const float* g1 = arg_in(16) + l * DMODEL; const float* b1 = arg_in(17) + l * DMODEL; const float* brg = arg_in(19) + l * 4; const float* bre = arg_in(21) + l * 16;
    int* rowtok = (int*)(F.ws + TB2_ROWTOK); f32x2g* roww = (f32x2g*)(F.ws + TB2_ROWW); gu32* gcnt = F.ctl + CW_CNT + 2048 * l;
    LAS int* ent = (LAS int*)(F.lds + LDSX_OFF); LAS int* cbase = (LAS int*)(F.lds + LDSX_OFF + 2048);
    f32x4 gg[4], bb[4];
#pragma unroll
    for (int j = 0; j < 4; ++j) { gg[j] = *(const f32x4*)(g1 + 4 * lane + 256 * j); bb[j] = *(const f32x4*)(b1 + 4 * lane + 256 * j); }
    const f32x4 brg4 = *(const f32x4*)brg;
    for (int rg = F.vcu; rg < M / 128; rg += F.G) {
        if (tid < NCLS) cc[tid] = 0;
        LDS_WAIT(); __syncthreads();
        constexpr int NR = 2;
        u32x2g qn[NR][4];
#pragma unroll
        for (int r = 0; r < NR; ++r)
#pragma unroll
            for (int j = 0; j < 4; ++j) qn[r][j] = *(const u32x2g*)(H1 + ((size_t)rg * 128 + wave * 16 + r) * DMODEL + 4 * lane + 256 * j);
        for (int i = 0; i < 16; i += NR) {
            f32x4 v[NR][4]; float mean[NR], rstd[NR];
#pragma unroll
            for (int r = 0; r < NR; ++r)
#pragma unroll
                for (int j = 0; j < 4; ++j) v[r][j] = (f32x4){bflo(qn[r][j].x), bfhi(qn[r][j].x), bflo(qn[r][j].y), bfhi(qn[r][j].y)};
            if (i + NR < 16) {
#pragma unroll
                for (int r = 0; r < NR; ++r)
#pragma unroll
                    for (int j = 0; j < 4; ++j) qn[r][j] = *(const u32x2g*)(H1 + ((size_t)rg * 128 + wave * 16 + i + NR + r) * DMODEL + 4 * lane + 256 * j); }
#pragma unroll
            for (int r = 0; r < NR; ++r) { float s = 0.f;
#pragma unroll
                for (int j = 0; j < 4; ++j) s += (v[r][j][0] + v[r][j][1]) + (v[r][j][2] + v[r][j][3]);
                mean[r] = wave_sum(s) * (1.f / DMODEL); }
#pragma unroll
            for (int r = 0; r < NR; ++r) { float s2 = 0.f;
#pragma unroll
                for (int j = 0; j < 4; ++j) { v[r][j] = v[r][j] - mean[r]; s2 += (v[r][j][0] * v[r][j][0] + v[r][j][1] * v[r][j][1]) + (v[r][j][2] * v[r][j][2] + v[r][j][3] * v[r][j][3]); }
                rstd[r] = 1.f / sqrtf(wave_sum(s2) * (1.f / DMODEL) + LN_EPS); }
            f32x4 gl[NR];
#pragma unroll
            for (int r = 0; r < NR; ++r) gl[r] = (f32x4){0.f, 0.f, 0.f, 0.f};
#pragma unroll
            for (int r = 0; r < NR; ++r) { const size_t row = (size_t)rg * 128 + wave * 16 + i + r;
#pragma unroll
                for (int j = 0; j < 4; ++j) { v[r][j] = v[r][j] * rstd[r] * gg[j] + bb[j];
                    u32x2g w; w.x = cvtpk(v[r][j][0], v[r][j][1]); w.y = cvtpk(v[r][j][2], v[r][j][3]); *(u32x2g*)(XB + row * DMODEL + 4 * lane + 256 * j) = w;
                    *(unsigned*)(X18 + row * DMODEL + 4 * lane + 256 * j) = pg8::fp8_pk4(v[r][j][0] * pg8::FP8_XS, v[r][j][1] * pg8::FP8_XS, v[r][j][2] * pg8::FP8_XS, v[r][j][3] * pg8::FP8_XS); } }
#pragma unroll
            for (int j = 0; j < 4; ++j)
#pragma unroll
                for (int e = 0; e < 4; ++e) { const f32x4 w = *(const LAS f32x4*)(Wrg + ((j * 4 + e) * 64 + lane) * 4);
#pragma unroll
                    for (int r = 0; r < NR; ++r) gl[r] += w * v[r][j][e]; }
            int gs[NR]; float psel[NR];
#pragma unroll
            for (int r = 0; r < NR; ++r) {
#pragma unroll
                for (int e = 0; e < 4; ++e) gl[r][e] = wave_sum(gl[r][e]) + brg4[e];
                int g_ = 0; float gm = gl[r][0];
#pragma unroll
                for (int e = 1; e < 4; ++e) if (gl[r][e] > gm) { gm = gl[r][e]; g_ = e; }
                psel[r] = 1.0f / ((expf(gl[r][0] - gm) + expf(gl[r][1] - gm)) + (expf(gl[r][2] - gm) + expf(gl[r][3] - gm)));
                gs[r] = __builtin_amdgcn_readfirstlane(g_); }
            f32x4 el[NR];
#pragma unroll
            for (int r = 0; r < NR; ++r) el[r] = (f32x4){0.f, 0.f, 0.f, 0.f};
#pragma unroll
            for (int r = 0; r < NR; ++r) { const LAS float* wre = Wre + gs[r] * 4096;
#pragma unroll
                for (int j = 0; j < 4; ++j)
#pragma unroll
                    for (int e = 0; e < 4; ++e) el[r] += *(const LAS f32x4*)(wre + ((j * 4 + e) * 64 + lane) * 4) * v[r][j][e]; }
#pragma unroll
            for (int r = 0; r < NR; ++r) { const size_t row = (size_t)rg * 128 + wave * 16 + i + r; const f32x4 bre4 = *(const f32x4*)(bre + gs[r] * 4);
#pragma unroll
                for (int e = 0; e < 4; ++e) el[r][e] = wave_sum(el[r][e]) + bre4[e];
                int i1 = 0; float v1 = el[r][0];
#pragma unroll
                for (int e = 1; e < 4; ++e) if (el[r][e] > v1) { v1 = el[r][e]; i1 = e; }
                int i2 = -1; float v2 = 0.f;
#pragma unroll
                for (int e = 0; e < 4; ++e) if (e != i1 && (i2 < 0 || el[r][e] > v2)) { v2 = el[r][e]; i2 = e; }
                const float w1 = psel[r] / (1.0f + expf(v2 - v1)), w2 = psel[r] - w1;
                const int ea = i1 < i2 ? i1 : i2, eb = i1 < i2 ? i2 : i1; const float wa = i1 < i2 ? w1 : w2, wb = i1 < i2 ? w2 : w1;
                const int pair = (ea == 0) ? (eb - 1) : (ea == 1) ? (eb + 1) : 5; const int cls = gs[r] * 6 + pair;
                if (lane == 0) { const int lr = atomicAdd((int*)(cc + cls), 1); LAS int* e_ = ent + 4 * (wave * 16 + i + r); e_[0] = cls; e_[1] = lr; e_[2] = __float_as_int(wa); e_[3] = __float_as_int(wb); } }
        }
        LDS_WAIT(); __syncthreads();
        if (tid < NCLS) { const int n = cc[tid]; cbase[tid] = n ? (int)__hip_atomic_fetch_add(gcnt + 64 * tid, (unsigned)n, RLX_AGENT) : 0; }
        LDS_WAIT(); __syncthreads();
        if (tid < 128) { const LAS int* e_ = ent + 4 * tid; const int idx = e_[0] * CAP + cbase[e_[0]] + e_[1]; rowtok[idx] = rg * 128 + tid; roww[idx] = (f32x2g){__int_as_float(e_[2]), __int_as_float(e_[3])}; }
        __syncthreads();
    }
}
__device__ __forceinline__ void moe_tables(Frame& F, int l) {
    LAS int* cb = (LAS int*)(F.lds + LDSCTL_OFF); LAS int* tot = (LAS int*)(F.lds + LDSCTL_OFF + 128);
    if (F.tid < NCLS) tot[F.tid] = (int)__hip_atomic_load(F.ctl + CW_CNT + 2048 * l + 64 * F.tid, RLX_AGENT);
    LDS_WAIT(); __syncthreads();
    if (F.tid == 0) { int b = 0; for (int c = 0; c < NCLS; ++c) { cb[c] = b; b += (tot[c] + 255) & ~255; } cb[NCLS] = b; }
    LDS_WAIT(); __syncthreads();
}
__device__ __forceinline__ int cls_of_rowtile_(const LAS int* cb, int rt) { int c = 0; for (int q = 1; q < NCLS; ++q) c += (__builtin_amdgcn_readfirstlane(cb[q]) <= rt * 256) ? 1 : 0; return c; }
__device__ __forceinline__ int rowtile_info(const LAS int* cb, int rt, int& z, int& v) {
    const int c = cls_of_rowtile_(cb, rt); const int s0 = rt * 256 - __builtin_amdgcn_readfirstlane(cb[c]); const int n = __builtin_amdgcn_readfirstlane(cb[32 + c]) - s0;
    z = c * CAP + s0; v = n < 256 ? n : 256; return c; }
__device__ __forceinline__ void cls_experts(int cls, int& e1, int& e2) { const int g = cls / 6, p = cls % 6; const int a = p < 3 ? 0 : (p < 5 ? 1 : 2), b = p < 3 ? p + 1 : (p < 5 ? p - 1 : 3); e1 = g * 4 + a; e2 = g * 4 + b; }
struct MoeUpOrder {
    const char* A; const char* B; const int* rt; const LAS int* cb; int G, c;
    __device__ __forceinline__ bool next(int i, pg8::Unit& u) const {
        const int L = i * G + c, nrt = __builtin_amdgcn_readfirstlane(cb[NCLS]) >> 8; if (L >= nrt * 4) return false;
        const int rt_ = L >> 2, j = L & 3, half = j >> 1, jj = j & 1; int e1, e2; cls_experts(rowtile_info(cb, rt_, u.z, u.v), e1, e2);
        u.pm = rt_; u.pn = (half ? e2 : e1) * 2 + jj; u.x = half * 256 + jj * 128; u.y = half; return true; }
    __device__ __forceinline__ const int* rowtab() const { return rt; }
    __device__ __forceinline__ const char* aptr(const pg8::Unit& u, int t) const { return A + (size_t)t * 128; }
    __device__ __forceinline__ const char* bptr(const pg8::Unit& u, int t) const { return B + (size_t)u.pn * (256 * 1024) + (size_t)t * 128; }
};
struct MoeDownOrder {
    const char* A; const char* B; const LAS int* cb; int G, c;
    __device__ __forceinline__ bool next(int i, pg8::Unit& u) const {
        const int L = i * G + c, nrt = __builtin_amdgcn_readfirstlane(cb[NCLS]) >> 8; if (L >= nrt * 4) return false;
        const int rt = L >> 2; int e1, e2; cls_experts(rowtile_info(cb, rt, u.z, u.v), e1, e2);
        u.pm = rt; u.pn = L & 3; u.x = e1; u.y = e2; return true; }
    __device__ __forceinline__ const char* aptr(const pg8::Unit& u, int t) const { return A + (size_t)u.pm * (256 * 512) + (size_t)t * 128; }
    __device__ __forceinline__ const char* bptr(const pg8::Unit& u, int t) const { return B + ((size_t)((t < 2 ? u.x : u.y) * 1024 + u.pn * 256) * 256) + (size_t)(t & 1) * 128; }
};
struct MergeOrder {
    const char* A; const char* B; int G, c;
    __device__ __forceinline__ bool next(int i, pg8::Unit& u) const {
        const int L = i * G + c; if (L >= (M / 256) * 8) return false;
        u.pm = L >> 3; u.pn = L & 7; u.x = 0; u.y = 0; u.z = 0; u.v = 0; return true; }
    __device__ __forceinline__ const char* aptr(const pg8::Unit& u, int t) const { return A + (size_t)(t >> 2) * ((size_t)M * 512) + (size_t)u.pm * (256 * 512) + (size_t)(t & 3) * 128; }
    __device__ __forceinline__ const char* bptr(const pg8::Unit& u, int t) const { return B + (size_t)(t >> 2) * (1024 * 512) + (size_t)u.pn * (128 * 512) + (size_t)(t & 3) * 128; }
};
template <int NR> __device__ __forceinline__ void ln_rows(const bf16* hr, const float* g, const float* b, float* of, bf16* ob, unsigned char* o8, size_t rstride, int lane) {
    f32x4 v[NR][4]; float mean[NR], rstd[NR];
#pragma unroll
    for (int r = 0; r < NR; ++r)
#pragma unroll
        for (int j = 0; j < 4; ++j) { const u32x2g q = *(const u32x2g*)(hr + r * rstride + 4 * lane + 256 * j); v[r][j] = (f32x4){bflo(q.x), bfhi(q.x), bflo(q.y), bfhi(q.y)}; }
    f32x4 gg[4], bb[4];
#pragma unroll
    for (int j = 0; j < 4; ++j) { gg[j] = *(const f32x4*)(g + 4 * lane + 256 * j); bb[j] = *(const f32x4*)(b + 4 * lane + 256 * j); }
#pragma unroll
    for (int r = 0; r < NR; ++r) { float s = 0.f;
#pragma unroll
        for (int j = 0; j < 4; ++j) s += (v[r][j][0] + v[r][j][1]) + (v[r][j][2] + v[r][j][3]);
        mean[r] = wave_sum(s) * (1.f / DMODEL); }
#pragma unroll
    for (int r = 0; r < NR; ++r) { float s2 = 0.f;
#pragma unroll
        for (int j = 0; j < 4; ++j) { v[r][j] = v[r][j] - mean[r]; s2 += (v[r][j][0] * v[r][j][0] + v[r][j][1] * v[r][j][1]) + (v[r][j][2] * v[r][j][2] + v[r][j][3] * v[r][j][3]); }
        rstd[r] = 1.f / sqrtf(wave_sum(s2) * (1.f / DMODEL) + LN_EPS); }
#pragma unroll
    for (int r = 0; r < NR; ++r)
#pragma unroll
        for (int j = 0; j < 4; ++j) { const f32x4 o = v[r][j] * rstd[r] * gg[j] + bb[j];
            if (of) *(f32x4*)(of + r * rstride + 4 * lane + 256 * j) = o;
            else { u32x2g w; w.x = cvtpk(o[0], o[1]); w.y = cvtpk(o[2], o[3]); *(u32x2g*)(ob + r * rstride + 4 * lane + 256 * j) = w;
                const float sc = pg8::FP8_XS; *(unsigned*)(o8 + r * rstride + 4 * lane + 256 * j) = pg8::fp8_pk4(o[0] * sc, o[1] * sc, o[2] * sc, o[3] * sc); } }
}

struct Args { const float* in[27]; float* out; unsigned char* ws; int ph_lo, ph_hi; };
__device__ __forceinline__ void mkframe(Frame& F, int wave, LAS unsigned char* lds) {
    unsigned la = (unsigned)(uintptr_t)lds; asm volatile("" : "+s"(la), "+s"(wave));
    LAS unsigned char* l = (LAS unsigned char*)(uintptr_t)la; volatile LAS unsigned* mi = (volatile LAS unsigned*)(l + MISC_OFF);
    const unsigned w0 = __builtin_amdgcn_readfirstlane(mi[10]), w1 = __builtin_amdgcn_readfirstlane(mi[11]), o0 = __builtin_amdgcn_readfirstlane(mi[12]), o1 = __builtin_amdgcn_readfirstlane(mi[13]);
    GAS unsigned char* wsg = (GAS unsigned char*)(uintptr_t)(((unsigned long long)w1 << 32) | w0); GAS float* og = (GAS float*)(uintptr_t)(((unsigned long long)o1 << 32) | o0);
    const int tid = wave * 64 + xb_lane_id();
    F.ws = (unsigned char*)wsg; F.out = (float*)og;
    F.G = (int)__builtin_amdgcn_readfirstlane(mi[14]); F.vcu = (int)__builtin_amdgcn_readfirstlane(mi[15]); F.bx = (int)__builtin_amdgcn_readfirstlane(mi[16]);
    F.tid = tid; F.lane = tid & 63; F.wave = wave; F.lds = l; F.ctl = (gu32*)(F.ws + WS_CTL);
}
#if MK_PER_PHASE
#define GRID_BAR() do { } while (0)
#else
#define GRID_BAR() do { XcdBarrier b_; b_.bar = (unsigned*)F.ws; b_.off = (unsigned)(WS_CTL / 4 + CW_BAR); b_.x = 0; b_.st = (volatile LAS unsigned*)(F.lds + MISC_OFF) + 8; b_.wave = F.wave; b_.G = (unsigned)F.G; xcd_barrier(b_); } while (0)
#endif
#ifndef PHMASK
#define PHMASK 0x7ff
#endif
#define IN(k) (lo <= (k) && (k) < hi)
#define ON(j) ((PHMASK >> (j)) & 1)
#ifndef REPMASK
#define REPMASK 0
#endif
#define REP(j) for (int rep_ = 0; rep_ < 1 + ((REPMASK >> (j)) & 1); ++rep_)
#ifndef BARX
#define BARX 1
#endif
#define SEAM(k) do { if (IN(k) && IN((k) + 1)) { for (int bx_ = 0; bx_ < BARX; ++bx_) GRID_BAR(); } } while (0)
#define FRAME() Frame F; mkframe(F, wave0, ldsb); unsigned char* const ws = F.ws; LAS unsigned char* const ring = F.lds + RING_OFF; (void)ws; (void)ring
template <int l> __device__ __forceinline__ void layer_phases(const int lo, const int hi, const int wave0, LAS unsigned char* const ldsb) {
        const int pb = 1 + 10 * l;
        const float lam_init = l == 0 ? 0.2f : 0.35550906759096764f;
        if (ON(1) && IN(pb + 0)) { FRAME();
            { pg8::StdOrder S; S.init(ws + WS_XB, ws + W_IN, M, NPB, DMODEL * 2, F.G, F.bx); S.skew = 2;
              pg8::EpiProjA E{(bf16*)(ws + WS_P), (bf16*)(ws + WS_QP), (bf16*)(ws + WS_KP), (const float*)(ws + TB_ROPEC), (const float*)(ws + TB_ROPES), attn_body::C2};
              REP(1) pg8::gemm_phase<pg8::EpiProjA, pg8::StdOrder, false, 0, 2>(ring, F.tid, DMODEL / 64, DMODEL * 2, DMODEL * 2, S, E); }
            { pg8::StdOrder S; S.init(ws + WS_X8, ws + W_G8, M, NGATE, DMODEL, F.G, F.bx); S.skew = 1;
              pg8::EpiGate E{(unsigned char*)F.out};
              REP(1) pg8::gemm_phase<pg8::EpiGate, pg8::StdOrder, false, 1, 2>(ring, F.tid, DMODEL / 128, DMODEL, DMODEL, S, E); }
            SEAM(pb + 0);
        }
        if (ON(2) && IN(pb + 1)) { FRAME();
            REP(2) for (int ch = F.vcu; ch < M / 128; ch += F.G) prep_unit(F, ch, l);
            if (MK_PER_PHASE) SEAM(pb + 1);
        }
        if (ON(3) && IN(pb + 2)) { FRAME();
            float lam;
            { const float* q1 = arg_in(5); const float* k1 = arg_in(6); const float* q2 = arg_in(7); const float* k2 = arg_in(8); const int li = l * 32 + (F.lane & 31);
              const float p1 = F.lane < 32 ? q1[li] * k1[li] : 0.f, p2 = F.lane < 32 ? q2[li] * k2[li] : 0.f;
              lam = expf(wave_sum(p1)) - expf(wave_sum(p2)) + lam_init; }
            const attn_body::bf16* Qp = (const attn_body::bf16*)(ws + WS_QP); const attn_body::bf16* Kp = (const attn_body::bf16*)(ws + WS_KP);
            const attn_body::bf16* Vb = (const attn_body::bf16*)(ws + WS_P) + PC_V; attn_body::bf16* YC = (attn_body::bf16*)(ws + WS_YA) + (size_t)2 * M * 256;
            const float* sg = arg_in(9) + l * 64;
            REP(3) for (int i = 0;; ++i) { const int p = (i >> 1) * F.G + F.vcu; if (p >= 256) break;
                const int bh = p >> 3, s = p & 7, qb = (i & 1) ? 15 - s : s;
                for (int mp = 0; mp < 2; ++mp) attn_body::attn_unit<8>(bh >> 2, bh & 3, mp, qb, Qp, Kp, Vb, YC, lam, 1.0f - lam_init, sg, (char*)(unsigned char*)ring, F.tid); }
            SEAM(pb + 2);
        }
        if (ON(4) && IN(pb + 3)) { FRAME();
            MergeOrder S{(const char*)(ws + WS_YA), (const char*)(ws + W_B), F.G, F.vcu};
            pg8::EpiMerge2 E{(const unsigned char*)F.out, (bf16*)(ws + WS_MG)};
            REP(4) pg8::gemm_phase<pg8::EpiMerge2, MergeOrder, true, 0, 1>(ring, F.tid, 16, 512, 512, S, E);
            SEAM(pb + 3);
        }
        if (ON(5) && IN(pb + 4)) { FRAME();
            pg8::StdOrder S; S.init(ws + WS_MG, ws + W_O, M, DMODEL, DMODEL * 2, F.G, F.bx);
            { pg8::EpiRes<true> E{(const void*)(ws + WS_XB), (bf16*)F.out};
                REP(5) pg8::gemm_phase<pg8::EpiRes<true>, pg8::StdOrder, true, 0, 2>(ring, F.tid, DMODEL / 64, DMODEL * 2, DMODEL * 2, S, E); }
            SEAM(pb + 4);
        }
        if (ON(6) && IN(pb + 5)) { FRAME(); route_phase(F, l); if (IN(pb + 5) && IN(pb + 7)) GRID_BAR(); }
        if (ON(8) && IN(pb + 7)) {
            { FRAME();
              moe_tables(F, l);
              MoeUpOrder S{(const char*)(ws + WS_X18), (const char*)(ws + W_GU), (const int*)(ws + TB2_ROWTOK), (const LAS int*)(F.lds + LDSCTL_OFF), F.G, F.vcu};
              pg8::EpiAct E{(unsigned char*)(ws + WS_HB), (const pg8::f32x2*)(ws + TB2_ROWW)};
              REP(8) pg8::gemm_phase<pg8::EpiAct, MoeUpOrder, true, 1, 2, true>(ring, F.tid, DMODEL / 128, DMODEL, DMODEL, S, E); }
            { FRAME();
              if (l + 1 < DEPTH) convert_tail(F, l + 1, 0, WI_NX);
              SEAM(pb + 7); }
        }
        if (ON(9) && IN(pb + 8)) {
            { FRAME();
              moe_tables(F, l);
              MoeDownOrder S{(const char*)(ws + WS_HB), (const char*)(ws + W_D), (const LAS int*)(F.lds + LDSCTL_OFF), F.G, F.vcu};
              pg8::EpiDown E{(const int*)(ws + TB2_ROWTOK), (bf16*)(ws + WS_XB)};
              pg8::gemm_phase<pg8::EpiDown, MoeDownOrder, true, 1, 2>(ring, F.tid, 4, 512, 256, S, E); }
            { FRAME();
              if (l + 1 < DEPTH) convert_tail(F, l + 1, WI_NX, WI_NX + WI_GU);
              SEAM(pb + 8); }
        }
        if (ON(10) && IN(pb + 9)) { FRAME();
            bf16* XB = (bf16*)(ws + WS_XB);
            const float* g2 = arg_in(25) + l * DMODEL; const float* b2 = arg_in(26) + l * DMODEL;
            for (int m = 4 * (F.vcu * NWAVES + F.wave); m < M; m += 4 * F.G * NWAVES)
                ln_rows<4>(XB + (size_t)m * DMODEL, g2, b2, (l == DEPTH - 1) ? F.out + (size_t)m * DMODEL : nullptr, XB + (size_t)m * DMODEL, ws + WS_X8 + (size_t)m * DMODEL, (size_t)DMODEL, F.lane);
            if (l + 1 < DEPTH) { convert_weights(F, l + 1, WI_NX + WI_GU, WI_ALL); SEAM(pb + 9); }
        }
}
__global__ void __launch_bounds__(NWAVES * 64, 2) fwd(Args args) {
    extern __shared__ __attribute__((aligned(16))) unsigned char lds[];
    LAS unsigned char* const ldsb = (LAS unsigned char*)lds;
    const int G0 = gridDim.x; int vcu0; { const int bx = blockIdx.x; vcu0 = (G0 % 8 == 0) ? (bx % 8) * (G0 / 8) + bx / 8 : bx; }
    unsigned char* const ws0 = args.ws; float* const out0 = args.out; const int wave0 = __builtin_amdgcn_readfirstlane((int)threadIdx.x >> 6);
    for (int u = threadIdx.x; u < (LDS_BYTES - LDSCTL_OFF) / 4; u += NWAVES * 64) ((LAS unsigned*)(ldsb + LDSCTL_OFF))[u] = 0u;
    __syncthreads();
    volatile LAS unsigned* MISC = (volatile LAS unsigned*)(ldsb + MISC_OFF);
    if (threadIdx.x == 0) { const unsigned long long w = (unsigned long long)(uintptr_t)ws0, o = (unsigned long long)(uintptr_t)out0;
        MISC[10] = (unsigned)w; MISC[11] = (unsigned)(w >> 32); MISC[12] = (unsigned)o; MISC[13] = (unsigned)(o >> 32); MISC[14] = (unsigned)G0; MISC[15] = (unsigned)vcu0; MISC[16] = blockIdx.x; }
    __syncthreads();
#if !MK_PER_PHASE
    (void)xcd_barrier_post((unsigned*)ws0, (unsigned)(WS_CTL / 4 + CW_BAR), MISC + 8, wave0);
#endif
    const int lo = args.ph_lo, hi = args.ph_hi;
    if (ON(0) && IN(0)) { FRAME(); REP(0) p0_prologue(F); SEAM(0); }
    layer_phases<0>(lo, hi, wave0, ldsb);
    layer_phases<1>(lo, hi, wave0, ldsb);
    static_assert(DEPTH == 2, "two layer instances");
}
#undef IN
#undef SEAM
#undef GRID_BAR
#undef FRAME


extern "C" void kernel_launch(void* const* d_in, const int* in_sizes, int n_in, void* d_out, int out_size, void* d_ws, size_t ws_size, hipStream_t stream) {
    static int grid = 0;
    if (grid == 0) {
        if (n_in != 27 || in_sizes[0] != M * DMODEL || out_size != M * DMODEL || ws_size < WS_END) { fprintf(stderr, "kernel_launch: built for 27 inputs, x/out of %d floats, >= %zu bytes of workspace; got n_in %d, in0 %d, out %d, ws %zu; nothing launched\n", M * DMODEL, (size_t)WS_END, n_in, n_in > 0 ? in_sizes[0] : -1, out_size, ws_size); grid = -1; return; }
        int dev = 0, cus = 0, per_cu = 0;
        if (hipGetDevice(&dev) != hipSuccess || hipDeviceGetAttribute(&cus, hipDeviceAttributeMultiprocessorCount, dev) != hipSuccess) { fprintf(stderr, "kernel_launch: device query failed\n"); grid = -1; return; }
        if (hipFuncSetAttribute((const void*)fwd, hipFuncAttributeMaxDynamicSharedMemorySize, LDS_BYTES) != hipSuccess) { fprintf(stderr, "kernel_launch: hipFuncSetAttribute failed\n"); grid = -1; return; }
        if (hipOccupancyMaxActiveBlocksPerMultiprocessor(&per_cu, (const void*)fwd, NWAVES * 64, LDS_BYTES) != hipSuccess || per_cu < 1) { fprintf(stderr, "kernel_launch: occupancy query reports %d workgroups per CU\n", per_cu); }
        (void)hipGetLastError();
        grid = cus;
    }
    if (grid < 0) return;
    if (hipMemsetAsync((char*)d_ws + WS_CTL, 0, CTL_ZERO_BYTES, stream) != hipSuccess) { fprintf(stderr, "kernel_launch: memset failed\n"); return; }
    Args a{};
    for (int i = 0; i < 27; ++i) a.in[i] = (const float*)d_in[i];
    a.out = (float*)d_out; a.ws = (unsigned char*)d_ws;
#if MK_PER_PHASE
    for (int p = 0; p < NPHASE; ++p) { a.ph_lo = p; a.ph_hi = p + 1; hipLaunchKernelGGL(fwd, dim3(grid), dim3(NWAVES * 64), LDS_BYTES, stream, a); }
#else
    a.ph_lo = 0; a.ph_hi = NPHASE; hipLaunchKernelGGL(fwd, dim3(grid), dim3(NWAVES * 64), LDS_BYTES, stream, a);
#endif
    const hipError_t le = hipPeekAtLastError();
    if (le != hipSuccess) fprintf(stderr, "kernel_launch: launch failed: %s\n", hipGetErrorName(le));
}
```
